# Optimizing an MI355X kernel written in HIP

```python
import jax, jax.numpy as jnp
from jax import lax
import numpy as np

D_MODEL = 1024
BATCH = 32
SEQ = 2048
DEPTH = 4

GRID_W = 64
CTX_LEN = 256
CONV_DIM = 1024
CONV_WIDTH = 3
MLSTM_HEADS = 4
MLSTM_HEAD_DIM = 256
MLSTM_DIM = MLSTM_HEADS * MLSTM_HEAD_DIM
MLSTM_CHUNK = 64
MLSTM_K_SCALE = MLSTM_HEAD_DIM ** -0.5
NEG_INIT = -1e30
MLA_HEADS = 16
QK_NOPE_DIM = 128
QK_ROPE_DIM = 64
V_HEAD_DIM = 128
Q_LORA_RANK = 384
KV_LORA_RANK = 256
MLA_DIM = MLA_HEADS * V_HEAD_DIM
MLA_SCALE = (QK_NOPE_DIM + QK_ROPE_DIM) ** -0.5
ROPE_BASE = 10000.0
Q_BLOCK = 128
EVEN_IN_SIZES = (CONV_DIM, CONV_DIM, CONV_DIM, CONV_DIM, MLSTM_DIM, MLSTM_DIM, MLSTM_DIM, MLSTM_DIM, MLSTM_DIM, 4 * MLSTM_HEADS)
EVEN_IN_DIM = 4 * CONV_DIM + 5 * MLSTM_DIM + 4 * MLSTM_HEADS
EVEN_MIX_DIM = CONV_DIM + MLSTM_DIM
ODD_IN_SIZES = (Q_LORA_RANK, KV_LORA_RANK, QK_ROPE_DIM, MLA_DIM)
ODD_IN_DIM = Q_LORA_RANK + KV_LORA_RANK + QK_ROPE_DIM + MLA_DIM
N_EVEN = (DEPTH + 1) // 2
N_ODD = DEPTH // 2
LN_EPS = 1e-5
RMS_EPS = 1e-6
DEEPNORM_ALPHA = (2 * DEPTH) ** 0.25
DEEPNORM_BETA = (8 * DEPTH) ** -0.25

kernel_name = 'hybrid_conv_mlstm_mla_prefix_trunk'


def layer_norm(x, g, b):
    xf = x.astype(jnp.float32)
    mu = jnp.mean(xf, axis=-1, keepdims=True)
    var = jnp.mean(jnp.square(xf - mu), axis=-1, keepdims=True)
    return ((xf - mu) * lax.rsqrt(var + LN_EPS) * g + b).astype(x.dtype)


def rms_norm(x, g):
    xf = x.astype(jnp.float32)
    return (xf * lax.rsqrt(jnp.mean(jnp.square(xf), axis=-1, keepdims=True) + RMS_EPS) * g).astype(x.dtype)


def split_cols(p, sizes):
    out, start = [], 0
    for s in sizes:
        out.append(p[..., start:start + s])
        start += s
    return out


def axial_rope_tables(n_lat):
    rows = n_lat // GRID_W
    row = jnp.repeat(jnp.arange(rows, dtype=jnp.float32), GRID_W)
    col = jnp.tile(jnp.arange(GRID_W, dtype=jnp.float32), rows)
    n_freq = QK_ROPE_DIM // 4
    inv_freq = ROPE_BASE ** (-jnp.arange(n_freq, dtype=jnp.float32) / n_freq)
    ang = jnp.concatenate([row[:, None] * inv_freq, col[:, None] * inv_freq], axis=-1)
    return jnp.cos(ang), jnp.sin(ang)


def apply_rope(x, cos, sin):
    half = QK_ROPE_DIM // 2
    x1, x2 = x[..., :half], x[..., half:]
    return jnp.concatenate([x1 * cos - x2 * sin, x1 * sin + x2 * cos], axis=-1).astype(x.dtype)


def short_conv3(u, w):
    up = jnp.pad(u, ((0, 0), (1, 1), (0, 0)))
    return up[:, :-2] * w[0] + up[:, 1:-1] * w[1] + up[:, 2:] * w[2]


def mlstm_zero_state(bsz):
    return (jnp.zeros((bsz, MLSTM_HEADS, MLSTM_HEAD_DIM, MLSTM_HEAD_DIM), jnp.float32),
            jnp.zeros((bsz, MLSTM_HEADS, MLSTM_HEAD_DIM), jnp.float32),
            jnp.full((bsz, MLSTM_HEADS), NEG_INIT, jnp.float32))


def mlstm_chunkwise(q, k, v, i_pre, log_f, state):
    bsz, nh, t_len, dh = q.shape
    n_chunk = t_len // MLSTM_CHUNK

    def chunks(a):
        a = a.astype(jnp.float32).reshape((bsz, nh, n_chunk, MLSTM_CHUNK) + a.shape[3:])
        return jnp.moveaxis(a, 2, 0)

    xs = (chunks(q), chunks(k), chunks(v), chunks(i_pre), chunks(log_f))
    lower = jnp.tril(jnp.ones((MLSTM_CHUNK, MLSTM_CHUNK), dtype=bool))

    def step(carry, inp):
        c_st, n_st, m_st = carry
        qc, kc, vc, ic, fc = inp
        b = lax.cumsum(fc, axis=2)
        d = jnp.where(lower, b[..., :, None] - b[..., None, :] + ic[..., None, :], -jnp.inf)
        inter = b + m_st[..., None]
        m_t = jnp.maximum(inter, jnp.max(d, axis=-1))
        w = jnp.exp(d - m_t[..., None])
        a_inter = jnp.exp(inter - m_t)
        s = jnp.einsum('bhtd,bhsd->bhts', qc, kc) * w
        num = jnp.einsum('bhts,bhsd->bhtd', s, vc) + a_inter[..., None] * jnp.einsum('bhtk,bhkd->bhtd', qc, c_st)
        den = jnp.sum(s, axis=-1) + a_inter * jnp.einsum('bhtk,bhk->bht', qc, n_st)
        h = num / jnp.maximum(jnp.abs(den), jnp.exp(-m_t))[..., None]
        m_new = m_t[..., -1]
        decay = jnp.exp(b[..., -1] + m_st - m_new)
        w_tok = jnp.exp(b[..., -1:] - b + ic - m_new[..., None])
        kw = kc * w_tok[..., None]
        c_new = decay[..., None, None] * c_st + jnp.einsum('bhsk,bhsd->bhkd', kw, vc)
        n_new = decay[..., None] * n_st + jnp.sum(kw, axis=2)
        return (c_new, n_new, m_new), h

    state, hs = lax.scan(step, state, xs)
    return jnp.moveaxis(hs, 0, 2).reshape(bsz, nh, t_len, dh), state


def even_mixer(u_ctx, u_lat, w_in, conv_w, gate_b, w_out, need_ctx):
    s_ctx = split_cols(u_ctx @ w_in, EVEN_IN_SIZES)
    s_lat = split_cols(u_lat @ w_in, EVEN_IN_SIZES)

    def conv_branch(s):
        a_b, a_c, a_x, a_z = s[:4]
        return a_b * short_conv3(a_c * a_x, conv_w) * jax.nn.silu(a_z)

    def to_heads(a):
        bsz, t_len, _ = a.shape
        return a.reshape(bsz, t_len, MLSTM_HEADS, MLSTM_HEAD_DIM).transpose(0, 2, 1, 3)

    def mlstm_inputs(s):
        q, k, v, g = s[4], s[5], s[6], s[9]
        bsz, t_len, _ = g.shape
        g = (g + gate_b).astype(jnp.float32).reshape(bsz, t_len, 2, 2, MLSTM_HEADS)
        g = jnp.transpose(g, (2, 3, 0, 4, 1))
        return to_heads(q), to_heads(k) * MLSTM_K_SCALE, to_heads(v), g

    qc, kc, vc, gc = mlstm_inputs(s_ctx)
    ql, kl, vl, gl = mlstm_inputs(s_lat)
    h_ctx, h_lat = 0.0, 0.0
    for direction in range(2):
        f = (lambda a: jnp.flip(a, axis=2)) if direction == 1 else (lambda a: a)
        hc, st = mlstm_chunkwise(f(qc), f(kc), f(vc), f(gc[direction, 0]),
                                 jax.nn.log_sigmoid(f(gc[direction, 1])), mlstm_zero_state(qc.shape[0]))
        hl, _ = mlstm_chunkwise(f(ql), f(kl), f(vl), f(gl[direction, 0]),
                                jax.nn.log_sigmoid(f(gl[direction, 1])), st)
        h_lat = h_lat + f(hl)
        if need_ctx:
            h_ctx = h_ctx + f(hc)

    def mlstm_branch(h, s):
        o, z = s[7], s[8]
        bsz, t_len, _ = o.shape
        h = h.transpose(0, 2, 1, 3).reshape(bsz, t_len, MLSTM_DIM).astype(o.dtype)
        return jax.nn.sigmoid(o) * h * jax.nn.silu(z)

    def merge(s, h):
        return jnp.concatenate([conv_branch(s), mlstm_branch(h, s)], axis=-1) @ w_out

    y_lat = merge(s_lat, h_lat)
    y_ctx = merge(s_ctx, h_ctx) if need_ctx else None
    return y_ctx, y_lat


def mla_attend(q_n, q_r, k_n, k_r, v):
    s = jnp.einsum('bqhd,bkhd->bhqk', q_n, k_n) + jnp.einsum('bqhr,bkr->bhqk', q_r, k_r)
    p = jax.nn.softmax(s.astype(jnp.float32) * MLA_SCALE, axis=-1)
    return jnp.einsum('bhqk,bkhd->bqhd', p.astype(v.dtype), v)


def mla_mixer(u_ctx, u_lat, w_in, q_norm, w_uq, kv_norm, w_ukv, w_out, cos, sin, need_ctx):
    s_ctx = split_cols(u_ctx @ w_in, ODD_IN_SIZES)
    s_lat = split_cols(u_lat @ w_in, ODD_IN_SIZES)

    def kv_side(s):
        kv_c, k_r = s[1], s[2]
        bsz, t_len, _ = kv_c.shape
        kv = (rms_norm(kv_c, kv_norm) @ w_ukv).reshape(bsz, t_len, MLA_HEADS, QK_NOPE_DIM + V_HEAD_DIM)
        return kv[..., :QK_NOPE_DIM], k_r, kv[..., QK_NOPE_DIM:]

    def q_side(s):
        q_c = s[0]
        bsz, t_len, _ = q_c.shape
        q = (rms_norm(q_c, q_norm) @ w_uq).reshape(bsz, t_len, MLA_HEADS, QK_NOPE_DIM + QK_ROPE_DIM)
        return q[..., :QK_NOPE_DIM], q[..., QK_NOPE_DIM:]

    kn_c, kr_c, v_c = kv_side(s_ctx)
    kn_l, kr_l, v_l = kv_side(s_lat)
    kr_l = apply_rope(kr_l, cos, sin)
    qn_l, qr_l = q_side(s_lat)
    qr_l = apply_rope(qr_l, cos[:, None, :], sin[:, None, :])
    kn_all = jnp.concatenate([kn_c, kn_l], axis=1)
    kr_all = jnp.concatenate([kr_c, kr_l], axis=1)
    v_all = jnp.concatenate([v_c, v_l], axis=1)
    bsz, n_lat, _ = u_lat.shape
    n_blk = n_lat // Q_BLOCK

    def blocks(a):
        return jnp.moveaxis(a.reshape((bsz, n_blk, Q_BLOCK) + a.shape[2:]), 1, 0)

    o_blk = lax.map(lambda qs: mla_attend(qs[0], qs[1], kn_all, kr_all, v_all), (blocks(qn_l), blocks(qr_l)))
    o_lat = jnp.moveaxis(o_blk, 0, 1).reshape(bsz, n_lat, MLA_DIM)
    y_lat = (o_lat * jax.nn.silu(s_lat[3])) @ w_out
    y_ctx = None
    if need_ctx:
        qn_c, qr_c = q_side(s_ctx)
        o_ctx = mla_attend(qn_c, qr_c, kn_c, kr_c, v_c).reshape(bsz, -1, MLA_DIM)
        y_ctx = (o_ctx * jax.nn.silu(s_ctx[3])) @ w_out
    return y_ctx, y_lat


def setup_inputs(seed: int = 0) -> dict:
    key = jax.random.key(seed)
    ks = jax.random.split(key, 20)

    def nrm(k, shape, s):
        return jax.random.normal(k, shape, jnp.float32) * s

    i_bias = nrm(ks[10], (N_EVEN, 2, 1, MLSTM_HEADS), 0.1)
    f_bias = jnp.linspace(3.0, 6.0, MLSTM_HEADS, dtype=jnp.float32) + nrm(ks[11], (N_EVEN, 2, 1, MLSTM_HEADS), 0.1)
    return {
        'x': nrm(ks[0], (BATCH, SEQ, D_MODEL), 1.0),
        'c': nrm(ks[1], (BATCH, D_MODEL), 1.0),
        'ctx': nrm(ks[2], (BATCH, CTX_LEN, D_MODEL), 1.0),
        'c_ctx': nrm(ks[3], (D_MODEL,), 1.0),
        'mod_w': nrm(ks[4], (DEPTH, D_MODEL, 3 * D_MODEL), 0.5 * D_MODEL ** -0.5),
        'mod_b': nrm(ks[5], (DEPTH, 3 * D_MODEL), 0.01),
        'ln_g': 1.0 + nrm(ks[6], (DEPTH, D_MODEL), 0.01),
        'ln_b': nrm(ks[7], (DEPTH, D_MODEL), 0.01),
        'ev_w_in': nrm(ks[8], (N_EVEN, D_MODEL, EVEN_IN_DIM), D_MODEL ** -0.5),
        'ev_conv_w': nrm(ks[9], (N_EVEN, CONV_WIDTH, CONV_DIM), CONV_WIDTH ** -0.5),
        'ev_gate_b': jnp.concatenate([i_bias, f_bias], axis=2).reshape(N_EVEN, 4 * MLSTM_HEADS),
        'ev_w_out': nrm(ks[12], (N_EVEN, EVEN_MIX_DIM, D_MODEL), DEEPNORM_BETA * EVEN_MIX_DIM ** -0.5),
        'od_w_in': nrm(ks[13], (N_ODD, D_MODEL, ODD_IN_DIM), D_MODEL ** -0.5),
        'od_q_norm': 1.0 + nrm(ks[14], (N_ODD, Q_LORA_RANK), 0.01),
        'od_w_uq': nrm(ks[15], (N_ODD, Q_LORA_RANK, MLA_HEADS * (QK_NOPE_DIM + QK_ROPE_DIM)), Q_LORA_RANK ** -0.5),
        'od_kv_norm': 1.0 + nrm(ks[16], (N_ODD, KV_LORA_RANK), 0.01),
        'od_w_ukv': nrm(ks[17], (N_ODD, KV_LORA_RANK, MLA_HEADS * (QK_NOPE_DIM + V_HEAD_DIM)), KV_LORA_RANK ** -0.5),
        'od_w_out': nrm(ks[18], (N_ODD, MLA_DIM, D_MODEL), DEEPNORM_BETA * MLA_DIM ** -0.5),
    }


def reference(x, c, ctx, c_ctx, mod_w, mod_b, ln_g, ln_b, ev_w_in, ev_conv_w, ev_gate_b, ev_w_out,
              od_w_in, od_q_norm, od_w_uq, od_kv_norm, od_w_ukv, od_w_out):
    cos, sin = axial_rope_tables(x.shape[1])
    silu_c = jax.nn.silu(c)
    silu_cc = jax.nn.silu(c_ctx)
    h_lat, h_ctx = x, ctx
    for layer in range(DEPTH):
        need_ctx = layer < DEPTH - 1
        sh_l, sc_l, g_l = jnp.split((silu_c @ mod_w[layer] + mod_b[layer])[:, None, :], 3, axis=-1)
        sh_c, sc_c, g_c = jnp.split(silu_cc @ mod_w[layer] + mod_b[layer], 3, axis=-1)
        u_lat = h_lat * (1.0 + sc_l) + sh_l
        u_ctx = h_ctx * (1.0 + sc_c) + sh_c
        j = layer // 2
        if layer % 2 == 0:
            y_ctx, y_lat = even_mixer(u_ctx, u_lat, ev_w_in[j], ev_conv_w[j], ev_gate_b[j], ev_w_out[j], need_ctx)
        else:
            y_ctx, y_lat = mla_mixer(u_ctx, u_lat, od_w_in[j], od_q_norm[j], od_w_uq[j], od_kv_norm[j],
                                     od_w_ukv[j], od_w_out[j], cos, sin, need_ctx)
        h_lat = layer_norm(DEEPNORM_ALPHA * h_lat + g_l * y_lat, ln_g[layer], ln_b[layer])
        if need_ctx:
            h_ctx = layer_norm(DEEPNORM_ALPHA * h_ctx + g_c * y_ctx, ln_g[layer], ln_b[layer])
    return h_lat
```

```cpp
#include <hip/hip_runtime.h>
#include <cstdio>
#include <cstdint>

#define LAS __attribute__((address_space(3)))
typedef unsigned short bf16_t;
typedef short bf16x8 __attribute__((ext_vector_type(8)));
typedef float f32x4 __attribute__((ext_vector_type(4)));
typedef unsigned u32x4 __attribute__((ext_vector_type(4)));
typedef unsigned u32x2 __attribute__((ext_vector_type(2)));

constexpr int DM = 1024, NB = 32, SEQ = 2048, CTXL = 256, SB = SEQ + CTXL  , TOK = NB * SB  ;
constexpr int NTILE = TOK / 256;
constexpr int EV_LD = 6144;
constexpr int EV_NP = 9472;
constexpr int OD_LD = 2816;
constexpr int NGRP = 4, GB = NB / NGRP  , GT = GB * 9  , GROWS = GB * SB  ;
constexpr float ALPHA = 1.681792830507429f;
constexpr float QSCALE = 0.07216878364870322f * 1.4426950408889634f;
constexpr float LN_EPS = 1e-5f, RMS_EPS = 1e-6f;

constexpr size_t DO_U = 0;
constexpr size_t DO_W = 150994944;
constexpr size_t W_PAIR = 38010880, W_EVIN = 0, W_EVOUT = 19398656, W_ODIN = 23592960, W_UQ = 29360128, W_UKV = 31719424, W_ODOUT = 33816576;
constexpr size_t DO_MODV = DO_W + 2 * W_PAIR;
constexpr size_t DO_ROPE = DO_MODV + 1622016;
constexpr size_t DO_ROWSC = DO_ROPE + 524288;
constexpr size_t DO_SMALL = DO_ROWSC + 589824;
constexpr size_t DO_END = DO_SMALL + 9437184;
static_assert(DO_END <= 268435456, "d_out map");
constexpr size_t WS_CTL = 0, CTL_BYTES = 1 << 20;
constexpr size_t WS_H = 1 << 20;
constexpr size_t WS_BIG = WS_H + 150994944;
constexpr size_t BIG_Q = 415236096, BIG_K = BIG_Q + 113246208, BIG_V = BIG_K + 113246208;
constexpr size_t WS_END = WS_BIG + 905969664;
static_assert(WS_END <= 1073741824, "ws map");
static_assert(BIG_V + 75497472 <= 905969664, "odd map");

__device__ __forceinline__ unsigned cvt_pk_bf16(float lo, float hi) { unsigned r; asm volatile("v_cvt_pk_bf16_f32 %0, %1, %2" : "=v"(r) : "v"(lo), "v"(hi)); return r; }
__device__ __forceinline__ float bflo(unsigned w) { return __uint_as_float(w << 16); }
__device__ __forceinline__ float bfhi(unsigned w) { return __uint_as_float(w & 0xffff0000u); }
__device__ __forceinline__ float bf1(bf16_t h) { return __uint_as_float(((unsigned)h) << 16); }
__device__ __forceinline__ bf16_t f2bf(float f) { return (bf16_t)(cvt_pk_bf16(f, 0.f) & 0xffffu); }
__device__ __forceinline__ float fsigmoid(float x) { return __builtin_amdgcn_rcpf(1.0f + __builtin_amdgcn_exp2f(-1.4426950408889634f * x)); }
__device__ __forceinline__ float fsilu(float x) { return x * fsigmoid(x); }
__device__ __forceinline__ float wave_sum(float v) {
#pragma unroll
    for (int o = 1; o < 64; o <<= 1) v += __shfl_xor(v, o);
    return v;
}
#define LDS_WAIT() asm volatile("s_waitcnt lgkmcnt(0)" ::: "memory")

#define XB_TMO      128
#define XB_XCNT(j)  (256  + 64 * (j))
#define XB_XSUB(j)  (1280 + 64 * (j))
#define XB_XGEN(j)  (2304 + 64 * (j))
#define XB_TOP      3328
#define XB_TOPGEN   3392
#define XCD_BAR_WORDS 3456
#define XB_SPIN_CAP (1u << 24)
__device__ __forceinline__ unsigned xb_ld(unsigned* p)              { return __hip_atomic_load(p, __ATOMIC_RELAXED, __HIP_MEMORY_SCOPE_AGENT); }
__device__ __forceinline__ unsigned xb_add(unsigned* p, unsigned v) { return __hip_atomic_fetch_add(p, v, __ATOMIC_RELAXED, __HIP_MEMORY_SCOPE_AGENT); }
__device__ __forceinline__ unsigned xb_xcc_id() { return (unsigned)__builtin_amdgcn_s_getreg((3 << 11) | 20) & 0xFu; }
#define XB_SPIN(cond, bar) do { unsigned _sp = 0; while (cond) { __builtin_amdgcn_s_sleep(1); \
    if ((++_sp & 255u) == 0u) { if (xb_ld(&(bar)[XB_TMO])) break; if (_sp > XB_SPIN_CAP) { atomicAdd(&(bar)[XB_TMO], 1u); break; } } } } while (0)
struct XcdBarrier { unsigned* bar; unsigned x; volatile LAS unsigned* st; };
__device__ __forceinline__ XcdBarrier xcd_barrier_post(unsigned* bar, volatile LAS unsigned* st) {
    XcdBarrier b; b.bar = bar; b.x = xb_xcc_id(); b.st = st;
    if (threadIdx.x == 0) (void)xb_add(&bar[XB_XCNT(b.x)], 1u);
    return b;
}
__device__ __forceinline__ void xcd_barrier_complete(unsigned* bar, unsigned x, unsigned& nloc, unsigned& nx) {
    const unsigned G = gridDim.x * gridDim.y * gridDim.z;
    unsigned sum, cnt, mine, sp = 0u;
    for (;;) {
        sum = 0u; cnt = 0u; mine = 0u;
#pragma unroll
        for (unsigned j = 0; j < 16; ++j) { const unsigned c = xb_ld(&bar[XB_XCNT(j)]); sum += c; cnt += (c > 0u) ? 1u : 0u; mine = (j == x) ? c : mine; }
        if (sum == G) break;
        __builtin_amdgcn_s_sleep(1);
        if ((++sp & 255u) == 0u) { if (xb_ld(&bar[XB_TMO])) break; if (sp > XB_SPIN_CAP) { atomicAdd(&bar[XB_TMO], 1u); break; } }
    }
    nloc = mine > 0u ? mine : 1u; nx = cnt > 0u ? cnt : 1u;
}
__device__ __forceinline__ void xcd_barrier(const XcdBarrier& b) {
    asm volatile("s_waitcnt vmcnt(0)" ::: "memory");
    __syncthreads();
    if (threadIdx.x == 0) {
        unsigned* bar = b.bar;
        __builtin_amdgcn_s_waitcnt(0);
        unsigned nloc = b.st[0], nx = b.st[1];
        if (nloc == 0u) { xcd_barrier_complete(bar, b.x, nloc, nx); b.st[0] = nloc; b.st[1] = nx; }
        const unsigned old = xb_add(&bar[XB_XSUB(b.x)], 1u);
        const unsigned gen = old / nloc;
        if (old + 1u == (gen + 1u) * nloc) {
            __builtin_amdgcn_fence(__ATOMIC_RELEASE, "agent");
            asm volatile("s_waitcnt vmcnt(0)" ::: "memory");
            const unsigned og = xb_add(&bar[XB_TOP], 1u);
            const unsigned tg = og / nx;
            if (og + 1u == (tg + 1u) * nx) xb_add(&bar[XB_TOPGEN], 1u);
            else XB_SPIN(xb_ld(&bar[XB_TOPGEN]) == tg, bar);
            __builtin_amdgcn_fence(__ATOMIC_ACQUIRE, "agent");
            xb_add(&bar[XB_XGEN(b.x)], 1u);
            asm volatile("s_waitcnt vmcnt(0)" ::: "memory");
        } else {
            XB_SPIN(xb_ld(&bar[XB_XGEN(b.x)]) == gen, bar);
            __builtin_amdgcn_fence(__ATOMIC_ACQUIRE, "agent");
            asm volatile("s_waitcnt vmcnt(0)" ::: "memory");
        }
    }
    __syncthreads();
}

namespace pg8 {
constexpr int BM = 256, BK = 64, HALF = 128, HTB = HALF * BK * 2, STAGE_BYTES = 8 * HTB, NXCD = 8, WGM = 8;
__host__ __device__ __forceinline__ int lds_byte(int r, int c) { const int st = (r >> 4) * 2 + (c >> 5), rr = r & 15, cc = c & 31, ob = rr * 64 + cc * 2; return st * 1024 + (ob ^ (((ob >> 9) & 1) << 5)); }
__host__ __device__ __forceinline__ void stage_rc(int b, int& R, int& C) { const int st = b / 1024, sb = b % 1024, swz = sb ^ (((sb >> 9) & 1) << 5); R = (st >> 1) * 16 + swz / 64; C = (st & 1) * 32 + (swz % 64) / 2; }
__host__ __device__ __forceinline__ int perm32(int rho) { const int n = rho >> 4, i = rho & 15; return 8 * (i >> 2) + 4 * n + (i & 3); }
struct Unit { int pm, pn; };
struct Gemm { const bf16_t* A; const bf16_t* Bt; int lda, K, nM, nN, tbase, gsz, gstride, goff;
    __device__ __forceinline__ int ptile(int pm) const { return tbase + (pm / gsz) * gstride + goff + (pm % gsz); } };
struct StaticOrder {
    int nM, nN, nwg, G, c;
    __device__ void init(int nM_, int nN_, int G_, int c_) { nM = nM_; nN = nN_; nwg = nM * nN; G = G_; c = c_; }
    __device__ bool next(int i, Unit& u) const {
        const long L = (long)i * G + c; if (L >= nwg) return false;
        int wgid = (int)L; { const int q = nwg / NXCD, r = nwg % NXCD, xcd = wgid % NXCD, off = wgid / NXCD; wgid = (xcd < r ? xcd * (q + 1) : r * (q + 1) + (xcd - r) * q) + off; }
        const int nig = WGM * nN, gid = wgid / nig, fm = gid * WGM, gsz = (nM - fm) < WGM ? (nM - fm) : WGM;
        u.pm = fm + ((wgid % nig) % gsz); u.pn = (wgid % nig) / gsz; return true;
    }
};
template <class Epi>
__device__ __forceinline__ void gemm_phase(LAS unsigned char* lds, const int tid, const Gemm g, const StaticOrder& S, const Epi& E) {
    const int wid = __builtin_amdgcn_readfirstlane(tid >> 6), lane = tid & 63, wr = wid >> 2, wc = wid & 3, fr = lane & 15, fq = lane >> 4;
    const int K = g.K, nt = K / BK, lda = g.lda;
    unsigned voffA[2], voffB[2];
#pragma unroll
    for (int i = 0; i < 2; ++i) { int R, C; stage_rc(tid * 16 + i * 8192, R, C); const int Rb = (R & ~31) + perm32(R & 31);
        voffA[i] = (unsigned)(R * lda + C) * 2u; voffB[i] = (unsigned)(Rb * K + C) * 2u; }
    const size_t kstep = (size_t)(BK * 2);
    const size_t hstepA = (size_t)HALF * lda * 2, hstepB = (size_t)HALF * K * 2;
    const size_t tstepA = 2 * hstepA, tstepB = 2 * hstepB;
    const unsigned ldsw = (unsigned)wid * 1024u;
    const int aoff = lds_byte(wr * 64 + fr, fq * 8), boff = lds_byte(wc * 32 + fr, fq * 8);
#define PG8_SA(b, h) (((b) * 2 + (h)) * HTB)
#define PG8_SB(b, h) ((4 + (b) * 2 + (h)) * HTB)
#define PG8_STAGE(bufoff, gbase, voff) do { _Pragma("unroll") for (int _i = 0; _i < 2; ++_i) \
        __builtin_amdgcn_global_load_lds((const unsigned*)((const char*)(gbase) + (voff)[_i]), (LAS unsigned*)(lds + (bufoff) + ldsw + _i * 8192), 16, 0, 0); } while (0)
#define PG8_LDA(dst, b, h) do { _Pragma("unroll") for (int m = 0; m < 4; ++m) _Pragma("unroll") for (int k = 0; k < 2; ++k) dst[m][k] = *(const LAS bf16x8*)(lds + PG8_SA(b, h) + aoff + m * 2048 + k * 1024); } while (0)
#define PG8_LDB(dst, b, h) do { _Pragma("unroll") for (int n = 0; n < 2; ++n) _Pragma("unroll") for (int k = 0; k < 2; ++k) dst[n][k] = *(const LAS bf16x8*)(lds + PG8_SB(b, h) + boff + n * 2048 + k * 1024); } while (0)
#define PG8_MMA(ai, bj, At, Bt) do { __builtin_amdgcn_s_setprio(1); _Pragma("unroll") for (int m = 0; m < 4; ++m) _Pragma("unroll") for (int n = 0; n < 2; ++n) _Pragma("unroll") for (int k = 0; k < 2; ++k) \
        acc[ai][bj][m][n] = __builtin_amdgcn_mfma_f32_16x16x32_bf16(Bt[n][k], At[m][k], acc[ai][bj][m][n], 0, 0, 0); __builtin_amdgcn_s_setprio(0); } while (0)
#define PG8_WAIT_V(n) asm volatile("s_waitcnt vmcnt(" #n ")" ::: "memory")
#define PG8_WAIT_L(n) asm volatile("s_waitcnt lgkmcnt(" #n ")" ::: "memory")
#define PG8_BAR __builtin_amdgcn_s_barrier()
#define PG8_SCHED __builtin_amdgcn_sched_barrier(0)
    Unit cur, nxt; int ui = 0;
    if (!S.next(0, cur)) return;
    f32x4 acc[2][2][4][2];
#pragma unroll
    for (int a = 0; a < 2; ++a)
#pragma unroll
        for (int b = 0; b < 2; ++b)
#pragma unroll
            for (int m = 0; m < 4; ++m)
#pragma unroll
                for (int n = 0; n < 2; ++n) acc[a][b][m][n] = (f32x4){0.f, 0.f, 0.f, 0.f};
    bf16x8 At[4][2], B0[2][2], B1[2][2];
    int curpt = g.ptile(cur.pm);
    const char* cA = (const char*)g.A + (size_t)curpt * tstepA; const char* cB = (const char*)g.Bt + (size_t)cur.pn * tstepB;
    PG8_STAGE(PG8_SB(0, 0), cB, voffB); PG8_STAGE(PG8_SA(0, 0), cA, voffA); PG8_STAGE(PG8_SB(0, 1), cB + hstepB, voffB); PG8_STAGE(PG8_SA(0, 1), cA + hstepA, voffA);
    if (wr == 1) PG8_BAR;
    PG8_WAIT_V(4); PG8_BAR;
    PG8_STAGE(PG8_SB(1, 0), cB + kstep, voffB); PG8_STAGE(PG8_SA(1, 0), cA + kstep, voffA); PG8_STAGE(PG8_SB(1, 1), cB + hstepB + kstep, voffB);
    PG8_WAIT_V(6); PG8_BAR;
    for (;;) {
        const bool has_next = S.next(ui + 1, nxt);
        const int nxtpt = has_next ? g.ptile(nxt.pm) : curpt;
        const char* nA = has_next ? (const char*)g.A + (size_t)nxtpt * tstepA : cA; const char* nB = has_next ? (const char*)g.Bt + (size_t)nxt.pn * tstepB : cB;
#pragma unroll 1
        for (int t = 0; t < nt; t += 2) {
            const bool last = (t == nt - 2);
            const char* a1 = cA + (size_t)(t + 1) * kstep;
            const char* a2 = last ? nA : cA + (size_t)(t + 2) * kstep; const char* b2 = last ? nB : cB + (size_t)(t + 2) * kstep;
            const char* a3 = a2 + kstep; const char* b3 = b2 + kstep;
            PG8_LDB(B0, 0, 0); PG8_SCHED; PG8_LDA(At, 0, 0); PG8_STAGE(PG8_SA(1, 1), a1 + hstepA, voffA);
            PG8_WAIT_L(8); PG8_BAR; PG8_WAIT_L(0); PG8_MMA(0, 0, At, B0); PG8_BAR; PG8_SCHED;
            PG8_LDB(B1, 0, 1); PG8_STAGE(PG8_SB(0, 0), b2, voffB);
            PG8_BAR; PG8_WAIT_L(0); PG8_MMA(0, 1, At, B1); PG8_BAR;
            PG8_LDA(At, 0, 1); PG8_STAGE(PG8_SA(0, 0), a2, voffA);
            PG8_BAR; PG8_WAIT_L(0); PG8_MMA(1, 0, At, B0); PG8_BAR; PG8_SCHED;
            PG8_STAGE(PG8_SB(0, 1), b2 + hstepB, voffB);
            PG8_WAIT_V(6); PG8_BAR; PG8_MMA(1, 1, At, B1); PG8_BAR;
            PG8_LDB(B0, 1, 0); PG8_SCHED; PG8_LDA(At, 1, 0); PG8_STAGE(PG8_SA(0, 1), a2 + hstepA, voffA);
            PG8_WAIT_L(8); PG8_BAR; PG8_WAIT_L(0); PG8_MMA(0, 0, At, B0); PG8_BAR; PG8_SCHED;
            PG8_LDB(B1, 1, 1); PG8_STAGE(PG8_SB(1, 0), b3, voffB);
            PG8_BAR; PG8_WAIT_L(0); PG8_MMA(0, 1, At, B1); PG8_BAR;
            PG8_LDA(At, 1, 1); PG8_STAGE(PG8_SA(1, 0), a3, voffA);
            PG8_BAR; PG8_WAIT_L(0); PG8_MMA(1, 0, At, B0); PG8_BAR; PG8_SCHED;
            PG8_STAGE(PG8_SB(1, 1), b3 + hstepB, voffB);
            PG8_WAIT_V(6); PG8_BAR; PG8_MMA(1, 1, At, B1); PG8_BAR;
        }
        E(acc, cur.pn, curpt, wr, wc, fr, fq);
        if (!has_next) break;
#pragma unroll
        for (int a = 0; a < 2; ++a)
#pragma unroll
            for (int b = 0; b < 2; ++b)
#pragma unroll
                for (int m = 0; m < 4; ++m)
#pragma unroll
                    for (int n = 0; n < 2; ++n) acc[a][b][m][n] = (f32x4){0.f, 0.f, 0.f, 0.f};
        cur = nxt; cA = nA; cB = nB; curpt = nxtpt; ++ui;
    }
    PG8_WAIT_V(0);
    if (wr == 0) PG8_BAR;
    PG8_BAR;
#undef PG8_SA
#undef PG8_SB
#undef PG8_STAGE
#undef PG8_LDA
#undef PG8_LDB
#undef PG8_MMA
#undef PG8_WAIT_V
#undef PG8_WAIT_L
#undef PG8_BAR
#undef PG8_SCHED
}
}

typedef const f32x4 (&AccRef)[2][2][4][2];
__device__ __forceinline__ u32x4 pack8(const f32x4 a, const f32x4 b) { u32x4 w; w.x = cvt_pk_bf16(a[0], a[1]); w.y = cvt_pk_bf16(a[2], a[3]); w.z = cvt_pk_bf16(b[0], b[1]); w.w = cvt_pk_bf16(b[2], b[3]); return w; }
__device__ __forceinline__ void unpack8(const u32x4 w, f32x4& a, f32x4& b) { a = (f32x4){bflo(w.x), bfhi(w.x), bflo(w.y), bfhi(w.y)}; b = (f32x4){bflo(w.z), bfhi(w.z), bflo(w.w), bfhi(w.w)}; }
__device__ __forceinline__ f32x4 silu4(f32x4 v) { return (f32x4){fsilu(v[0]), fsilu(v[1]), fsilu(v[2]), fsilu(v[3])}; }
__device__ __forceinline__ f32x4 sigm4(f32x4 v) { return (f32x4){fsigmoid(v[0]), fsigmoid(v[1]), fsigmoid(v[2]), fsigmoid(v[3])}; }

struct EpiEvIn {
    bf16_t* EV; float* gates; const float* gate_b;
    __device__ __forceinline__ void operator()(AccRef acc, int pn, int pt, int wr, int wc, int fr, int fq) const {
        const int row0 = pt * 256 + wr * 64 + fr, cl = wc * 32 + 8 * fq;
        if (pn < 24) {
            const int kind = pn >> 3, col = kind * 1024 + (pn & 7) * 128 + cl;
#pragma unroll
            for (int ai = 0; ai < 2; ++ai)
#pragma unroll
                for (int m = 0; m < 4; ++m) {
                    const f32x4 x0 = acc[ai][0][m][0], x1 = acc[ai][0][m][1], y0 = acc[ai][1][m][0], y1 = acc[ai][1][m][1];
                    f32x4 r0, r1;
                    if (kind == 0) { r0 = x0 * silu4(y0); r1 = x1 * silu4(y1); }
                    else if (kind == 1) { r0 = sigm4(x0) * silu4(y0); r1 = sigm4(x1) * silu4(y1); }
                    else { r0 = x0 * y0; r1 = x1 * y1; }
                    *(u32x4*)(EV + (size_t)(row0 + ai * 128 + m * 16) * EV_LD + col) = pack8(r0, r1);
                    asm volatile("" ::: "memory");
                }
        } else if (pn < 36) {
            const int col = 3072 + (pn - 24) * 256 + cl;
#pragma unroll
            for (int ai = 0; ai < 2; ++ai)
#pragma unroll
                for (int m = 0; m < 4; ++m)
#pragma unroll
                    for (int bj = 0; bj < 2; ++bj)
                        *(u32x4*)(EV + (size_t)(row0 + ai * 128 + m * 16) * EV_LD + col + bj * 128) = pack8(acc[ai][bj][m][0], acc[ai][bj][m][1]);
        } else {
            if (wc == 0 && fq < 2) {
                const f32x4 b0 = *(const f32x4*)(gate_b + 8 * fq), b1 = *(const f32x4*)(gate_b + 8 * fq + 4);
#pragma unroll
                for (int ai = 0; ai < 2; ++ai)
#pragma unroll
                    for (int m = 0; m < 4; ++m) {
                        float* gp = gates + (size_t)(row0 + ai * 128 + m * 16) * 16 + 8 * fq;
                        *(f32x4*)gp = acc[ai][0][m][0] + b0; *(f32x4*)(gp + 4) = acc[ai][0][m][1] + b1;
                    }
            }
        }
    }
};
struct EpiOdIn {
    bf16_t* OD;
    __device__ __forceinline__ void operator()(AccRef acc, int pn, int pt, int wr, int wc, int fr, int fq) const {
        const int row0 = pt * 256 + wr * 64 + fr, col = pn * 256 + wc * 32 + 8 * fq;
#pragma unroll
        for (int ai = 0; ai < 2; ++ai)
#pragma unroll
            for (int m = 0; m < 4; ++m)
#pragma unroll
                for (int bj = 0; bj < 2; ++bj) {
                    f32x4 v0 = acc[ai][bj][m][0], v1 = acc[ai][bj][m][1];
                    if (pn < 8) { v0 = silu4(v0); v1 = silu4(v1); }
                    *(u32x4*)(OD + (size_t)(row0 + ai * 128 + m * 16) * OD_LD + col + bj * 128) = pack8(v0, v1);
                }
    }
};
struct EpiUq {
    bf16_t* Q; const float* rowsc; const float* cosT; const float* sinT; int grp;
    __device__ __forceinline__ void operator()(AccRef acc, int pn, int pt, int wr, int wc, int fr, int fq) const {
        const int lt = pt - grp * GT, bl = lt / 9, s0 = (lt % 9) * 256 + wr * 64 + fr, row0 = pt * 256 + wr * 64 + fr;
        float sc[8];
#pragma unroll
        for (int i = 0; i < 8; ++i) sc[i] = rowsc[(size_t)(row0 + (i >> 2) * 128 + (i & 3) * 16) * 2];
        if (pn < 8) {
#pragma unroll
            for (int ai = 0; ai < 2; ++ai)
#pragma unroll
                for (int m = 0; m < 4; ++m) {
                    const int ro = ai * 128 + m * 16; const float scq = sc[ai * 4 + m] * QSCALE;
#pragma unroll
                    for (int bj = 0; bj < 2; ++bj) {
                        const int head = 2 * pn + bj;
                        *(u32x4*)(Q + ((size_t)(bl * 16 + head) * SB + s0 + ro) * 192 + wc * 32 + 8 * fq) = pack8(acc[ai][bj][m][0] * scq, acc[ai][bj][m][1] * scq);
                    }
                }
        } else {
            const int head = 4 * (pn - 8) + wc, i0 = 8 * fq; const bool lat = (lt % 9) != 0;
#pragma unroll
            for (int ai = 0; ai < 2; ++ai) {
                f32x4 c0[4], c1[4], n0[4], n1[4];
#pragma unroll
                for (int m = 0; m < 4; ++m) {
                    c0[m] = (f32x4){1.f, 1.f, 1.f, 1.f}; c1[m] = c0[m]; n0[m] = (f32x4){0.f, 0.f, 0.f, 0.f}; n1[m] = n0[m];
                    if (lat) { const int pos = s0 + ai * 128 + m * 16 - CTXL; c0[m] = *(const f32x4*)(cosT + pos * 32 + i0); c1[m] = *(const f32x4*)(cosT + pos * 32 + i0 + 4);
                        n0[m] = *(const f32x4*)(sinT + pos * 32 + i0); n1[m] = *(const f32x4*)(sinT + pos * 32 + i0 + 4); }
                }
#pragma unroll
                for (int m = 0; m < 4; ++m) {
                    const int s = s0 + ai * 128 + m * 16; const float scq = sc[ai * 4 + m] * QSCALE;
                    const f32x4 xa0 = acc[ai][0][m][0], xa1 = acc[ai][0][m][1], xb0 = acc[ai][1][m][0], xb1 = acc[ai][1][m][1];
                    bf16_t* qp = Q + ((size_t)(bl * 16 + head) * SB + s) * 192 + 128 + i0;
                    *(u32x4*)qp = pack8((xa0 * c0[m] - xb0 * n0[m]) * scq, (xa1 * c1[m] - xb1 * n1[m]) * scq);
                    *(u32x4*)(qp + 32) = pack8((xa0 * n0[m] + xb0 * c0[m]) * scq, (xa1 * n1[m] + xb1 * c1[m]) * scq);
                }
                asm volatile("" ::: "memory");
            }
        }
    }
};
struct EpiUkv {
    bf16_t* Kb; bf16_t* Vb; const float* rowsc; const bf16_t* KR; int grp;
    __device__ __forceinline__ void operator()(AccRef acc, int pn, int pt, int wr, int wc, int fr, int fq) const {
        const int lt = pt - grp * GT, bl = lt / 9, s0 = (lt % 9) * 256 + wr * 64 + fr, row0 = pt * 256 + wr * 64 + fr, head = pn;
        const int c8 = ((wc & 1) * 4 + fq) * 8;
        float sc[8]; u32x4 kr[8];
#pragma unroll
        for (int i = 0; i < 8; ++i) { const int ro = (i >> 2) * 128 + (i & 3) * 16; sc[i] = rowsc[(size_t)(row0 + ro) * 2 + 1];
            kr[i] = (wc < 2) ? *(const u32x4*)(KR + (size_t)(row0 + ro) * 64 + c8) : (u32x4){0u, 0u, 0u, 0u}; }
#pragma unroll
        for (int ai = 0; ai < 2; ++ai)
#pragma unroll
            for (int m = 0; m < 4; ++m) {
                const int ro = ai * 128 + m * 16; const float scv = sc[ai * 4 + m];
                const size_t kv = (size_t)(bl * 16 + head) * SB + s0 + ro;
                *(u32x4*)(Kb + kv * 192 + wc * 32 + 8 * fq) = pack8(acc[ai][0][m][0] * scv, acc[ai][0][m][1] * scv);
                *(u32x4*)(Vb + kv * 128 + wc * 32 + 8 * fq) = pack8(acc[ai][1][m][0] * scv, acc[ai][1][m][1] * scv);
                if (wc < 2) *(u32x4*)(Kb + kv * 192 + 128 + c8) = kr[ai * 4 + m];
            }
    }
};
struct EpiOut {
    bf16_t* H; const float* modv  ;
    __device__ __forceinline__ void operator()(AccRef acc, int pn, int pt, int wr, int wc, int fr, int fq) const {
        const int row0 = pt * 256 + wr * 64 + fr, midx = (pt % 9 == 0) ? 32 : pt / 9;
        const float* gv = modv + (size_t)midx * 3072 + 2048;
#pragma unroll
        for (int bj = 0; bj < 2; ++bj) {
            const int col = pn * 256 + bj * 128 + wc * 32 + 8 * fq;
            const f32x4 g0 = *(const f32x4*)(gv + col), g1 = *(const f32x4*)(gv + col + 4);
            u32x4 hw[8];
#pragma unroll
            for (int i = 0; i < 8; ++i) hw[i] = *(const u32x4*)(H + (size_t)(row0 + (i >> 2) * 128 + (i & 3) * 16) * DM + col);
#pragma unroll
            for (int i = 0; i < 8; ++i) { const int ai = i >> 2, m = i & 3;
                f32x4 h0, h1; unpack8(hw[i], h0, h1);
                *(u32x4*)(H + (size_t)(row0 + ai * 128 + m * 16) * DM + col) = pack8(h0 * ALPHA + g0 * acc[ai][bj][m][0], h1 * ALPHA + g1 * acc[ai][bj][m][1]); }
            asm volatile("" ::: "memory");
        }
    }
};

namespace att {
typedef short s16x4 __attribute__((ext_vector_type(4)));
typedef float f32x16 __attribute__((ext_vector_type(16)));
constexpr int SHM_V = 16384, SHM_KN = 16384, SHM_KR = 8192, OFF_V = 0, OFF_KN = 32768, OFF_KR = 65536, OFF_WS = 81920;
constexpr float THR2 = 11.5f;
#define KSWZ(row, colB) ((row) * 256 + ((colB) ^ (((row) & 7) << 4)))
#define KSWZ2(row, colB) ((row) * 128 + ((colB) ^ ((((row) >> 1) & 7) << 4)))
#define SBAR() __builtin_amdgcn_sched_barrier(0)
__device__ __forceinline__ int crow(int r, int hi) { return (r & 3) + 8 * (r >> 2) + 4 * hi; }
__device__ __forceinline__ void partialSM(f32x16& p0, f32x16& p1, float& m_reg, float& mn, float& alpha) {
  float pmax = p0[0];
#pragma unroll
  for (int r = 1; r < 16; ++r) pmax = fmaxf(pmax, p0[r]);
#pragma unroll
  for (int r = 0; r < 16; ++r) pmax = fmaxf(pmax, p1[r]);
  { auto rr = __builtin_amdgcn_permlane32_swap(__float_as_uint(pmax), __float_as_uint(pmax), false, false);
    pmax = fmaxf(__uint_as_float(rr[0]), __uint_as_float(rr[1])); }
  if (__builtin_expect(__all(pmax - m_reg <= THR2), 1)) { mn = m_reg; alpha = 1.f; }
  else { mn = fmaxf(m_reg, pmax); alpha = __builtin_amdgcn_exp2f(m_reg - mn); m_reg = mn; }
#pragma unroll
  for (int r = 0; r < 16; ++r) p0[r] = p0[r] - mn;
#pragma unroll
  for (int r = 0; r < 16; ++r) p1[r] = p1[r] - mn;
#pragma unroll
  for (int r = 0; r < 16; ++r) p0[r] = __builtin_amdgcn_exp2f(p0[r]);
}
__device__ __forceinline__ void finishSM(f32x16& p0, f32x16& p1, float alpha, float& l_reg, bf16x8& pa0, bf16x8& pa1, bf16x8& pa2, bf16x8& pa3) {
#pragma unroll
  for (int r = 0; r < 16; ++r) p1[r] = __builtin_amdgcn_exp2f(p1[r]);
  float ps = 0;
#pragma unroll
  for (int r = 0; r < 16; ++r) ps += p0[r];
#pragma unroll
  for (int r = 0; r < 16; ++r) ps += p1[r];
  { auto rr = __builtin_amdgcn_permlane32_swap(__float_as_uint(ps), __float_as_uint(ps), false, false);
    ps = __uint_as_float(rr[0]) + __uint_as_float(rr[1]); }
  l_reg = l_reg * alpha + ps;
#define PK4(P, BASE, OUT) do { unsigned a0 = cvt_pk_bf16(P[BASE + 0], P[BASE + 1]), a1 = cvt_pk_bf16(P[BASE + 2], P[BASE + 3]);   \
    unsigned b0 = cvt_pk_bf16(P[BASE + 4], P[BASE + 5]), b1 = cvt_pk_bf16(P[BASE + 6], P[BASE + 7]);                              \
    auto r0 = __builtin_amdgcn_permlane32_swap(a0, b0, false, false); auto r1 = __builtin_amdgcn_permlane32_swap(a1, b1, false, false); \
    u32x4 w = {r0[0], r1[0], r0[1], r1[1]}; OUT = *reinterpret_cast<bf16x8*>(&w); } while (0)
  PK4(p0, 0, pa0); PK4(p0, 8, pa1); PK4(p1, 0, pa2); PK4(p1, 8, pa3);
#undef PK4
}
__device__ __forceinline__ void qkt(f32x16& p0, f32x16& p1, unsigned kn, unsigned kr, unsigned qrp, const bf16x8 (&qr)[12], int r32, int hi) {
  p0 = f32x16{}; p1 = f32x16{};
  unsigned hb = (unsigned)hi * 16u; asm volatile("" : "+v"(hb));
  const unsigned swn = ((unsigned)r32 & 7u) << 4, swr = (((unsigned)r32 >> 1) & 7u) << 4, an = kn + (unsigned)r32 * 256u, ar = kr + (unsigned)r32 * 128u;
#pragma unroll
  for (int d0 = 0; d0 < 8; ++d0) { const unsigned ad = an + (((unsigned)d0 * 32u + hb) ^ swn);
    const bf16x8 b0 = *(const LAS bf16x8*)(uintptr_t)ad;
    const bf16x8 b1 = *(const LAS bf16x8*)(uintptr_t)(ad + 8192u);
    p0 = __builtin_amdgcn_mfma_f32_32x32x16_bf16(b0, qr[d0], p0, 0, 0, 0);
    p1 = __builtin_amdgcn_mfma_f32_32x32x16_bf16(b1, qr[d0], p1, 0, 0, 0); }
#pragma unroll
  for (int d0 = 0; d0 < 4; ++d0) { const unsigned ad = ar + (((unsigned)d0 * 32u + hb) ^ swr);
    const bf16x8 b0 = *(const LAS bf16x8*)(uintptr_t)ad;
    const bf16x8 b1 = *(const LAS bf16x8*)(uintptr_t)(ad + 4096u);
    p0 = __builtin_amdgcn_mfma_f32_32x32x16_bf16(b0, qr[8 + d0], p0, 0, 0, 0);
    p1 = __builtin_amdgcn_mfma_f32_32x32x16_bf16(b1, qr[8 + d0], p1, 0, 0, 0); }
  (void)qrp;
}
__device__ __forceinline__ int v_st(int k, int c) { const int kk = (k & ~0xC) | ((k & 4) << 1) | ((k & 8) >> 1); return ((kk >> 3) * 4 + (c >> 5)) * 512 + ((kk & 7) * 32 + (c & 31)) * 2; }
__device__ __forceinline__ int v_rd_base(int lane) { return ((lane & 3) << 3) | (((lane >> 2) & 3) << 6) | (((lane >> 4) & 1) << 5) | (((lane >> 5) & 1) << 8); }
constexpr int v_rd_off(int d0, int ks, int half) { return d0 * 512 + ks * 4096 + half * 2048; }
template <int OFF> __device__ __forceinline__ s16x4 tr_read(int vb) {
  s16x4 r; asm volatile("ds_read_b64_tr_b16 %0, %1 offset:%2" : "=&v"(r) : "v"(vb), "i"(OFF) : "memory"); return r;
}
template <int D0> __device__ __forceinline__ void pv_one(f32x16& od, int vb, bf16x8 pa0, bf16x8 pa1, bf16x8 pa2, bf16x8 pa3) {
  const s16x4 l0 = tr_read<v_rd_off(D0, 0, 0)>(vb), h0 = tr_read<v_rd_off(D0, 0, 1)>(vb), l1 = tr_read<v_rd_off(D0, 1, 0)>(vb), h1 = tr_read<v_rd_off(D0, 1, 1)>(vb);
  const s16x4 l2 = tr_read<v_rd_off(D0, 2, 0)>(vb), h2 = tr_read<v_rd_off(D0, 2, 1)>(vb), l3 = tr_read<v_rd_off(D0, 3, 0)>(vb), h3 = tr_read<v_rd_off(D0, 3, 1)>(vb);
  asm volatile("s_waitcnt lgkmcnt(0)" ::: "memory"); SBAR();
#define PK(L, H) (bf16x8){L[0], L[1], L[2], L[3], H[0], H[1], H[2], H[3]}
  od = __builtin_amdgcn_mfma_f32_32x32x16_bf16(pa0, PK(l0, h0), od, 0, 0, 0);
  od = __builtin_amdgcn_mfma_f32_32x32x16_bf16(pa1, PK(l1, h1), od, 0, 0, 0);
  od = __builtin_amdgcn_mfma_f32_32x32x16_bf16(pa2, PK(l2, h2), od, 0, 0, 0);
  od = __builtin_amdgcn_mfma_f32_32x32x16_bf16(pa3, PK(l3, h3), od, 0, 0, 0);
#undef PK
}
__device__ __forceinline__ void pv_d0(f32x16* o, int vb, bf16x8 pa0, bf16x8 pa1, bf16x8 pa2, bf16x8 pa3) {
  pv_one<0>(o[0], vb, pa0, pa1, pa2, pa3); pv_one<1>(o[1], vb, pa0, pa1, pa2, pa3); pv_one<2>(o[2], vb, pa0, pa1, pa2, pa3); pv_one<3>(o[3], vb, pa0, pa1, pa2, pa3);
}
constexpr int BUFB = 40960, OFF_RV = 0, OFF_RKN = 16384, OFF_RKR = 32768, OFF_RWS = 3 * BUFB, OFF_QR = OFF_RWS + 2048  ;
__device__ __forceinline__ void attn_unit(const bf16_t* __restrict__ Qb, const bf16_t* __restrict__ Kh, const bf16_t* __restrict__ Vh, bf16_t* Zp, int seq, LAS unsigned char* lds, int tid_in) {
  int tid = tid_in; asm volatile("" : "+v"(tid));
  const int wid = __builtin_amdgcn_readfirstlane(tid >> 6), lane = tid & 63, r32 = lane & 31, hi = lane >> 5;
  LAS float* wsl = (LAS float*)(lds + OFF_RWS) + wid * 64; LAS float* li_l = wsl; LAS float* al_l = wsl + 32;
  float m_reg = -1e30f, l_reg = 0; f32x16 o[4] = {}; bf16x8 qr[12];
  const bf16_t* Qw = Qb + (size_t)(wid * 32 + r32) * 192 + hi * 8;
#pragma unroll
  for (int d0 = 0; d0 < 12; ++d0) qr[d0] = *(const bf16x8*)(Qw + d0 * 16);
  const unsigned ldsb = (unsigned)(uintptr_t)lds, qrp = ldsb + (unsigned)(OFF_QR + wid * 4096);
  unsigned sov[2], sok[2], sor;
#pragma unroll
  for (int i = 0; i < 2; ++i) {
    { const int c = 2 * wid + i, sub = 2 * c + (lane >> 5), kk = (sub >> 2) * 8 + ((lane & 31) >> 2), k = (kk & ~0xC) | ((kk & 4) << 1) | ((kk & 8) >> 1), col = (sub & 3) * 32 + (lane & 3) * 8;
      sov[i] = (unsigned)(k * 128 + col) * 2u; }
    { const int c = 2 * wid + i, row = 4 * c + (lane >> 4), u = (lane & 15) ^ (row & 7); sok[i] = (unsigned)(row * 384 + u * 16); }
  }
  { const int row = 8 * wid + (lane >> 3), u = (lane & 7) ^ ((row >> 1) & 7); sor = (unsigned)(row * 384 + 256 + u * 16); }
#define DMA(j) do { const int b_ = (j) % 3; const char* vt_ = (const char*)Vh + (size_t)(j) * (64 * 128 * 2); const char* kt_ = (const char*)Kh + (size_t)(j) * (64 * 192 * 2); \
    __builtin_amdgcn_global_load_lds((const unsigned*)(vt_ + sov[0]), (LAS unsigned*)(lds + b_ * BUFB + OFF_RV + (2 * wid) * 1024), 16, 0, 0); \
    __builtin_amdgcn_global_load_lds((const unsigned*)(vt_ + sov[1]), (LAS unsigned*)(lds + b_ * BUFB + OFF_RV + (2 * wid + 1) * 1024), 16, 0, 0); \
    __builtin_amdgcn_global_load_lds((const unsigned*)(kt_ + sok[0]), (LAS unsigned*)(lds + b_ * BUFB + OFF_RKN + (2 * wid) * 1024), 16, 0, 0); \
    __builtin_amdgcn_global_load_lds((const unsigned*)(kt_ + sok[1]), (LAS unsigned*)(lds + b_ * BUFB + OFF_RKN + (2 * wid + 1) * 1024), 16, 0, 0); \
    __builtin_amdgcn_global_load_lds((const unsigned*)(kt_ + sor), (LAS unsigned*)(lds + b_ * BUFB + OFF_RKR + wid * 1024), 16, 0, 0); } while (0)
#define VMW(n) asm volatile("s_waitcnt vmcnt(" #n ")" ::: "memory")
#define BAR() do { asm volatile("" ::: "memory"); __builtin_amdgcn_s_barrier(); asm volatile("" ::: "memory"); } while (0)
#define RESC(a) do { if (__any((a) < 1.f)) { if (hi == 0) al_l[r32] = (a); asm volatile("s_waitcnt lgkmcnt(0)" ::: "memory"); \
    _Pragma("unroll") for (int d = 0; d < 4; ++d) _Pragma("unroll") for (int r = 0; r < 16; ++r) o[d][r] *= al_l[crow(r, hi)]; } } while (0)
#define KN(j) (ldsb + (unsigned)(((j) % 3) * BUFB + OFF_RKN))
#define KRP(j) (ldsb + (unsigned)(((j) % 3) * BUFB + OFF_RKR))
#define VB(j) (vb0 + ((j) % 3) * BUFB)
  const int vb0 = (int)ldsb + OFF_RV + v_rd_base(lane);
  f32x16 pA0, pA1, pB0, pB1; float mnA, mnB, alA, alB; bf16x8 pa0, pa1, pa2, pa3; const int NT = seq / 64;
  DMA(0); DMA(1);
  VMW(5); BAR();
  qkt(pA0, pA1, KN(0), KRP(0), qrp, qr, r32, hi); partialSM(pA0, pA1, m_reg, mnA, alA);
  VMW(0); BAR();
  DMA(2);
  if (wid < 4) {
    for (int j = 1; j + 1 < NT; j += 2) {
      SBAR(); qkt(pB0, pB1, KN(j), KRP(j), qrp, qr, r32, hi);
      finishSM(pA0, pA1, alA, l_reg, pa0, pa1, pa2, pa3); SBAR();
      pv_d0(o, VB(j - 1), pa0, pa1, pa2, pa3); partialSM(pB0, pB1, m_reg, mnB, alB);
      VMW(0); BAR();
      DMA(j + 2);
      RESC(alB);
      SBAR(); qkt(pA0, pA1, KN(j + 1), KRP(j + 1), qrp, qr, r32, hi);
      finishSM(pB0, pB1, alB, l_reg, pa0, pa1, pa2, pa3); SBAR();
      pv_d0(o, VB(j), pa0, pa1, pa2, pa3); partialSM(pA0, pA1, m_reg, mnA, alA);
      VMW(0); BAR();
      if (j + 3 < NT) DMA(j + 3);
      RESC(alA);
    }
  } else {
    for (int j = 1; j + 1 < NT; j += 2) {
      SBAR(); finishSM(pA0, pA1, alA, l_reg, pa0, pa1, pa2, pa3); SBAR();
      pv_d0(o, VB(j - 1), pa0, pa1, pa2, pa3); SBAR();
      qkt(pB0, pB1, KN(j), KRP(j), qrp, qr, r32, hi); partialSM(pB0, pB1, m_reg, mnB, alB);
      VMW(0); BAR();
      DMA(j + 2);
      RESC(alB);
      SBAR(); finishSM(pB0, pB1, alB, l_reg, pa0, pa1, pa2, pa3); SBAR();
      pv_d0(o, VB(j), pa0, pa1, pa2, pa3); SBAR();
      qkt(pA0, pA1, KN(j + 1), KRP(j + 1), qrp, qr, r32, hi); partialSM(pA0, pA1, m_reg, mnA, alA);
      VMW(0); BAR();
      if (j + 3 < NT) DMA(j + 3);
      RESC(alA);
    }
  }
  SBAR(); qkt(pB0, pB1, KN(NT - 1), KRP(NT - 1), qrp, qr, r32, hi);
  finishSM(pA0, pA1, alA, l_reg, pa0, pa1, pa2, pa3); SBAR();
  pv_d0(o, VB(NT - 2), pa0, pa1, pa2, pa3); partialSM(pB0, pB1, m_reg, mnB, alB);
  RESC(alB);
  finishSM(pB0, pB1, alB, l_reg, pa0, pa1, pa2, pa3); SBAR();
  pv_d0(o, VB(NT - 1), pa0, pa1, pa2, pa3);
  if (hi == 0) li_l[r32] = l_reg; asm volatile("s_waitcnt lgkmcnt(0)" ::: "memory");
  float rli[16];
#pragma unroll
  for (int r = 0; r < 16; ++r) rli[r] = __builtin_amdgcn_rcpf(li_l[crow(r, hi)]);
  int r32e = r32, hie = hi; asm volatile("" : "+v"(r32e), "+v"(hie));
  bf16_t* Zw = Zp + (size_t)(wid * 32 + 4 * hie) * OD_LD + r32e;
#pragma unroll
  for (int r = 0; r < 16; ++r) { const int orow = (r & 3) + 8 * (r >> 2);
#pragma unroll
    for (int d0 = 0; d0 < 4; ++d0) { bf16_t* zp = Zw + (size_t)orow * OD_LD + d0 * 32; *zp = f2bf(o[d0][r] * rli[r] * bf1(*zp)); } }
  VMW(0); BAR();
#undef DMA
#undef VMW
#undef BAR
#undef RESC
#undef KN
#undef KRP
#undef VB
}
}

namespace msc {
using att::f32x16; using att::s16x4; using att::crow; using att::v_st; using att::v_rd_base; using att::v_rd_off; using att::tr_read;
constexpr int CL = 32, NCH = SB / CL;
constexpr int BUF = 40960, O_Q = 0, O_K = 16384, O_V = 32768, O_KW = 81920, O_X = 98304, O_A = 114688, O_G = O_A + 9216, O_M = O_G + 9216, O_MP = O_M + 9216, O_N = 142848, O_QN = 144896, O_PW = 145408, O_PST = 148480, O_RS = 156672;
#define PK4(P, BASE, OUT) do { unsigned a0 = cvt_pk_bf16(P[BASE + 0], P[BASE + 1]), a1 = cvt_pk_bf16(P[BASE + 2], P[BASE + 3]);   \
    unsigned b0 = cvt_pk_bf16(P[BASE + 4], P[BASE + 5]), b1 = cvt_pk_bf16(P[BASE + 6], P[BASE + 7]);                              \
    auto r0 = __builtin_amdgcn_permlane32_swap(a0, b0, false, false); auto r1 = __builtin_amdgcn_permlane32_swap(a1, b1, false, false); \
    u32x4 w = {r0[0], r1[0], r0[1], r1[1]}; OUT = *reinterpret_cast<bf16x8*>(&w); } while (0)
#define PKLH(L, H) (bf16x8){L[0], L[1], L[2], L[3], H[0], H[1], H[2], H[3]}
__device__ __forceinline__ void scan_item(const bf16_t* evb  , const float* gb  , bf16_t* hfb  ,
                                          int head, int dh, LAS unsigned char* lds, int wave0) {
  int tid; asm volatile("v_mbcnt_lo_u32_b32 %0, -1, 0\n\tv_mbcnt_hi_u32_b32 %0, -1, %0" : "=v"(tid)); tid += wave0 * 64;
  const int tid_o = tid; const int wid = wave0, lane = tid & 63, r32 = lane & 31, hi = lane >> 5, kh = wid >> 2, dq = wid & 3; (void)r32; (void)hi;
  const unsigned ldsb = (unsigned)(uintptr_t)lds;
  LAS float* aS = (LAS float*)(lds + O_A); LAS float* gT = (LAS float*)(lds + O_G); LAS float* mT = (LAS float*)(lds + O_M); LAS float* mP = (LAS float*)(lds + O_MP);
  LAS float* nbuf = (LAS float*)(lds + O_N); LAS float* qnS = (LAS float*)(lds + O_QN); LAS float* pw = (LAS float*)(lds + O_PW) + wid * 96;
  LAS float* xch = (LAS float*)(lds + O_X) + dq * 1024; LAS float* rsS = (LAS float*)(lds + O_RS);
#define BARX() do { asm volatile("" ::: "memory"); __builtin_amdgcn_s_barrier(); asm volatile("" ::: "memory"); } while (0)
#define LGK0() do { asm volatile("s_waitcnt lgkmcnt(0)" ::: "memory"); __builtin_amdgcn_sched_barrier(0); } while (0)
  for (int dir = 0; dir < 2; ++dir) {
    asm volatile("s_waitcnt vmcnt(0) lgkmcnt(0)" ::: "memory"); BARX();
    {
      LAS float* rawI = (LAS float*)lds; LAS float* rawF = rawI + SB;
      for (int jx = tid; jx < SB; jx += 512) {
        const int srow = dir == 0 ? jx : (jx < CTXL ? CTXL - 1 - jx : SB - 1 - (jx - CTXL));
        const float* gr = gb + (size_t)srow * 16 + dir * 8;
        const float ip = gr[head], fp = gr[4 + head];
        rawI[jx] = ip; rawF[jx] = fminf(fp, 0.f) - __logf(1.0f + __expf(-fabsf(fp)));
      }
      if (tid < 256) { nbuf[tid] = 0.f; nbuf[256 + tid] = 0.f; }
      LGK0(); BARX();
      if (wid == 0) {
        float mprev = -1e30f; const int l5 = lane & 31;
        for (int c = 0; c < NCH; ++c) {
          const float ip = rawI[c * CL + l5]; float bsum = rawF[c * CL + l5];
#pragma unroll
          for (int o = 1; o < 32; o <<= 1) { const float t = __shfl_up(bsum, o, 32); if (l5 >= o) bsum += t; }
          const float a = ip - bsum; float cm = a;
#pragma unroll
          for (int o = 1; o < 32; o <<= 1) { const float t = __shfl_up(cm, o, 32); if (l5 >= o) cm = fmaxf(cm, t); }
          const float g = fmaxf(mprev, cm), m = bsum + g;
          if (lane < 32) { aS[c * CL + l5] = a; gT[c * CL + l5] = g; mT[c * CL + l5] = m; }
          if (lane == 0) mP[c] = mprev;
          mprev = __shfl(m, 31, 32);
        }
      }
      LGK0(); BARX();
    }
    unsigned soq[2], sov;
#pragma unroll
    for (int i = 0; i < 2; ++i) { const int c2 = 2 * wid + i, t = 2 * c2 + (lane >> 5), u = (lane & 31) ^ (t & 15), ro = dir ? 31 - t : t; soq[i] = (unsigned)(ro * EV_LD * 2 + u * 16); }
    { const int sub = 2 * wid + (lane >> 5), kk = (sub >> 2) * 8 + ((lane & 31) >> 2), s_ = (kk & ~0xC) | ((kk & 4) << 1) | ((kk & 8) >> 1), col = (sub & 3) * 32 + (lane & 3) * 8, ro = dir ? 31 - s_ : s_;
      sov = (unsigned)(ro * EV_LD * 2 + col * 2); }
#define SLO(c) (dir == 0 ? (c) * CL : ((c) * CL < CTXL ? CTXL - CL - (c) * CL : SB - CL - ((c) * CL - CTXL)))
#define DMA(c) do { const int b_ = (c) & 1; const char* rb_ = (const char*)(evb + (size_t)SLO(c) * EV_LD); \
    const char* qb_ = rb_ + (3072 + head * 256) * 2; const char* kb_ = rb_ + (4096 + head * 256) * 2; const char* vb_ = rb_ + (5120 + head * 256 + dh * 128) * 2; \
    __builtin_amdgcn_global_load_lds((const unsigned*)(qb_ + soq[0]), (LAS unsigned*)(lds + b_ * BUF + O_Q + (2 * wid) * 1024), 16, 0, 0); \
    __builtin_amdgcn_global_load_lds((const unsigned*)(qb_ + soq[1]), (LAS unsigned*)(lds + b_ * BUF + O_Q + (2 * wid + 1) * 1024), 16, 0, 0); \
    __builtin_amdgcn_global_load_lds((const unsigned*)(kb_ + soq[0]), (LAS unsigned*)(lds + b_ * BUF + O_K + (2 * wid) * 1024), 16, 0, 0); \
    __builtin_amdgcn_global_load_lds((const unsigned*)(kb_ + soq[1]), (LAS unsigned*)(lds + b_ * BUF + O_K + (2 * wid + 1) * 1024), 16, 0, 0); \
    __builtin_amdgcn_global_load_lds((const unsigned*)(vb_ + sov), (LAS unsigned*)(lds + b_ * BUF + O_V + wid * 1024), 16, 0, 0); } while (0)
    f32x16 C[4] = {};
    float nv[4] = {0.f, 0.f, 0.f, 0.f};
    const bf16x8 ones8 = {0x3F80, 0x3F80, 0x3F80, 0x3F80, 0x3F80, 0x3F80, 0x3F80, 0x3F80};
    DMA(0); DMA(1);
    asm volatile("s_waitcnt vmcnt(5)" ::: "memory"); BARX();
    for (int c = 0; c < NCH; ++c) {
      int tid = tid_o; asm volatile("" : "+v"(tid));
      const int lane = tid & 63, r32 = lane & 31, hi = lane >> 5, dcol = head * 256 + dh * 128 + dq * 32 + r32;
      const unsigned tb = ldsb + (unsigned)((c & 1) * BUF);
      const float mprev = mP[c], glast = gT[c * CL + CL - 1];
      const float decay = __expf(mprev - glast);
      const unsigned rb = (unsigned)r32 * 512u, sw = ((unsigned)r32 & 15u) << 4; unsigned hb = (unsigned)hi * 16u; asm volatile("" : "+v"(hb));
      const int slo = SLO(c);
      bf16_t pf_h[16], pf_o[16];
      if (kh == 1) {
        f32x16 pe = {}, po = {};
#pragma unroll
        for (int kk = 0; kk < 16; kk += 2) { const unsigned ad0 = tb + rb + (((unsigned)kk * 32u + hb) ^ sw), ad1 = tb + rb + (((unsigned)(kk + 1) * 32u + hb) ^ sw);
          const bf16x8 kf0 = *(const LAS bf16x8*)(uintptr_t)(ad0 + O_K), qf0 = *(const LAS bf16x8*)(uintptr_t)(ad0 + O_Q);
          const bf16x8 kf1 = *(const LAS bf16x8*)(uintptr_t)(ad1 + O_K), qf1 = *(const LAS bf16x8*)(uintptr_t)(ad1 + O_Q);
          pe = __builtin_amdgcn_mfma_f32_32x32x16_bf16(kf0, qf0, pe, 0, 0, 0);
          po = __builtin_amdgcn_mfma_f32_32x32x16_bf16(kf1, qf1, po, 0, 0, 0); }
        f32x16 p = pe + po;
        const float gt = gT[c * CL + r32]; float rowsum = 0.f;
#pragma unroll
        for (int r4 = 0; r4 < 4; ++r4) { const f32x4 a4 = *(const LAS f32x4*)(aS + c * CL + 8 * r4 + 4 * hi);
#pragma unroll
          for (int e = 0; e < 4; ++e) { const int sidx = 8 * r4 + 4 * hi + e; const float w = (sidx <= r32) ? __expf(a4[e] - gt) : 0.f; p[4 * r4 + e] *= w; rowsum += p[4 * r4 + e]; } }
        { auto rr = __builtin_amdgcn_permlane32_swap(__float_as_uint(rowsum), __float_as_uint(rowsum), false, false); rowsum = __uint_as_float(rr[0]) + __uint_as_float(rr[1]); }
        bf16x8 pa0, pa1; PK4(p, 0, pa0); PK4(p, 8, pa1);
        *(LAS bf16x8*)(lds + O_PST + (dq * 2 + 0) * 1024 + lane * 16) = pa0; *(LAS bf16x8*)(lds + O_PST + (dq * 2 + 1) * 1024 + lane * 16) = pa1;
        if (hi == 0) rsS[dq * 32 + r32] = rowsum;
      } else {
        if (dir == 1) {
          const char* hb_ = (const char*)(hfb + (size_t)slo * DM); const char* ob_ = (const char*)(evb + (size_t)slo * EV_LD + 1024);
          const unsigned ho = (unsigned)((31 - 4 * hi) * DM + dcol) * 2u, oo = (unsigned)((31 - 4 * hi) * EV_LD + dcol) * 2u;
#pragma unroll
          for (int r = 0; r < 16; ++r) { const int tc = (r & 3) + 8 * (r >> 2);
            pf_h[r] = *(const bf16_t*)(hb_ + (ho - (unsigned)(tc * DM * 2))); pf_o[r] = *(const bf16_t*)(ob_ + (oo - (unsigned)(tc * EV_LD * 2))); }
        }
        { const int s_ = tid >> 3, cb = (tid & 7) * 8; const float wt = __expf(aS[c * CL + s_] - glast);
#pragma unroll
          for (int h4 = 0; h4 < 4; ++h4) { const int c8 = cb + 64 * h4; f32x4 x0, x1;
            unpack8(*(const LAS u32x4*)(uintptr_t)(tb + O_K + (unsigned)s_ * 512u + ((unsigned)(c8 * 2) ^ (((unsigned)s_ & 15u) << 4))), x0, x1);
            *(LAS u32x4*)(lds + O_KW + (c8 >> 7) * 8192 + v_st(s_, c8 & 127)) = pack8(x0 * wt, x1 * wt); } }
        { const int t_ = tid >> 3, part = tid & 7; const LAS float* nb = nbuf + (c & 1) * 256 + part * 32; float acc = 0.f;
#pragma unroll
          for (int e = 0; e < 4; ++e) { f32x4 x0, x1; unpack8(*(const LAS u32x4*)(uintptr_t)(tb + O_Q + (unsigned)t_ * 512u + ((unsigned)(part * 64 + e * 16) ^ (((unsigned)t_ & 15u) << 4))), x0, x1);
            const f32x4 n0 = *(const LAS f32x4*)(nb + e * 8), n1 = *(const LAS f32x4*)(nb + e * 8 + 4);
            acc += x0[0] * n0[0] + x0[1] * n0[1] + x0[2] * n0[2] + x0[3] * n0[3] + x1[0] * n1[0] + x1[1] * n1[1] + x1[2] * n1[2] + x1[3] * n1[3]; }
          acc += __shfl_xor(acc, 1); acc += __shfl_xor(acc, 2); acc += __shfl_xor(acc, 4);
          if (part == 0) qnS[t_] = acc; }
      }
      LGK0(); BARX();
      f32x16 aq0 = {}, aq1 = {};
#pragma unroll
      for (int j = 0; j < 8; ++j) { const unsigned ad = tb + O_Q + rb + (((unsigned)(8 * kh + j) * 32u + hb) ^ sw);
        const bf16x8 qf = *(const LAS bf16x8*)(uintptr_t)ad; bf16x8 cf;
        if ((j & 1) == 0) { PK4(C[j >> 1], 0, cf); aq0 = __builtin_amdgcn_mfma_f32_32x32x16_bf16(qf, cf, aq0, 0, 0, 0); }
        else { PK4(C[j >> 1], 8, cf); aq1 = __builtin_amdgcn_mfma_f32_32x32x16_bf16(qf, cf, aq1, 0, 0, 0); } }
      f32x16 aqc = aq0 + aq1;
      const int vbase = (int)(tb + O_V) + v_rd_base(lane) + dq * 512;
      const int kwb = (int)(ldsb + O_KW + kh * 8192) + v_rd_base(lane);
      const s16x4 vl0 = tr_read<v_rd_off(0, 0, 0)>(vbase), vh0 = tr_read<v_rd_off(0, 0, 1)>(vbase), vl1 = tr_read<v_rd_off(0, 1, 0)>(vbase), vh1 = tr_read<v_rd_off(0, 1, 1)>(vbase);
      const s16x4 a0l0 = tr_read<v_rd_off(0, 0, 0)>(kwb), a0h0 = tr_read<v_rd_off(0, 0, 1)>(kwb), a0l1 = tr_read<v_rd_off(0, 1, 0)>(kwb), a0h1 = tr_read<v_rd_off(0, 1, 1)>(kwb);
      const s16x4 a1l0 = tr_read<v_rd_off(1, 0, 0)>(kwb), a1h0 = tr_read<v_rd_off(1, 0, 1)>(kwb), a1l1 = tr_read<v_rd_off(1, 1, 0)>(kwb), a1h1 = tr_read<v_rd_off(1, 1, 1)>(kwb);
      const s16x4 a2l0 = tr_read<v_rd_off(2, 0, 0)>(kwb), a2h0 = tr_read<v_rd_off(2, 0, 1)>(kwb), a2l1 = tr_read<v_rd_off(2, 1, 0)>(kwb), a2h1 = tr_read<v_rd_off(2, 1, 1)>(kwb);
      const s16x4 a3l0 = tr_read<v_rd_off(3, 0, 0)>(kwb), a3h0 = tr_read<v_rd_off(3, 0, 1)>(kwb), a3l1 = tr_read<v_rd_off(3, 1, 0)>(kwb), a3h1 = tr_read<v_rd_off(3, 1, 1)>(kwb);
      bf16x8 pa0 = {}, pa1 = {};
      if (kh == 0) { pa0 = *(const LAS bf16x8*)(lds + O_PST + (dq * 2 + 0) * 1024 + lane * 16); pa1 = *(const LAS bf16x8*)(lds + O_PST + (dq * 2 + 1) * 1024 + lane * 16); }
      LGK0();
      const bf16x8 vf0 = PKLH(vl0, vh0), vf1 = PKLH(vl1, vh1);
      const bf16x8 kwf[4][2] = {{PKLH(a0l0, a0h0), PKLH(a0l1, a0h1)}, {PKLH(a1l0, a1h0), PKLH(a1l1, a1h1)}, {PKLH(a2l0, a2h0), PKLH(a2l1, a2h1)}, {PKLH(a3l0, a3h0), PKLH(a3l1, a3h1)}};
      f32x16 asv = {};
      if (kh == 0) {
        asv = __builtin_amdgcn_mfma_f32_32x32x16_bf16(pa0, vf0, asv, 0, 0, 0);
        asv = __builtin_amdgcn_mfma_f32_32x32x16_bf16(pa1, vf1, asv, 0, 0, 0);
        const float ai = __expf(mprev - gT[c * CL + r32]);
        pw[r32] = rsS[dq * 32 + r32] + ai * qnS[r32]; pw[32 + r32] = ai; pw[64 + r32] = __expf(-mT[c * CL + r32]);
      } else {
#pragma unroll
        for (int r = 0; r < 16; ++r) xch[r * 64 + lane] = aqc[r];
      }
#pragma unroll
      for (int i = 0; i < 4; ++i) {
#pragma unroll
        for (int r = 0; r < 16; ++r) C[i][r] *= decay;
        C[i] = __builtin_amdgcn_mfma_f32_32x32x16_bf16(kwf[i][0], vf0, C[i], 0, 0, 0);
        C[i] = __builtin_amdgcn_mfma_f32_32x32x16_bf16(kwf[i][1], vf1, C[i], 0, 0, 0);
        if (dq == 0) {
          f32x16 na = {}; na = __builtin_amdgcn_mfma_f32_32x32x16_bf16(ones8, kwf[i][0], na, 0, 0, 0); na = __builtin_amdgcn_mfma_f32_32x32x16_bf16(ones8, kwf[i][1], na, 0, 0, 0);
          nv[i] = decay * nv[i] + na[0];
          if (hi == 0) nbuf[((c + 1) & 1) * 256 + kh * 128 + i * 32 + r32] = nv[i]; }
      }
      asm volatile("s_waitcnt vmcnt(0) lgkmcnt(0)" ::: "memory"); BARX();
      if (c + 2 < NCH) DMA(c + 2);
      if (kh == 0) {
        float hvs[16];
#pragma unroll
        for (int r4 = 0; r4 < 4; ++r4) {
          const f32x4 dn = *(const LAS f32x4*)(pw + 8 * r4 + 4 * hi), ai4 = *(const LAS f32x4*)(pw + 32 + 8 * r4 + 4 * hi), em4 = *(const LAS f32x4*)(pw + 64 + 8 * r4 + 4 * hi);
#pragma unroll
          for (int e = 0; e < 4; ++e) { const int r = 4 * r4 + e;
            hvs[r] = (asv[r] + ai4[e] * (aqc[r] + xch[r * 64 + lane])) * __builtin_amdgcn_rcpf(fmaxf(fabsf(dn[e]), em4[e])); }
        }
        if (dir == 0) {
          char* hb_ = (char*)(hfb + (size_t)slo * DM); const unsigned ho = (unsigned)((4 * hi) * DM + dcol) * 2u;
#pragma unroll
          for (int r = 0; r < 16; ++r) { const int tc = (r & 3) + 8 * (r >> 2); *(bf16_t*)(hb_ + (ho + (unsigned)(tc * DM * 2))) = f2bf(hvs[r]); }
        } else {
          char* ob_ = (char*)((bf16_t*)evb + (size_t)slo * EV_LD + 1024); const unsigned oo = (unsigned)((31 - 4 * hi) * EV_LD + dcol) * 2u;
#pragma unroll
          for (int r = 0; r < 16; ++r) { const int tc = (r & 3) + 8 * (r >> 2); *(bf16_t*)(ob_ + (oo - (unsigned)(tc * EV_LD * 2))) = f2bf(bf1(pf_o[r]) * (bf1(pf_h[r]) + hvs[r])); }
        }
      }
    }
#undef DMA
#undef SLO
  }
  asm volatile("s_waitcnt vmcnt(0) lgkmcnt(0)" ::: "memory"); BARX();
#undef BARX
#undef LGK0
}
#undef PK4
#undef PKLH
}

struct Params { const float* in[18]; float* out; unsigned char* ws; };
constexpr int LDS_BYTES = 163840, LDS_CTL = 162816, MISC_OFF = LDS_CTL + 320;

template <int MID> __device__ __forceinline__ int wmap(int n) {
    if (MID == 0) {
        const int pn = n >> 8, lc = n & 255, bj = lc >> 7, c = lc & 127;
        if (pn < 8)  return (bj ? 3072 : 0) + 128 * pn + c;
        if (pn < 16) return (bj ? 8192 : 7168) + 128 * (pn - 8) + c;
        if (pn < 24) return (bj ? 2048 : 1024) + 128 * (pn - 16) + c;
        if (pn < 36) return 4096 + 256 * (pn - 24) + lc;
        return lc < 16 ? 9216 + lc : -1;
    } else if (MID == 2) {
        if (n < 2048) return 704 + n;
        return (n - 2048 < 704) ? n - 2048 : -1;
    } else if (MID == 3) {
        const int pn = n >> 8, lc = n & 255;
        if (pn < 8) return (n >> 7) * 192 + (n & 127);
        const int bj = lc >> 7, hh = (lc & 127) >> 5, i = lc & 31;
        return (4 * (pn - 8) + hh) * 192 + 128 + 32 * bj + i;
    }
    return n;
}
template <int MID> __device__ __forceinline__ void wconv_item(const float* W, int K, int NS, bf16_t* WT, int nblk, const float* kscale, LAS float* scr, int item, int lane) {
    const int kb = item / nblk, nb = item % nblk, k0 = 64 * kb, n0 = 32 * nb;
    const int src = wmap<MID>(n0 + (lane & 31));
    const float cs = (MID == 0 && src >= 5120 && src < 6144) ? 0.0625f : 1.0f;
#pragma unroll 8
    for (int i = 0; i < 32; ++i) { const int kk = 2 * i + (lane >> 5); float v = 0.f;
        if (src >= 0) { v = W[(size_t)(k0 + kk) * NS + src] * cs; if (kscale) v *= kscale[k0 + kk]; }
        scr[kk * 33 + (lane & 31)] = v; }
    LDS_WAIT(); asm volatile("" ::: "memory");
    const int c = lane & 7;
#pragma unroll
    for (int j = 0; j < 4; ++j) { const int n = (lane >> 3) + 8 * j; const LAS float* s = scr + (8 * c) * 33 + n;
        u32x4 o; o.x = cvt_pk_bf16(s[0 * 33], s[1 * 33]); o.y = cvt_pk_bf16(s[2 * 33], s[3 * 33]); o.z = cvt_pk_bf16(s[4 * 33], s[5 * 33]); o.w = cvt_pk_bf16(s[6 * 33], s[7 * 33]);
        *(u32x4*)(WT + (size_t)(n0 + n) * K + k0 + 8 * c) = o; }
    LDS_WAIT(); asm volatile("" ::: "memory");
}

constexpr int PTR_OFF = LDS_CTL + 512;
__device__ __forceinline__ const float* inp(LAS unsigned char* lds, int i) {
    unsigned off = (unsigned)(PTR_OFF + 8 * i); asm volatile("" : "+s"(off));
    volatile LAS unsigned* t = (volatile LAS unsigned*)(lds + off);
    const unsigned lo = __builtin_amdgcn_readfirstlane(t[0]), hi = __builtin_amdgcn_readfirstlane(t[1]);
    return (const float*)(((unsigned long long)hi << 32) | lo);
}
#define PH_BEGIN int tid; asm volatile("v_mbcnt_lo_u32_b32 %0, -1, 0\n\tv_mbcnt_hi_u32_b32 %0, -1, %0" : "=v"(tid)); tid += wave0 * 64; unsigned char* ws = ws0; unsigned char* dob = dob0; asm volatile("" : "+v"(tid), "+s"(ws), "+s"(dob)); \
    const int lane = tid & 63, wave = __builtin_amdgcn_readfirstlane(tid >> 6), G = gridDim.x, bx = blockIdx.x, vcu = (G % 8 == 0) ? (bx % 8) * (G / 8) + bx / 8 : bx, gw = vcu * 8 + wave, NGW = G * 8; \
    (void)lane; (void)wave; (void)gw; (void)NGW; (void)vcu; \
    bf16_t* U = (bf16_t*)(dob + DO_U); bf16_t* H = (bf16_t*)(ws + WS_H); bf16_t* BIG = (bf16_t*)(ws + WS_BIG); float* modv = (float*)(dob + DO_MODV); \
    (void)U; (void)H; (void)BIG; (void)modv;

template <bool FINAL>
__device__ __forceinline__ void ln_phase(bf16_t* H, bf16_t* U, float* outp, const float* ln_g, const float* ln_b, const float* modn, int gw, int NGW, int lane, unsigned tmo) {
    for (int rg = gw; rg < TOK / 4; rg += NGW) {
        const int r0 = rg * 4, b = r0 / SB, s0 = r0 % SB, midx = (s0 < CTXL) ? 32 : b;
        if (FINAL && s0 < CTXL) continue;
        bf16_t* hr = H + (size_t)r0 * DM;
        f32x4 v[4][2][2]; float sm[4], sq[4];
#pragma unroll
        for (int i = 0; i < 4; ++i)
#pragma unroll
            for (int jj = 0; jj < 2; ++jj) unpack8(*(const u32x4*)(hr + (size_t)i * DM + jj * 512 + lane * 8), v[i][jj][0], v[i][jj][1]);
#pragma unroll
        for (int i = 0; i < 4; ++i) { sm[i] = 0.f;
#pragma unroll
            for (int jj = 0; jj < 2; ++jj)
#pragma unroll
                for (int q = 0; q < 2; ++q) sm[i] += (v[i][jj][q][0] + v[i][jj][q][1]) + (v[i][jj][q][2] + v[i][jj][q][3]); }
#pragma unroll
        for (int o = 1; o < 64; o <<= 1)
#pragma unroll
            for (int i = 0; i < 4; ++i) sm[i] += __shfl_xor(sm[i], o);
#pragma unroll
        for (int i = 0; i < 4; ++i) { const float mean = sm[i] * (1.0f / DM); sq[i] = 0.f;
#pragma unroll
            for (int jj = 0; jj < 2; ++jj)
#pragma unroll
                for (int q = 0; q < 2; ++q) { v[i][jj][q] = v[i][jj][q] - mean; sq[i] += (v[i][jj][q][0] * v[i][jj][q][0] + v[i][jj][q][1] * v[i][jj][q][1]) + (v[i][jj][q][2] * v[i][jj][q][2] + v[i][jj][q][3] * v[i][jj][q][3]); } }
#pragma unroll
        for (int o = 1; o < 64; o <<= 1)
#pragma unroll
            for (int i = 0; i < 4; ++i) sq[i] += __shfl_xor(sq[i], o);
        const float* mv = FINAL ? nullptr : modn + (size_t)midx * 3072;
#pragma unroll
        for (int jj = 0; jj < 2; ++jj) { const int c = jj * 512 + lane * 8;
            f32x4 gg[2], bb[2], sh[2], sc[2];
#pragma unroll
            for (int q = 0; q < 2; ++q) { gg[q] = *(const f32x4*)(ln_g + c + 4 * q); bb[q] = *(const f32x4*)(ln_b + c + 4 * q);
                if (!FINAL) { sh[q] = *(const f32x4*)(mv + c + 4 * q); sc[q] = *(const f32x4*)(mv + 1024 + c + 4 * q) + 1.0f; } }
#pragma unroll
            for (int i = 0; i < 4; ++i) { const float rstd = 1.0f / sqrtf(sq[i] * (1.0f / DM) + LN_EPS);
                f32x4 y0 = v[i][jj][0] * rstd * gg[0] + bb[0], y1 = v[i][jj][1] * rstd * gg[1] + bb[1];
                if (!FINAL) { *(u32x4*)(hr + (size_t)i * DM + c) = pack8(y0, y1); *(u32x4*)(U + (size_t)(r0 + i) * DM + c) = pack8(y0 * sc[0] + sh[0], y1 * sc[1] + sh[1]); }
                else { float* op = outp + ((size_t)b * SEQ + (s0 + i - CTXL)) * DM + c;
                    if (tmo) { const float qn = __builtin_nanf(""); y0 = (f32x4){qn, qn, qn, qn}; y1 = y0; }
                    *(f32x4*)op = y0; *(f32x4*)(op + 4) = y1; } }
        }
    }
}

__global__ void __launch_bounds__(512, 2) fwd_kernel(Params p) {
    extern __shared__ __attribute__((aligned(16))) unsigned char lds_raw[];
    LAS unsigned char* lds = (LAS unsigned char*)lds_raw;
    const int tid0 = threadIdx.x;
    volatile LAS unsigned* MISC = (volatile LAS unsigned*)(lds + MISC_OFF);
    for (int u = tid0; u < (LDS_BYTES - LDS_CTL) / 4; u += 512) ((LAS unsigned*)(lds + LDS_CTL))[u] = 0u;
    __syncthreads();
    if (tid0 < 18) { const unsigned long long a = (unsigned long long)p.in[tid0]; volatile LAS unsigned* t = (volatile LAS unsigned*)(lds + PTR_OFF); t[2 * tid0] = (unsigned)a; t[2 * tid0 + 1] = (unsigned)(a >> 32); }
    __syncthreads();
    unsigned char* const ws0 = p.ws; unsigned char* const dob0 = (unsigned char*)p.out;
    const int wave0 = __builtin_amdgcn_readfirstlane(tid0 >> 6);
    (void)xcd_barrier_post((unsigned*)(ws0 + WS_CTL) + 4096, MISC + 8);
#define GRID_BAR() do { XcdBarrier b2_; b2_.bar = (unsigned*)(ws0 + WS_CTL) + 4096; asm volatile("" : "+s"(b2_.bar)); b2_.x = xb_xcc_id(); b2_.st = (volatile LAS unsigned*)(lds + MISC_OFF) + 8; xcd_barrier(b2_); } while (0)

    {
        PH_BEGIN
        LAS float* scr = (LAS float*)(lds + wave * 16384);
        for (int j = 0; j < 2; ++j) {
            unsigned char* wb = dob + DO_W + (size_t)j * W_PAIR;
            { const float* w = inp(lds, 8) + (size_t)j * 1024 * 9232; for (int it = gw; it < 16 * 296; it += NGW) wconv_item<0>(w, 1024, 9232, (bf16_t*)(wb + W_EVIN), 296, nullptr, scr, it, lane); }
            { const float* w = inp(lds, 11) + (size_t)j * 2048 * 1024; for (int it = gw; it < 32 * 32; it += NGW)  wconv_item<1>(w, 2048, 1024, (bf16_t*)(wb + W_EVOUT), 32, nullptr, scr, it, lane); }
            { const float* w = inp(lds, 12) + (size_t)j * 1024 * 2752; for (int it = gw; it < 16 * 88; it += NGW)  wconv_item<2>(w, 1024, 2752, (bf16_t*)(wb + W_ODIN), 88, nullptr, scr, it, lane); }
            { const float* w = inp(lds, 14) + (size_t)j * 384 * 3072; const float* ks = inp(lds, 13) + j * 384; for (int it = gw; it < 6 * 96; it += NGW)   wconv_item<3>(w, 384, 3072, (bf16_t*)(wb + W_UQ), 96, ks, scr, it, lane); }
            { const float* w = inp(lds, 16) + (size_t)j * 256 * 4096; const float* ks = inp(lds, 15) + j * 256; for (int it = gw; it < 4 * 128; it += NGW)  wconv_item<1>(w, 256, 4096, (bf16_t*)(wb + W_UKV), 128, ks, scr, it, lane); }
            { const float* w = inp(lds, 17) + (size_t)j * 2048 * 1024; for (int it = gw; it < 32 * 32; it += NGW)  wconv_item<1>(w, 2048, 1024, (bf16_t*)(wb + W_ODOUT), 32, nullptr, scr, it, lane); }
        }
        __syncthreads();
        {
            const float* cvec = inp(lds, 1); const float* cctx = inp(lds, 3); const float* mod_w = inp(lds, 4); const float* mod_b = inp(lds, 5);
            LAS float* Ssil = (LAS float*)lds;
            LAS float* red = (LAS float*)(lds + 33 * 128 * 4);
            const int cl = tid & 127, kq = tid >> 7;
            for (int it = bx; it < 4 * 24; it += G) {
                const int L = it / 24, n0 = (it % 24) * 128;
                float a[33];
#pragma unroll
                for (int r = 0; r < 33; ++r) a[r] = 0.f;
                for (int kc = 0; kc < 8; ++kc) {
                    __syncthreads();
                    for (int e = tid; e < 33 * 128; e += 512) { const int r = e >> 7, k = kc * 128 + (e & 127); const float v = (r < 32) ? cvec[r * 1024 + k] : cctx[k]; Ssil[e] = fsilu(v); }
                    __syncthreads();
                    for (int k2 = 0; k2 < 32; ++k2) {
                        const int kl = kq * 32 + k2; const float w = mod_w[((size_t)L * 1024 + kc * 128 + kl) * 3072 + n0 + cl];
#pragma unroll
                        for (int r = 0; r < 33; ++r) a[r] += Ssil[r * 128 + kl] * w;
                    }
                }
                __syncthreads();
#pragma unroll
                for (int r = 0; r < 33; ++r) red[(kq * 33 + r) * 128 + cl] = a[r];
                __syncthreads();
                for (int e = tid; e < 33 * 128; e += 512) { const int r = e >> 7, c = e & 127;
                    modv[((size_t)L * 33 + r) * 3072 + n0 + c] = red[(0 * 33 + r) * 128 + c] + red[(1 * 33 + r) * 128 + c] + red[(2 * 33 + r) * 128 + c] + red[(3 * 33 + r) * 128 + c] + mod_b[L * 3072 + n0 + c]; }
                __syncthreads();
            }
        }
        { float* cosT = (float*)(dob + DO_ROPE); float* sinT = cosT + 2048 * 32;
          for (int e = (vcu * 512 + tid); e < 2048 * 32; e += G * 512) {
            const int pos = e >> 5, i = e & 31; const float invf = __builtin_amdgcn_exp2f(-(float)(i & 15) * (13.287712379549449f / 16.0f));
            const float ang = (float)((i < 16) ? (pos >> 6) : (pos & 63)) * invf;
            cosT[e] = __cosf(ang); sinT[e] = __sinf(ang); } }
    }
    GRID_BAR();
    {
        PH_BEGIN
        const float* x = inp(lds, 0); const float* ctxin = inp(lds, 2);
        for (int rg = gw; rg < TOK / 4; rg += NGW) {
            const int r0 = rg * 4, b = r0 / SB, s = r0 % SB, midx = (s < CTXL) ? 32 : b;
            const float* src = (s < CTXL) ? ctxin + ((size_t)b * CTXL + s) * DM : x + ((size_t)b * SEQ + (s - CTXL)) * DM;
            const float* mv = modv + (size_t)midx * 3072;
            f32x4 v[4][4];
#pragma unroll
            for (int i = 0; i < 4; ++i)
#pragma unroll
                for (int jq = 0; jq < 4; ++jq) v[i][jq] = *(const f32x4*)(src + (size_t)i * DM + jq * 256 + lane * 4);
#pragma unroll
            for (int jq = 0; jq < 4; ++jq) { const int c = jq * 256 + lane * 4; const f32x4 sh = *(const f32x4*)(mv + c), sc = *(const f32x4*)(mv + 1024 + c) + 1.0f;
#pragma unroll
                for (int i = 0; i < 4; ++i) { const f32x4 u = v[i][jq] * sc + sh;
                    u32x2 hw, uw; hw.x = cvt_pk_bf16(v[i][jq][0], v[i][jq][1]); hw.y = cvt_pk_bf16(v[i][jq][2], v[i][jq][3]); uw.x = cvt_pk_bf16(u[0], u[1]); uw.y = cvt_pk_bf16(u[2], u[3]);
                    *(u32x2*)(H + (size_t)(r0 + i) * DM + c) = hw; *(u32x2*)(U + (size_t)(r0 + i) * DM + c) = uw; } }
        }
    }
    GRID_BAR();

    for (int j = 0; j < 2; ++j) {
        { PH_BEGIN
          pg8::Gemm g{U, (const bf16_t*)(dob + DO_W + (size_t)j * W_PAIR + W_EVIN), DM, DM, NTILE, 37, 0, 1, 1, 0}; pg8::StaticOrder S; S.init(NTILE, 37, G, bx);
          EpiEvIn E{BIG, (float*)(dob + DO_SMALL), inp(lds, 10) + j * 16}; pg8::gemm_phase(lds, tid, g, S, E); }
        GRID_BAR();
        {   PH_BEGIN
            {
                const float* cw = inp(lds, 9) + (size_t)j * 3 * 1024;
                for (int rg = gw; rg < TOK / 4; rg += NGW) {
                    const int r0 = rg * 4, s0 = r0 % SB; const bool hp = (s0 != 0 && s0 != CTXL), hn = (s0 + 3 != CTXL - 1 && s0 + 3 != SB - 1);
                    bf16_t* er = BIG + (size_t)r0 * EV_LD;
#pragma unroll
                    for (int jj = 0; jj < 2; ++jj) { const int c = jj * 512 + lane * 8; const u32x4 z4 = (u32x4){0u, 0u, 0u, 0u};
                        u32x4 pw_[6], gw_[4];
                        pw_[0] = hp ? *(const u32x4*)(er - EV_LD + 2048 + c) : z4;
#pragma unroll
                        for (int i = 0; i < 4; ++i) { pw_[1 + i] = *(const u32x4*)(er + (size_t)i * EV_LD + 2048 + c); gw_[i] = *(const u32x4*)(er + (size_t)i * EV_LD + c); }
                        pw_[5] = hn ? *(const u32x4*)(er + (size_t)4 * EV_LD + 2048 + c) : z4;
                        const f32x4 w00 = *(const f32x4*)(cw + c), w01 = *(const f32x4*)(cw + c + 4), w10 = *(const f32x4*)(cw + 1024 + c), w11 = *(const f32x4*)(cw + 1024 + c + 4),
                                    w20 = *(const f32x4*)(cw + 2048 + c), w21 = *(const f32x4*)(cw + 2048 + c + 4);
                        f32x4 p[6][2];
#pragma unroll
                        for (int i = 0; i < 6; ++i) unpack8(pw_[i], p[i][0], p[i][1]);
#pragma unroll
                        for (int i = 0; i < 4; ++i) { f32x4 g0, g1; unpack8(gw_[i], g0, g1);
                            *(u32x4*)(er + (size_t)i * EV_LD + c) = pack8(g0 * (p[i][0] * w00 + p[i + 1][0] * w10 + p[i + 2][0] * w20), g1 * (p[i][1] * w01 + p[i + 1][1] * w11 + p[i + 2][1] * w21)); } }
                }
            }
            {
                for (int it = vcu; it < NB * 8; it += G) {
                    unsigned char* w2 = ws; unsigned char* d2 = dob; asm volatile("" : "+s"(w2), "+s"(d2));
                    const int b = it >> 3, head = (it >> 1) & 3, dh = it & 1;
                    msc::scan_item((const bf16_t*)(w2 + WS_BIG) + (size_t)b * SB * EV_LD, (const float*)(d2 + DO_SMALL) + (size_t)b * SB * 16, (bf16_t*)(d2 + DO_U) + (size_t)b * SB * DM, head, dh, lds, wave0);
                }
            }
        }
        GRID_BAR();
        { PH_BEGIN
          pg8::Gemm g{BIG, (const bf16_t*)(dob + DO_W + (size_t)j * W_PAIR + W_EVOUT), EV_LD, 2048, NTILE, 4, 0, 1, 1, 0}; pg8::StaticOrder S; S.init(NTILE, 4, G, bx);
          EpiOut E{H, modv + (size_t)(2 * j) * 33 * 3072}; pg8::gemm_phase(lds, tid, g, S, E); }
        GRID_BAR();
        {   PH_BEGIN
            const int L = 2 * j;
            ln_phase<false>(H, U, nullptr, inp(lds, 6) + L * DM, inp(lds, 7) + L * DM, modv + (size_t)(L + 1) * 33 * 3072, gw, NGW, lane, 0u);
        }
        GRID_BAR();
        const bool need_ctx = (j == 0);
        { PH_BEGIN
          pg8::Gemm g{U, (const bf16_t*)(dob + DO_W + (size_t)j * W_PAIR + W_ODIN), DM, DM, NTILE, 11, 0, 1, 1, 0}; pg8::StaticOrder S; S.init(NTILE, 11, G, bx);
          EpiOdIn E{BIG}; pg8::gemm_phase(lds, tid, g, S, E); }
        GRID_BAR();
        {   PH_BEGIN
            float* rowsc = (float*)(dob + DO_ROWSC); bf16_t* KR = (bf16_t*)(dob + DO_SMALL); const float* cosT = (const float*)(dob + DO_ROPE); const float* sinT = cosT + 2048 * 32;
            for (int r = gw; r < TOK; r += NGW) {
                const int s = r % SB; const bf16_t* orow = BIG + (size_t)r * OD_LD + 2048;
                float sq = 0.f, sk = 0.f;
#pragma unroll
                for (int i = 0; i < 3; ++i) { const unsigned w = *(const unsigned*)(orow + (i * 64 + lane) * 2); const float a = bflo(w), c = bfhi(w); sq += a * a + c * c; }
#pragma unroll
                for (int i = 0; i < 2; ++i) { const unsigned w = *(const unsigned*)(orow + 384 + (i * 64 + lane) * 2); const float a = bflo(w), c = bfhi(w); sk += a * a + c * c; }
                sq = wave_sum(sq); sk = wave_sum(sk);
                if (lane == 0) { rowsc[(size_t)r * 2] = 1.0f / sqrtf(sq * (1.0f / 384.0f) + RMS_EPS); rowsc[(size_t)r * 2 + 1] = 1.0f / sqrtf(sk * (1.0f / 256.0f) + RMS_EPS); }
                if (lane < 32) { const float x1 = bf1(orow[640 + lane]), x2 = bf1(orow[672 + lane]); float c = 1.f, sn = 0.f;
                    if (s >= CTXL) { c = cosT[(s - CTXL) * 32 + lane]; sn = sinT[(s - CTXL) * 32 + lane]; }
                    KR[(size_t)r * 64 + lane] = f2bf(x1 * c - x2 * sn); KR[(size_t)r * 64 + 32 + lane] = f2bf(x1 * sn + x2 * c); }
            }
        }
        GRID_BAR();
        for (int grp = 0; grp < NGRP; ++grp) {
            { PH_BEGIN
              const float* rowsc = (const float*)(dob + DO_ROWSC); const float* cosT = (const float*)(dob + DO_ROPE);
              pg8::Gemm g{BIG + 2048, (const bf16_t*)(dob + DO_W + (size_t)j * W_PAIR + W_UQ), OD_LD, 384, need_ctx ? GT : GB * 8, 12, grp * GT, need_ctx ? 1 : 8, need_ctx ? 1 : 9, need_ctx ? 0 : 1};
              pg8::StaticOrder S; S.init(g.nM, 12, G, bx); EpiUq E{(bf16_t*)(ws + WS_BIG + BIG_Q), rowsc, cosT, cosT + 2048 * 32, grp}; pg8::gemm_phase(lds, tid, g, S, E); }
            { PH_BEGIN
              const float* rowsc = (const float*)(dob + DO_ROWSC);
              pg8::Gemm g{BIG + 2432, (const bf16_t*)(dob + DO_W + (size_t)j * W_PAIR + W_UKV), OD_LD, 256, GT, 16, grp * GT, 1, 1, 0};
              pg8::StaticOrder S; S.init(GT, 16, G, bx); EpiUkv E{(bf16_t*)(ws + WS_BIG + BIG_K), (bf16_t*)(ws + WS_BIG + BIG_V), rowsc, (const bf16_t*)(dob + DO_SMALL), grp}; pg8::gemm_phase(lds, tid, g, S, E); }
            GRID_BAR();
            {   PH_BEGIN
                const int nunits = GB * 16 * 8 + (need_ctx ? GB * 16 : 0);
                for (int un = vcu; un < nunits; un += G) {
                    unsigned char* w2 = ws; asm volatile("" : "+s"(w2));
                    const bf16_t* Qb = (const bf16_t*)(w2 + WS_BIG + BIG_Q); const bf16_t* Kb = (const bf16_t*)(w2 + WS_BIG + BIG_K); const bf16_t* Vb = (const bf16_t*)(w2 + WS_BIG + BIG_V);
                    bf16_t* BIG2 = (bf16_t*)(w2 + WS_BIG);
                    int bl, head, qb, nkeys;
                    if (un < GB * 128) { bl = un >> 7; head = (un >> 3) & 15; qb = 1 + (un & 7); nkeys = SB; }
                    else { const int u2 = un - GB * 128; bl = u2 >> 4; head = u2 & 15; qb = 0; nkeys = CTXL; }
                    const size_t bh = (size_t)(bl * 16 + head) * SB;
                    att::attn_unit(Qb + (bh + qb * 256) * 192, Kb + bh * 192, Vb + bh * 128, BIG2 + (size_t)((grp * GB + bl) * SB + qb * 256) * OD_LD + head * 128, nkeys, lds, tid);
                }
            }
            GRID_BAR();
        }
        { PH_BEGIN
          pg8::Gemm g{BIG, (const bf16_t*)(dob + DO_W + (size_t)j * W_PAIR + W_ODOUT), OD_LD, 2048, need_ctx ? NTILE : NB * 8, 4, 0, need_ctx ? 1 : 8, need_ctx ? 1 : 9, need_ctx ? 0 : 1}; pg8::StaticOrder S; S.init(g.nM, 4, G, bx);
          EpiOut E{H, modv + (size_t)(2 * j + 1) * 33 * 3072}; pg8::gemm_phase(lds, tid, g, S, E); }
        GRID_BAR();
        {   PH_BEGIN
            const int L = 2 * j + 1;
            if (need_ctx) ln_phase<false>(H, U, nullptr, inp(lds, 6) + L * DM, inp(lds, 7) + L * DM, modv + (size_t)(L + 1) * 33 * 3072, gw, NGW, lane, 0u);
            else { const unsigned tmo = __hip_atomic_load((unsigned*)(ws + WS_CTL) + 4096 + XB_TMO, __ATOMIC_RELAXED, __HIP_MEMORY_SCOPE_AGENT);
                   ln_phase<true>(H, nullptr, (float*)dob, inp(lds, 6) + L * DM, inp(lds, 7) + L * DM, nullptr, gw, NGW, lane, tmo); }
        }
        if (need_ctx) GRID_BAR();
    }
}

extern "C" void kernel_launch(void* const* d_in, const int* in_sizes, int n_in, void* d_out, int out_size, void* d_ws, size_t ws_size, hipStream_t stream) {
    static int grid = 0;
    if (grid == 0) {
        if (n_in != 18 || out_size != NB * SEQ * DM || ws_size < WS_END) { fprintf(stderr, "kernel_launch: unexpected shapes (n_in %d out %d ws %zu)\n", n_in, out_size, ws_size); grid = -1; return; }
        int dev = 0, cus = 0;
        if (hipGetDevice(&dev) != hipSuccess || hipDeviceGetAttribute(&cus, hipDeviceAttributeMultiprocessorCount, dev) != hipSuccess) { grid = -1; return; }
        if (hipFuncSetAttribute((const void*)fwd_kernel, hipFuncAttributeMaxDynamicSharedMemorySize, LDS_BYTES) != hipSuccess) { fprintf(stderr, "kernel_launch: hipFuncSetAttribute failed\n"); grid = -1; return; }
        int per_cu = 0;
        if (hipOccupancyMaxActiveBlocksPerMultiprocessor(&per_cu, (const void*)fwd_kernel, 512, LDS_BYTES) != hipSuccess || per_cu < 1) fprintf(stderr, "kernel_launch: occupancy query says %d\n", per_cu);
        (void)hipGetLastError();
        grid = cus;
    }
    if (grid < 0) return;
    if (hipMemsetAsync((char*)d_ws + WS_CTL, 0, CTL_BYTES, stream) != hipSuccess) return;
    Params p{};
    for (int i = 0; i < 18; ++i) p.in[i] = (const float*)d_in[i];
    p.out = (float*)d_out; p.ws = (unsigned char*)d_ws;
    hipLaunchKernelGGL(fwd_kernel, dim3(grid), dim3(512), LDS_BYTES, stream, p);
}
```

```cpp
#include <hip/hip_runtime.h>
#include <cstdio>
#include <cstdint>

#define LAS __attribute__((address_space(3)))
typedef unsigned short bf16_t;
typedef short bf16x8 __attribute__((ext_vector_type(8)));
typedef float f32x4 __attribute__((ext_vector_type(4)));
typedef unsigned u32x4 __attribute__((ext_vector_type(4)));
typedef unsigned u32x2 __attribute__((ext_vector_type(2)));

constexpr int DM = 1024, NB = 32, SEQ = 2048, CTXL = 256, SB = SEQ + CTXL  , TOK = NB * SB  ;
constexpr int NTILE = TOK / 256;
constexpr int EV_LD = 6144;
constexpr int EV_NP = 9472;
constexpr int OD_LD = 2816;
constexpr int NGRP = 4, GB = NB / NGRP  , GT = GB * 9  , GROWS = GB * SB  ;
constexpr float ALPHA = 1.681792830507429f;
constexpr float QSCALE = 0.07216878364870322f * 1.4426950408889634f;
constexpr float LN_EPS = 1e-5f, RMS_EPS = 1e-6f;

constexpr size_t DO_U = 0;
constexpr size_t DO_W = 150994944;
constexpr size_t W_PAIR = 38010880, W_EVIN = 0, W_EVOUT = 19398656, W_ODIN = 23592960, W_UQ = 29360128, W_UKV = 31719424, W_ODOUT = 33816576;
constexpr size_t DO_MODV = DO_W + 2 * W_PAIR;
constexpr size_t DO_ROPE = DO_MODV + 1622016;
constexpr size_t DO_ROWSC = DO_ROPE + 524288;
constexpr size_t DO_SMALL = DO_ROWSC + 589824;
constexpr size_t DO_END = DO_SMALL + 9437184;
static_assert(DO_END <= 268435456, "d_out map");
constexpr size_t WS_CTL = 0, CTL_BYTES = 1 << 20;
constexpr size_t WS_H = 1 << 20;
constexpr size_t WS_BIG = WS_H + 150994944;
constexpr size_t BIG_Q = 415236096, BIG_K = BIG_Q + 113246208, BIG_V = BIG_K + 113246208;
constexpr size_t WS_END = WS_BIG + 905969664;
static_assert(WS_END <= 1073741824, "ws map");
static_assert(BIG_V + 75497472 <= 905969664, "odd map");

__device__ __forceinline__ unsigned cvt_pk_bf16(float lo, float hi) { unsigned r; asm volatile("v_cvt_pk_bf16_f32 %0, %1, %2" : "=v"(r) : "v"(lo), "v"(hi)); return r; }
__device__ __forceinline__ float bflo(unsigned w) { return __uint_as_float(w << 16); }
__device__ __forceinline__ float bfhi(unsigned w) { return __uint_as_float(w & 0xffff0000u); }
__device__ __forceinline__ float bf1(bf16_t h) { return __uint_as_float(((unsigned)h) << 16); }
__device__ __forceinline__ bf16_t f2bf(float f) { return (bf16_t)(cvt_pk_bf16(f, 0.f) & 0xffffu); }
__device__ __forceinline__ float fsigmoid(float x) { return __builtin_amdgcn_rcpf(1.0f + __builtin_amdgcn_exp2f(-1.4426950408889634f * x)); }
__device__ __forceinline__ float fsilu(float x) { return x * fsigmoid(x); }
__device__ __forceinline__ float wave_sum(float v) {
#pragma unroll
    for (int o = 1; o < 64; o <<= 1) v += __shfl_xor(v, o);
    return v;
}
#define LDS_WAIT() asm volatile("s_waitcnt lgkmcnt(0)" ::: "memory")

#define XB_TMO      128
#define XB_XCNT(j)  (256  + 64 * (j))
#define XB_XSUB(j)  (1280 + 64 * (j))
#define XB_XGEN(j)  (2304 + 64 * (j))
#define XB_TOP      3328
#define XB_TOPGEN   3392
#define XCD_BAR_WORDS 3456
#define XB_SPIN_CAP (1u << 24)
__device__ __forceinline__ unsigned xb_ld(unsigned* p)              { return __hip_atomic_load(p, __ATOMIC_RELAXED, __HIP_MEMORY_SCOPE_AGENT); }
__device__ __forceinline__ unsigned xb_add(unsigned* p, unsigned v) { return __hip_atomic_fetch_add(p, v, __ATOMIC_RELAXED, __HIP_MEMORY_SCOPE_AGENT); }
__device__ __forceinline__ unsigned xb_xcc_id() { return (unsigned)__builtin_amdgcn_s_getreg((3 << 11) | 20) & 0xFu; }
#define XB_SPIN(cond, bar) do { unsigned _sp = 0; while (cond) { __builtin_amdgcn_s_sleep(1); \
    if ((++_sp & 255u) == 0u) { if (xb_ld(&(bar)[XB_TMO])) break; if (_sp > XB_SPIN_CAP) { atomicAdd(&(bar)[XB_TMO], 1u); break; } } } } while (0)
struct XcdBarrier { unsigned* bar; unsigned x; volatile LAS unsigned* st; };
__device__ __forceinline__ XcdBarrier xcd_barrier_post(unsigned* bar, volatile LAS unsigned* st) {
    XcdBarrier b; b.bar = bar; b.x = xb_xcc_id(); b.st = st;
    if (threadIdx.x == 0) (void)xb_add(&bar[XB_XCNT(b.x)], 1u);
    return b;
}
__device__ __forceinline__ void xcd_barrier_complete(unsigned* bar, unsigned x, unsigned& nloc, unsigned& nx) {
    const unsigned G = gridDim.x * gridDim.y * gridDim.z;
    unsigned sum, cnt, mine, sp = 0u;
    for (;;) {
        sum = 0u; cnt = 0u; mine = 0u;
#pragma unroll
        for (unsigned j = 0; j < 16; ++j) { const unsigned c = xb_ld(&bar[XB_XCNT(j)]); sum += c; cnt += (c > 0u) ? 1u : 0u; mine = (j == x) ? c : mine; }
        if (sum == G) break;
        __builtin_amdgcn_s_sleep(1);
        if ((++sp & 255u) == 0u) { if (xb_ld(&bar[XB_TMO])) break; if (sp > XB_SPIN_CAP) { atomicAdd(&bar[XB_TMO], 1u); break; } }
    }
    nloc = mine > 0u ? mine : 1u; nx = cnt > 0u ? cnt : 1u;
}
__device__ __forceinline__ void xcd_barrier(const XcdBarrier& b) {
    asm volatile("s_waitcnt vmcnt(0)" ::: "memory");
    __syncthreads();
    if (threadIdx.x == 0) {
        unsigned* bar = b.bar;
        __builtin_amdgcn_s_waitcnt(0);
        unsigned nloc = b.st[0], nx = b.st[1];
        if (nloc == 0u) { xcd_barrier_complete(bar, b.x, nloc, nx); b.st[0] = nloc; b.st[1] = nx; }
        const unsigned old = xb_add(&bar[XB_XSUB(b.x)], 1u);
        const unsigned gen = old / nloc;
        if (old + 1u == (gen + 1u) * nloc) {
            __builtin_amdgcn_fence(__ATOMIC_RELEASE, "agent");
            asm volatile("s_waitcnt vmcnt(0)" ::: "memory");
            const unsigned og = xb_add(&bar[XB_TOP], 1u);
            const unsigned tg = og / nx;
            if (og + 1u == (tg + 1u) * nx) xb_add(&bar[XB_TOPGEN], 1u);
            else XB_SPIN(xb_ld(&bar[XB_TOPGEN]) == tg, bar);
            __builtin_amdgcn_fence(__ATOMIC_ACQUIRE, "agent");
            xb_add(&bar[XB_XGEN(b.x)], 1u);
            asm volatile("s_waitcnt vmcnt(0)" ::: "memory");
        } else {
            XB_SPIN(xb_ld(&bar[XB_XGEN(b.x)]) == gen, bar);
            __builtin_amdgcn_fence(__ATOMIC_ACQUIRE, "agent");
            asm volatile("s_waitcnt vmcnt(0)" ::: "memory");
        }
    }
    __syncthreads();
}

namespace pg8 {
constexpr int BM = 256, BK = 64, HALF = 128, HTB = HALF * BK * 2, STAGE_BYTES = 8 * HTB, NXCD = 8, WGM = 8;
__host__ __device__ __forceinline__ int lds_byte(int r, int c) { const int st = (r >> 4) * 2 + (c >> 5), rr = r & 15, cc = c & 31, ob = rr * 64 + cc * 2; return st * 1024 + (ob ^ (((ob >> 9) & 1) << 5)); }
__host__ __device__ __forceinline__ void stage_rc(int b, int& R, int& C) { const int st = b / 1024, sb = b % 1024, swz = sb ^ (((sb >> 9) & 1) << 5); R = (st >> 1) * 16 + swz / 64; C = (st & 1) * 32 + (swz % 64) / 2; }
__host__ __device__ __forceinline__ int perm32(int rho) { const int n = rho >> 4, i = rho & 15; return 8 * (i >> 2) + 4 * n + (i & 3); }
struct Unit { int pm, pn; };
struct Gemm { const bf16_t* A; const bf16_t* Bt; int lda, K, nM, nN, tbase, gsz, gstride, goff;
    __device__ __forceinline__ int ptile(int pm) const { return tbase + (pm / gsz) * gstride + goff + (pm % gsz); } };
struct StaticOrder {
    int nM, nN, nwg, G, c;
    __device__ void init(int nM_, int nN_, int G_, int c_) { nM = nM_; nN = nN_; nwg = nM * nN; G = G_; c = c_; }
    __device__ bool next(int i, Unit& u) const {
        const long L = (long)i * G + c; if (L >= nwg) return false;
        int wgid = (int)L; { const int q = nwg / NXCD, r = nwg % NXCD, xcd = wgid % NXCD, off = wgid / NXCD; wgid = (xcd < r ? xcd * (q + 1) : r * (q + 1) + (xcd - r) * q) + off; }
        const int nig = WGM * nN, gid = wgid / nig, fm = gid * WGM, gsz = (nM - fm) < WGM ? (nM - fm) : WGM;
        u.pm = fm + ((wgid % nig) % gsz); u.pn = (wgid % nig) / gsz; return true;
    }
};
template <class Epi>
__device__ __forceinline__ void gemm_phase(LAS unsigned char* lds, const int tid, const Gemm g, const StaticOrder& S, const Epi& E) {
    const int wid = __builtin_amdgcn_readfirstlane(tid >> 6), lane = tid & 63, wr = wid >> 2, wc = wid & 3, fr = lane & 15, fq = lane >> 4;
    const int K = g.K, nt = K / BK, lda = g.lda;
    unsigned voffA[2], voffB[2];
#pragma unroll
    for (int i = 0; i < 2; ++i) { int R, C; stage_rc(tid * 16 + i * 8192, R, C); const int Rb = (R & ~31) + perm32(R & 31);
        voffA[i] = (unsigned)(R * lda + C) * 2u; voffB[i] = (unsigned)(Rb * K + C) * 2u; }
    const size_t kstep = (size_t)(BK * 2);
    const size_t hstepA = (size_t)HALF * lda * 2, hstepB = (size_t)HALF * K * 2;
    const size_t tstepA = 2 * hstepA, tstepB = 2 * hstepB;
    const unsigned ldsw = (unsigned)wid * 1024u;
    const int aoff = lds_byte(wr * 64 + fr, fq * 8), boff = lds_byte(wc * 32 + fr, fq * 8);
#define PG8_SA(b, h) (((b) * 2 + (h)) * HTB)
#define PG8_SB(b, h) ((4 + (b) * 2 + (h)) * HTB)
#define PG8_STAGE(bufoff, gbase, voff) do { _Pragma("unroll") for (int _i = 0; _i < 2; ++_i) \
        __builtin_amdgcn_global_load_lds((const unsigned*)((const char*)(gbase) + (voff)[_i]), (LAS unsigned*)(lds + (bufoff) + ldsw + _i * 8192), 16, 0, 0); } while (0)
#define PG8_LDA(dst, b, h) do { _Pragma("unroll") for (int m = 0; m < 4; ++m) _Pragma("unroll") for (int k = 0; k < 2; ++k) dst[m][k] = *(const LAS bf16x8*)(lds + PG8_SA(b, h) + aoff + m * 2048 + k * 1024); } while (0)
#define PG8_LDB(dst, b, h) do { _Pragma("unroll") for (int n = 0; n < 2; ++n) _Pragma("unroll") for (int k = 0; k < 2; ++k) dst[n][k] = *(const LAS bf16x8*)(lds + PG8_SB(b, h) + boff + n * 2048 + k * 1024); } while (0)
#define PG8_MMA(ai, bj, At, Bt) do { __builtin_amdgcn_s_setprio(1); _Pragma("unroll") for (int m = 0; m < 4; ++m) _Pragma("unroll") for (int n = 0; n < 2; ++n) _Pragma("unroll") for (int k = 0; k < 2; ++k) \
        acc[ai][bj][m][n] = __builtin_amdgcn_mfma_f32_16x16x32_bf16(Bt[n][k], At[m][k], acc[ai][bj][m][n], 0, 0, 0); __builtin_amdgcn_s_setprio(0); } while (0)
#define PG8_WAIT_V(n) asm volatile("s_waitcnt vmcnt(" #n ")" ::: "memory")
#define PG8_WAIT_L(n) asm volatile("s_waitcnt lgkmcnt(" #n ")" ::: "memory")
#define PG8_BAR __builtin_amdgcn_s_barrier()
#define PG8_SCHED __builtin_amdgcn_sched_barrier(0)
    Unit cur, nxt; int ui = 0;
    if (!S.next(0, cur)) return;
    f32x4 acc[2][2][4][2];
#pragma unroll
    for (int a = 0; a < 2; ++a)
#pragma unroll
        for (int b = 0; b < 2; ++b)
#pragma unroll
            for (int m = 0; m < 4; ++m)
#pragma unroll
                for (int n = 0; n < 2; ++n) acc[a][b][m][n] = (f32x4){0.f, 0.f, 0.f, 0.f};
    bf16x8 At[4][2], B0[2][2], B1[2][2];
    int curpt = g.ptile(cur.pm);
    const char* cA = (const char*)g.A + (size_t)curpt * tstepA; const char* cB = (const char*)g.Bt + (size_t)cur.pn * tstepB;
    PG8_STAGE(PG8_SB(0, 0), cB, voffB); PG8_STAGE(PG8_SA(0, 0), cA, voffA); PG8_STAGE(PG8_SB(0, 1), cB + hstepB, voffB); PG8_STAGE(PG8_SA(0, 1), cA + hstepA, voffA);
    if (wr == 1) PG8_BAR;
    PG8_WAIT_V(4); PG8_BAR;
    PG8_STAGE(PG8_SB(1, 0), cB + kstep, voffB); PG8_STAGE(PG8_SA(1, 0), cA + kstep, voffA); PG8_STAGE(PG8_SB(1, 1), cB + hstepB + kstep, voffB);
    PG8_WAIT_V(6); PG8_BAR;
    for (;;) {
        const bool has_next = S.next(ui + 1, nxt);
        const int nxtpt = has_next ? g.ptile(nxt.pm) : curpt;
        const char* nA = has_next ? (const char*)g.A + (size_t)nxtpt * tstepA : cA; const char* nB = has_next ? (const char*)g.Bt + (size_t)nxt.pn * tstepB : cB;
#pragma unroll 1
        for (int t = 0; t < nt; t += 2) {
            const bool last = (t == nt - 2);
            const char* a1 = cA + (size_t)(t + 1) * kstep;
            const char* a2 = last ? nA : cA + (size_t)(t + 2) * kstep; const char* b2 = last ? nB : cB + (size_t)(t + 2) * kstep;
            const char* a3 = a2 + kstep; const char* b3 = b2 + kstep;
            PG8_LDB(B0, 0, 0); PG8_SCHED; PG8_LDA(At, 0, 0); PG8_STAGE(PG8_SA(1, 1), a1 + hstepA, voffA);
            PG8_WAIT_L(8); PG8_BAR; PG8_WAIT_L(0); PG8_MMA(0, 0, At, B0); PG8_BAR; PG8_SCHED;
            PG8_LDB(B1, 0, 1); PG8_STAGE(PG8_SB(0, 0), b2, voffB);
            PG8_BAR; PG8_WAIT_L(0); PG8_MMA(0, 1, At, B1); PG8_BAR;
            PG8_LDA(At, 0, 1); PG8_STAGE(PG8_SA(0, 0), a2, voffA);
            PG8_BAR; PG8_WAIT_L(0); PG8_MMA(1, 0, At, B0); PG8_BAR; PG8_SCHED;
            PG8_STAGE(PG8_SB(0, 1), b2 + hstepB, voffB);
            PG8_WAIT_V(6); PG8_BAR; PG8_MMA(1, 1, At, B1); PG8_BAR;
            PG8_LDB(B0, 1, 0); PG8_SCHED; PG8_LDA(At, 1, 0); PG8_STAGE(PG8_SA(0, 1), a2 + hstepA, voffA);
            PG8_WAIT_L(8); PG8_BAR; PG8_WAIT_L(0); PG8_MMA(0, 0, At, B0); PG8_BAR; PG8_SCHED;
            PG8_LDB(B1, 1, 1); PG8_STAGE(PG8_SB(1, 0), b3, voffB);
            PG8_BAR; PG8_WAIT_L(0); PG8_MMA(0, 1, At, B1); PG8_BAR;
            PG8_LDA(At, 1, 1); PG8_STAGE(PG8_SA(1, 0), a3, voffA);
            PG8_BAR; PG8_WAIT_L(0); PG8_MMA(1, 0, At, B0); PG8_BAR; PG8_SCHED;
            PG8_STAGE(PG8_SB(1, 1), b3 + hstepB, voffB);
            PG8_WAIT_V(6); PG8_BAR; PG8_MMA(1, 1, At, B1); PG8_BAR;
        }
        E(acc, cur.pn, curpt, wr, wc, fr, fq);
        if (!has_next) break;
#pragma unroll
        for (int a = 0; a < 2; ++a)
#pragma unroll
            for (int b = 0; b < 2; ++b)
#pragma unroll
                for (int m = 0; m < 4; ++m)
#pragma unroll
                    for (int n = 0; n < 2; ++n) acc[a][b][m][n] = (f32x4){0.f, 0.f, 0.f, 0.f};
        cur = nxt; cA = nA; cB = nB; curpt = nxtpt; ++ui;
    }
    PG8_WAIT_V(0);
    if (wr == 0) PG8_BAR;
    PG8_BAR;
#undef PG8_SA
#undef PG8_SB
#undef PG8_STAGE
#undef PG8_LDA
#undef PG8_LDB
#undef PG8_MMA
#undef PG8_WAIT_V
#undef PG8_WAIT_L
#undef PG8_BAR
#undef PG8_SCHED
}
}

typedef const f32x4 (&AccRef)[2][2][4][2];
__device__ __forceinline__ u32x4 pack8(const f32x4 a, const f32x4 b) { u32x4 w; w.x = cvt_pk_bf16(a[0], a[1]); w.y = cvt_pk_bf16(a[2], a[3]); w.z = cvt_pk_bf16(b[0], b[1]); w.w = cvt_pk_bf16(b[2], b[3]); return w; }
__device__ __forceinline__ void unpack8(const u32x4 w, f32x4& a, f32x4& b) { a = (f32x4){bflo(w.x), bfhi(w.x), bflo(w.y), bfhi(w.y)}; b = (f32x4){bflo(w.z), bfhi(w.z), bflo(w.w), bfhi(w.w)}; }
__device__ __forceinline__ f32x4 silu4(f32x4 v) { return (f32x4){fsilu(v[0]), fsilu(v[1]), fsilu(v[2]), fsilu(v[3])}; }
__device__ __forceinline__ f32x4 sigm4(f32x4 v) { return (f32x4){fsigmoid(v[0]), fsigmoid(v[1]), fsigmoid(v[2]), fsigmoid(v[3])}; }

struct EpiEvIn {
    bf16_t* EV; float* gates; const float* gate_b;
    __device__ __forceinline__ void operator()(AccRef acc, int pn, int pt, int wr, int wc, int fr, int fq) const {
        const int row0 = pt * 256 + wr * 64 + fr, cl = wc * 32 + 8 * fq;
        if (pn < 24) {
            const int kind = pn >> 3, col = kind * 1024 + (pn & 7) * 128 + cl;
#pragma unroll
            for (int ai = 0; ai < 2; ++ai)
#pragma unroll
                for (int m = 0; m < 4; ++m) {
                    const f32x4 x0 = acc[ai][0][m][0], x1 = acc[ai][0][m][1], y0 = acc[ai][1][m][0], y1 = acc[ai][1][m][1];
                    f32x4 r0, r1;
                    if (kind == 0) { r0 = x0 * silu4(y0); r1 = x1 * silu4(y1); }
                    else if (kind == 1) { r0 = sigm4(x0) * silu4(y0); r1 = sigm4(x1) * silu4(y1); }
                    else { r0 = x0 * y0; r1 = x1 * y1; }
                    *(u32x4*)(EV + (size_t)(row0 + ai * 128 + m * 16) * EV_LD + col) = pack8(r0, r1);
                    asm volatile("" ::: "memory");
                }
        } else if (pn < 36) {
            const int col = 3072 + (pn - 24) * 256 + cl;
#pragma unroll
            for (int ai = 0; ai < 2; ++ai)
#pragma unroll
                for (int m = 0; m < 4; ++m)
#pragma unroll
                    for (int bj = 0; bj < 2; ++bj)
                        *(u32x4*)(EV + (size_t)(row0 + ai * 128 + m * 16) * EV_LD + col + bj * 128) = pack8(acc[ai][bj][m][0], acc[ai][bj][m][1]);
        } else {
            if (wc == 0 && fq < 2) {
                const f32x4 b0 = *(const f32x4*)(gate_b + 8 * fq), b1 = *(const f32x4*)(gate_b + 8 * fq + 4);
#pragma unroll
                for (int ai = 0; ai < 2; ++ai)
#pragma unroll
                    for (int m = 0; m < 4; ++m) {
                        float* gp = gates + (size_t)(row0 + ai * 128 + m * 16) * 16 + 8 * fq;
                        *(f32x4*)gp = acc[ai][0][m][0] + b0; *(f32x4*)(gp + 4) = acc[ai][0][m][1] + b1;
                    }
            }
        }
    }
};
struct EpiOdIn {
    bf16_t* OD;
    __device__ __forceinline__ void operator()(AccRef acc, int pn, int pt, int wr, int wc, int fr, int fq) const {
        const int row0 = pt * 256 + wr * 64 + fr, col = pn * 256 + wc * 32 + 8 * fq;
#pragma unroll
        for (int ai = 0; ai < 2; ++ai)
#pragma unroll
            for (int m = 0; m < 4; ++m)
#pragma unroll
                for (int bj = 0; bj < 2; ++bj) {
                    f32x4 v0 = acc[ai][bj][m][0], v1 = acc[ai][bj][m][1];
                    if (pn < 8) { v0 = silu4(v0); v1 = silu4(v1); }
                    *(u32x4*)(OD + (size_t)(row0 + ai * 128 + m * 16) * OD_LD + col + bj * 128) = pack8(v0, v1);
                }
    }
};
struct EpiUq {
    bf16_t* Q; const float* rowsc; const float* cosT; const float* sinT; int grp;
    __device__ __forceinline__ void operator()(AccRef acc, int pn, int pt, int wr, int wc, int fr, int fq) const {
        const int lt = pt - grp * GT, bl = lt / 9, s0 = (lt % 9) * 256 + wr * 64 + fr, row0 = pt * 256 + wr * 64 + fr;
        float sc[8];
#pragma unroll
        for (int i = 0; i < 8; ++i) sc[i] = rowsc[(size_t)(row0 + (i >> 2) * 128 + (i & 3) * 16) * 2];
        if (pn < 8) {
#pragma unroll
            for (int ai = 0; ai < 2; ++ai)
#pragma unroll
                for (int m = 0; m < 4; ++m) {
                    const int ro = ai * 128 + m * 16; const float scq = sc[ai * 4 + m] * QSCALE;
#pragma unroll
                    for (int bj = 0; bj < 2; ++bj) {
                        const int head = 2 * pn + bj;
                        *(u32x4*)(Q + ((size_t)(bl * 16 + head) * SB + s0 + ro) * 192 + wc * 32 + 8 * fq) = pack8(acc[ai][bj][m][0] * scq, acc[ai][bj][m][1] * scq);
                    }
                }
        } else {
            const int head = 4 * (pn - 8) + wc, i0 = 8 * fq; const bool lat = (lt % 9) != 0;
#pragma unroll
            for (int ai = 0; ai < 2; ++ai) {
                f32x4 c0[4], c1[4], n0[4], n1[4];
#pragma unroll
                for (int m = 0; m < 4; ++m) {
                    c0[m] = (f32x4){1.f, 1.f, 1.f, 1.f}; c1[m] = c0[m]; n0[m] = (f32x4){0.f, 0.f, 0.f, 0.f}; n1[m] = n0[m];
                    if (lat) { const int pos = s0 + ai * 128 + m * 16 - CTXL; c0[m] = *(const f32x4*)(cosT + pos * 32 + i0); c1[m] = *(const f32x4*)(cosT + pos * 32 + i0 + 4);
                        n0[m] = *(const f32x4*)(sinT + pos * 32 + i0); n1[m] = *(const f32x4*)(sinT + pos * 32 + i0 + 4); }
                }
#pragma unroll
                for (int m = 0; m < 4; ++m) {
                    const int s = s0 + ai * 128 + m * 16; const float scq = sc[ai * 4 + m] * QSCALE;
                    const f32x4 xa0 = acc[ai][0][m][0], xa1 = acc[ai][0][m][1], xb0 = acc[ai][1][m][0], xb1 = acc[ai][1][m][1];
                    bf16_t* qp = Q + ((size_t)(bl * 16 + head) * SB + s) * 192 + 128 + i0;
                    *(u32x4*)qp = pack8((xa0 * c0[m] - xb0 * n0[m]) * scq, (xa1 * c1[m] - xb1 * n1[m]) * scq);
                    *(u32x4*)(qp + 32) = pack8((xa0 * n0[m] + xb0 * c0[m]) * scq, (xa1 * n1[m] + xb1 * c1[m]) * scq);
                }
                asm volatile("" ::: "memory");
            }
        }
    }
};
struct EpiUkv {
    bf16_t* Kb; bf16_t* Vb; const float* rowsc; const bf16_t* KR; int grp;
    __device__ __forceinline__ void operator()(AccRef acc, int pn, int pt, int wr, int wc, int fr, int fq) const {
        const int lt = pt - grp * GT, bl = lt / 9, s0 = (lt % 9) * 256 + wr * 64 + fr, row0 = pt * 256 + wr * 64 + fr, head = pn;
        const int c8 = ((wc & 1) * 4 + fq) * 8;
        float sc[8]; u32x4 kr[8];
#pragma unroll
        for (int i = 0; i < 8; ++i) { const int ro = (i >> 2) * 128 + (i & 3) * 16; sc[i] = rowsc[(size_t)(row0 + ro) * 2 + 1];
            kr[i] = (wc < 2) ? *(const u32x4*)(KR + (size_t)(row0 + ro) * 64 + c8) : (u32x4){0u, 0u, 0u, 0u}; }
#pragma unroll
        for (int ai = 0; ai < 2; ++ai)
#pragma unroll
            for (int m = 0; m < 4; ++m) {
                const int ro = ai * 128 + m * 16; const float scv = sc[ai * 4 + m];
                const size_t kv = (size_t)(bl * 16 + head) * SB + s0 + ro;
                *(u32x4*)(Kb + kv * 192 + wc * 32 + 8 * fq) = pack8(acc[ai][0][m][0] * scv, acc[ai][0][m][1] * scv);
                *(u32x4*)(Vb + kv * 128 + wc * 32 + 8 * fq) = pack8(acc[ai][1][m][0] * scv, acc[ai][1][m][1] * scv);
                if (wc < 2) *(u32x4*)(Kb + kv * 192 + 128 + c8) = kr[ai * 4 + m];
            }
    }
};
struct EpiOut {
    bf16_t* H; const float* modv  ;
    __device__ __forceinline__ void operator()(AccRef acc, int pn, int pt, int wr, int wc, int fr, int fq) const {
        const int row0 = pt * 256 + wr * 64 + fr, midx = (pt % 9 == 0) ? 32 : pt / 9;
        const float* gv = modv + (size_t)midx * 3072 + 2048;
#pragma unroll
        for (int bj = 0; bj < 2; ++bj) {
            const int col = pn * 256 + bj * 128 + wc * 32 + 8 * fq;
            const f32x4 g0 = *(const f32x4*)(gv + col), g1 = *(const f32x4*)(gv + col + 4);
            u32x4 hw[8];
#pragma unroll
            for (int i = 0; i < 8; ++i) hw[i] = *(const u32x4*)(H + (size_t)(row0 + (i >> 2) * 128 + (i & 3) * 16) * DM + col);
#pragma unroll
            for (int i = 0; i < 8; ++i) { const int ai = i >> 2, m = i & 3;
                f32x4 h0, h1; unpack8(hw[i], h0, h1);
                *(u32x4*)(H + (size_t)(row0 + ai * 128 + m * 16) * DM + col) = pack8(h0 * ALPHA + g0 * acc[ai][bj][m][0], h1 * ALPHA + g1 * acc[ai][bj][m][1]); }
            asm volatile("" ::: "memory");
        }
    }
};

namespace att {
typedef short s16x4 __attribute__((ext_vector_type(4)));
typedef float f32x16 __attribute__((ext_vector_type(16)));
constexpr int SHM_V = 16384, SHM_KN = 16384, SHM_KR = 8192, OFF_V = 0, OFF_KN = 32768, OFF_KR = 65536, OFF_WS = 81920;
constexpr float THR2 = 11.5f;
#define KSWZ(row, colB) ((row) * 256 + ((colB) ^ (((row) & 7) << 4)))
#define KSWZ2(row, colB) ((row) * 128 + ((colB) ^ ((((row) >> 1) & 7) << 4)))
#define SBAR() __builtin_amdgcn_sched_barrier(0)
__device__ __forceinline__ int crow(int r, int hi) { return (r & 3) + 8 * (r >> 2) + 4 * hi; }
__device__ __forceinline__ void partialSM(f32x16& p0, f32x16& p1, float& m_reg, float& mn, float& alpha) {
  float pmax = p0[0];
#pragma unroll
  for (int r = 1; r < 16; ++r) pmax = fmaxf(pmax, p0[r]);
#pragma unroll
  for (int r = 0; r < 16; ++r) pmax = fmaxf(pmax, p1[r]);
  { auto rr = __builtin_amdgcn_permlane32_swap(__float_as_uint(pmax), __float_as_uint(pmax), false, false);
    pmax = fmaxf(__uint_as_float(rr[0]), __uint_as_float(rr[1])); }
  if (__builtin_expect(__all(pmax - m_reg <= THR2), 1)) { mn = m_reg; alpha = 1.f; }
  else { mn = fmaxf(m_reg, pmax); alpha = __builtin_amdgcn_exp2f(m_reg - mn); m_reg = mn; }
#pragma unroll
  for (int r = 0; r < 16; ++r) p0[r] = p0[r] - mn;
#pragma unroll
  for (int r = 0; r < 16; ++r) p1[r] = p1[r] - mn;
#pragma unroll
  for (int r = 0; r < 16; ++r) p0[r] = __builtin_amdgcn_exp2f(p0[r]);
}
__device__ __forceinline__ void finishSM(f32x16& p0, f32x16& p1, float alpha, float& l_reg, bf16x8& pa0, bf16x8& pa1, bf16x8& pa2, bf16x8& pa3) {
#pragma unroll
  for (int r = 0; r < 16; ++r) p1[r] = __builtin_amdgcn_exp2f(p1[r]);
  float ps = 0;
#pragma unroll
  for (int r = 0; r < 16; ++r) ps += p0[r];
#pragma unroll
  for (int r = 0; r < 16; ++r) ps += p1[r];
  { auto rr = __builtin_amdgcn_permlane32_swap(__float_as_uint(ps), __float_as_uint(ps), false, false);
    ps = __uint_as_float(rr[0]) + __uint_as_float(rr[1]); }
  l_reg = l_reg * alpha + ps;
#define PK4(P, BASE, OUT) do { unsigned a0 = cvt_pk_bf16(P[BASE + 0], P[BASE + 1]), a1 = cvt_pk_bf16(P[BASE + 2], P[BASE + 3]);   \
    unsigned b0 = cvt_pk_bf16(P[BASE + 4], P[BASE + 5]), b1 = cvt_pk_bf16(P[BASE + 6], P[BASE + 7]);                              \
    auto r0 = __builtin_amdgcn_permlane32_swap(a0, b0, false, false); auto r1 = __builtin_amdgcn_permlane32_swap(a1, b1, false, false); \
    u32x4 w = {r0[0], r1[0], r0[1], r1[1]}; OUT = *reinterpret_cast<bf16x8*>(&w); } while (0)
  PK4(p0, 0, pa0); PK4(p0, 8, pa1); PK4(p1, 0, pa2); PK4(p1, 8, pa3);
#undef PK4
}
__device__ __forceinline__ void qkt(f32x16& p0, f32x16& p1, unsigned kn, unsigned kr, unsigned qrp, const bf16x8 (&qr)[12], int r32, int hi) {
  p0 = f32x16{}; p1 = f32x16{};
  unsigned hb = (unsigned)hi * 16u; asm volatile("" : "+v"(hb));
  const unsigned swn = ((unsigned)r32 & 7u) << 4, swr = (((unsigned)r32 >> 1) & 7u) << 4, an = kn + (unsigned)r32 * 256u, ar = kr + (unsigned)r32 * 128u;
#pragma unroll
  for (int d0 = 0; d0 < 8; ++d0) { const unsigned ad = an + (((unsigned)d0 * 32u + hb) ^ swn);
    const bf16x8 b0 = *(const LAS bf16x8*)(uintptr_t)ad;
    const bf16x8 b1 = *(const LAS bf16x8*)(uintptr_t)(ad + 8192u);
    p0 = __builtin_amdgcn_mfma_f32_32x32x16_bf16(b0, qr[d0], p0, 0, 0, 0);
    p1 = __builtin_amdgcn_mfma_f32_32x32x16_bf16(b1, qr[d0], p1, 0, 0, 0); }
#pragma unroll
  for (int d0 = 0; d0 < 4; ++d0) { const unsigned ad = ar + (((unsigned)d0 * 32u + hb) ^ swr);
    const bf16x8 b0 = *(const LAS bf16x8*)(uintptr_t)ad;
    const bf16x8 b1 = *(const LAS bf16x8*)(uintptr_t)(ad + 4096u);
    p0 = __builtin_amdgcn_mfma_f32_32x32x16_bf16(b0, qr[8 + d0], p0, 0, 0, 0);
    p1 = __builtin_amdgcn_mfma_f32_32x32x16_bf16(b1, qr[8 + d0], p1, 0, 0, 0); }
  (void)qrp;
}
__device__ __forceinline__ int v_st(int k, int c) { const int kk = (k & ~0xC) | ((k & 4) << 1) | ((k & 8) >> 1); return ((kk >> 3) * 4 + (c >> 5)) * 512 + ((kk & 7) * 32 + (c & 31)) * 2; }
__device__ __forceinline__ int v_rd_base(int lane) { return ((lane & 3) << 3) | (((lane >> 2) & 3) << 6) | (((lane >> 4) & 1) << 5) | (((lane >> 5) & 1) << 8); }
constexpr int v_rd_off(int d0, int ks, int half) { return d0 * 512 + ks * 4096 + half * 2048; }
template <int OFF> __device__ __forceinline__ s16x4 tr_read(int vb) {
  s16x4 r; asm volatile("ds_read_b64_tr_b16 %0, %1 offset:%2" : "=&v"(r) : "v"(vb), "i"(OFF) : "memory"); return r;
}
template <int D0> __device__ __forceinline__ void pv_one(f32x16& od, int vb, bf16x8 pa0, bf16x8 pa1, bf16x8 pa2, bf16x8 pa3) {
  const s16x4 l0 = tr_read<v_rd_off(D0, 0, 0)>(vb), h0 = tr_read<v_rd_off(D0, 0, 1)>(vb), l1 = tr_read<v_rd_off(D0, 1, 0)>(vb), h1 = tr_read<v_rd_off(D0, 1, 1)>(vb);
  const s16x4 l2 = tr_read<v_rd_off(D0, 2, 0)>(vb), h2 = tr_read<v_rd_off(D0, 2, 1)>(vb), l3 = tr_read<v_rd_off(D0, 3, 0)>(vb), h3 = tr_read<v_rd_off(D0, 3, 1)>(vb);
  asm volatile("s_waitcnt lgkmcnt(0)" ::: "memory"); SBAR();
#define PK(L, H) (bf16x8){L[0], L[1], L[2], L[3], H[0], H[1], H[2], H[3]}
  od = __builtin_amdgcn_mfma_f32_32x32x16_bf16(pa0, PK(l0, h0), od, 0, 0, 0);
  od = __builtin_amdgcn_mfma_f32_32x32x16_bf16(pa1, PK(l1, h1), od, 0, 0, 0);
  od = __builtin_amdgcn_mfma_f32_32x32x16_bf16(pa2, PK(l2, h2), od, 0, 0, 0);
  od = __builtin_amdgcn_mfma_f32_32x32x16_bf16(pa3, PK(l3, h3), od, 0, 0, 0);
#undef PK
}
__device__ __forceinline__ void pv_d0(f32x16* o, int vb, bf16x8 pa0, bf16x8 pa1, bf16x8 pa2, bf16x8 pa3) {
  pv_one<0>(o[0], vb, pa0, pa1, pa2, pa3); pv_one<1>(o[1], vb, pa0, pa1, pa2, pa3); pv_one<2>(o[2], vb, pa0, pa1, pa2, pa3); pv_one<3>(o[3], vb, pa0, pa1, pa2, pa3);
}
constexpr int BUFB = 40960, OFF_RV = 0, OFF_RKN = 16384, OFF_RKR = 32768, OFF_RWS = 3 * BUFB, OFF_QR = OFF_RWS + 2048  ;
__device__ __forceinline__ void attn_unit(const bf16_t* __restrict__ Qb, const bf16_t* __restrict__ Kh, const bf16_t* __restrict__ Vh, bf16_t* Zp, int seq, LAS unsigned char* lds, int tid_in) {
  int tid = tid_in; asm volatile("" : "+v"(tid));
  const int wid = __builtin_amdgcn_readfirstlane(tid >> 6), lane = tid & 63, r32 = lane & 31, hi = lane >> 5;
  LAS float* wsl = (LAS float*)(lds + OFF_RWS) + wid * 64; LAS float* li_l = wsl; LAS float* al_l = wsl + 32;
  float m_reg = -1e30f, l_reg = 0; f32x16 o[4] = {}; bf16x8 qr[12];
  const bf16_t* Qw = Qb + (size_t)(wid * 32 + r32) * 192 + hi * 8;
#pragma unroll
  for (int d0 = 0; d0 < 12; ++d0) qr[d0] = *(const bf16x8*)(Qw + d0 * 16);
  const unsigned ldsb = (unsigned)(uintptr_t)lds, qrp = ldsb + (unsigned)(OFF_QR + wid * 4096);
  unsigned sov[2], sok[2], sor;
#pragma unroll
  for (int i = 0; i < 2; ++i) {
    { const int c = 2 * wid + i, sub = 2 * c + (lane >> 5), kk = (sub >> 2) * 8 + ((lane & 31) >> 2), k = (kk & ~0xC) | ((kk & 4) << 1) | ((kk & 8) >> 1), col = (sub & 3) * 32 + (lane & 3) * 8;
      sov[i] = (unsigned)(k * 128 + col) * 2u; }
    { const int c = 2 * wid + i, row = 4 * c + (lane >> 4), u = (lane & 15) ^ (row & 7); sok[i] = (unsigned)(row * 384 + u * 16); }
  }
  { const int row = 8 * wid + (lane >> 3), u = (lane & 7) ^ ((row >> 1) & 7); sor = (unsigned)(row * 384 + 256 + u * 16); }
#define DMA(j) do { const int b_ = (j) % 3; const char* vt_ = (const char*)Vh + (size_t)(j) * (64 * 128 * 2); const char* kt_ = (const char*)Kh + (size_t)(j) * (64 * 192 * 2); \
    __builtin_amdgcn_global_load_lds((const unsigned*)(vt_ + sov[0]), (LAS unsigned*)(lds + b_ * BUFB + OFF_RV + (2 * wid) * 1024), 16, 0, 0); \
    __builtin_amdgcn_global_load_lds((const unsigned*)(vt_ + sov[1]), (LAS unsigned*)(lds + b_ * BUFB + OFF_RV + (2 * wid + 1) * 1024), 16, 0, 0); \
    __builtin_amdgcn_global_load_lds((const unsigned*)(kt_ + sok[0]), (LAS unsigned*)(lds + b_ * BUFB + OFF_RKN + (2 * wid) * 1024), 16, 0, 0); \
    __builtin_amdgcn_global_load_lds((const unsigned*)(kt_ + sok[1]), (LAS unsigned*)(lds + b_ * BUFB + OFF_RKN + (2 * wid + 1) * 1024), 16, 0, 0); \
    __builtin_amdgcn_global_load_lds((const unsigned*)(kt_ + sor), (LAS unsigned*)(lds + b_ * BUFB + OFF_RKR + wid * 1024), 16, 0, 0); } while (0)
#define VMW(n) asm volatile("s_waitcnt vmcnt(" #n ")" ::: "memory")
#define BAR() do { asm volatile("" ::: "memory"); __builtin_amdgcn_s_barrier(); asm volatile("" ::: "memory"); } while (0)
#define RESC(a) do { if (__any((a) < 1.f)) { if (hi == 0) al_l[r32] = (a); asm volatile("s_waitcnt lgkmcnt(0)" ::: "memory"); \
    _Pragma("unroll") for (int d = 0; d < 4; ++d) _Pragma("unroll") for (int r = 0; r < 16; ++r) o[d][r] *= al_l[crow(r, hi)]; } } while (0)
#define KN(j) (ldsb + (unsigned)(((j) % 3) * BUFB + OFF_RKN))
#define KRP(j) (ldsb + (unsigned)(((j) % 3) * BUFB + OFF_RKR))
#define VB(j) (vb0 + ((j) % 3) * BUFB)
  const int vb0 = (int)ldsb + OFF_RV + v_rd_base(lane);
  f32x16 pA0, pA1, pB0, pB1; float mnA, mnB, alA, alB; bf16x8 pa0, pa1, pa2, pa3; const int NT = seq / 64;
  DMA(0); DMA(1);
  VMW(5); BAR();
  qkt(pA0, pA1, KN(0), KRP(0), qrp, qr, r32, hi); partialSM(pA0, pA1, m_reg, mnA, alA);
  VMW(0); BAR();
  DMA(2);
  if (wid < 4) {
    for (int j = 1; j + 1 < NT; j += 2) {
      SBAR(); qkt(pB0, pB1, KN(j), KRP(j), qrp, qr, r32, hi);
      finishSM(pA0, pA1, alA, l_reg, pa0, pa1, pa2, pa3); SBAR();
      pv_d0(o, VB(j - 1), pa0, pa1, pa2, pa3); partialSM(pB0, pB1, m_reg, mnB, alB);
      VMW(0); BAR();
      DMA(j + 2);
      RESC(alB);
      SBAR(); qkt(pA0, pA1, KN(j + 1), KRP(j + 1), qrp, qr, r32, hi);
      finishSM(pB0, pB1, alB, l_reg, pa0, pa1, pa2, pa3); SBAR();
      pv_d0(o, VB(j), pa0, pa1, pa2, pa3); partialSM(pA0, pA1, m_reg, mnA, alA);
      VMW(0); BAR();
      if (j + 3 < NT) DMA(j + 3);
      RESC(alA);
    }
  } else {
    for (int j = 1; j + 1 < NT; j += 2) {
      SBAR(); finishSM(pA0, pA1, alA, l_reg, pa0, pa1, pa2, pa3); SBAR();
      pv_d0(o, VB(j - 1), pa0, pa1, pa2, pa3); SBAR();
      qkt(pB0, pB1, KN(j), KRP(j), qrp, qr, r32, hi); partialSM(pB0, pB1, m_reg, mnB, alB);
      VMW(0); BAR();
      DMA(j + 2);
      RESC(alB);
      SBAR(); finishSM(pB0, pB1, alB, l_reg, pa0, pa1, pa2, pa3); SBAR();
      pv_d0(o, VB(j), pa0, pa1, pa2, pa3); SBAR();
      qkt(pA0, pA1, KN(j + 1), KRP(j + 1), qrp, qr, r32, hi); partialSM(pA0, pA1, m_reg, mnA, alA);
      VMW(0); BAR();
      if (j + 3 < NT) DMA(j + 3);
      RESC(alA);
    }
  }
  SBAR(); qkt(pB0, pB1, KN(NT - 1), KRP(NT - 1), qrp, qr, r32, hi);
  finishSM(pA0, pA1, alA, l_reg, pa0, pa1, pa2, pa3); SBAR();
  pv_d0(o, VB(NT - 2), pa0, pa1, pa2, pa3); partialSM(pB0, pB1, m_reg, mnB, alB);
  RESC(alB);
  int r32e = r32, hie = hi; asm volatile("" : "+v"(r32e), "+v"(hie));
  bf16_t* Zw = Zp + (size_t)(wid * 32 + 4 * hie) * OD_LD + r32e;
  bf16_t zv[16][4];
#pragma unroll
  for (int r = 0; r < 16; ++r) { const int orow = (r & 3) + 8 * (r >> 2);
#pragma unroll
    for (int d0 = 0; d0 < 4; ++d0) zv[r][d0] = Zw[(size_t)orow * OD_LD + d0 * 32]; }
  SBAR();
  finishSM(pB0, pB1, alB, l_reg, pa0, pa1, pa2, pa3); SBAR();
  pv_d0(o, VB(NT - 1), pa0, pa1, pa2, pa3);
  if (hi == 0) li_l[r32] = l_reg; asm volatile("s_waitcnt lgkmcnt(0)" ::: "memory");
  float rli[16];
#pragma unroll
  for (int r = 0; r < 16; ++r) rli[r] = __builtin_amdgcn_rcpf(li_l[crow(r, hi)]);
#pragma unroll
  for (int r = 0; r < 16; ++r) { const int orow = (r & 3) + 8 * (r >> 2);
#pragma unroll
    for (int d0 = 0; d0 < 4; ++d0) Zw[(size_t)orow * OD_LD + d0 * 32] = f2bf(o[d0][r] * rli[r] * bf1(zv[r][d0])); }
  VMW(0); BAR();
#undef DMA
#undef VMW
#undef BAR
#undef RESC
#undef KN
#undef KRP
#undef VB
}
}

namespace msc {
using att::f32x16; using att::s16x4; using att::crow; using att::v_st; using att::v_rd_base; using att::v_rd_off; using att::tr_read;
constexpr int CL = 32, NCH = SB / CL;
constexpr int BUF = 40960, O_Q = 0, O_K = 16384, O_V = 32768, O_KW = 81920, O_X = 98304, O_A = 114688, O_G = O_A + 9216, O_M = O_G + 9216, O_MP = O_M + 9216, O_N = 142848, O_QN = 144896, O_PW = 145408, O_PST = 148480, O_RS = 156672;
#define PK4(P, BASE, OUT) do { unsigned a0 = cvt_pk_bf16(P[BASE + 0], P[BASE + 1]), a1 = cvt_pk_bf16(P[BASE + 2], P[BASE + 3]);   \
    unsigned b0 = cvt_pk_bf16(P[BASE + 4], P[BASE + 5]), b1 = cvt_pk_bf16(P[BASE + 6], P[BASE + 7]);                              \
    auto r0 = __builtin_amdgcn_permlane32_swap(a0, b0, false, false); auto r1 = __builtin_amdgcn_permlane32_swap(a1, b1, false, false); \
    u32x4 w = {r0[0], r1[0], r0[1], r1[1]}; OUT = *reinterpret_cast<bf16x8*>(&w); } while (0)
#define PKLH(L, H) (bf16x8){L[0], L[1], L[2], L[3], H[0], H[1], H[2], H[3]}
__device__ __forceinline__ void scan_item(const bf16_t* evb  , const float* gb  , bf16_t* hfb  ,
                                          int head, int dh, LAS unsigned char* lds, int wave0) {
  int tid; asm volatile("v_mbcnt_lo_u32_b32 %0, -1, 0\n\tv_mbcnt_hi_u32_b32 %0, -1, %0" : "=v"(tid)); tid += wave0 * 64;
  const int tid_o = tid; const int wid = wave0, lane = tid & 63, r32 = lane & 31, hi = lane >> 5, kh = wid >> 2, dq = wid & 3; (void)r32; (void)hi;
  const unsigned ldsb = (unsigned)(uintptr_t)lds;
  LAS float* aS = (LAS float*)(lds + O_A); LAS float* gT = (LAS float*)(lds + O_G); LAS float* mT = (LAS float*)(lds + O_M); LAS float* mP = (LAS float*)(lds + O_MP);
  LAS float* nbuf = (LAS float*)(lds + O_N); LAS float* qnS = (LAS float*)(lds + O_QN); LAS float* pw = (LAS float*)(lds + O_PW) + wid * 96;
  LAS float* xch = (LAS float*)(lds + O_X) + dq * 1024; LAS float* rsS = (LAS float*)(lds + O_RS);
#define BARX() do { asm volatile("" ::: "memory"); __builtin_amdgcn_s_barrier(); asm volatile("" ::: "memory"); } while (0)
#define LGK0() do { asm volatile("s_waitcnt lgkmcnt(0)" ::: "memory"); __builtin_amdgcn_sched_barrier(0); } while (0)
  for (int dir = 0; dir < 2; ++dir) {
    asm volatile("s_waitcnt vmcnt(0) lgkmcnt(0)" ::: "memory"); BARX();
    {
      LAS float* rawI = (LAS float*)lds; LAS float* rawF = rawI + SB; LAS float* Bc = rawF + SB; LAS float* CMc = Bc + 128;
      {
        float ipv[5], fpv[5];
#pragma unroll
        for (int i = 0; i < 5; ++i) { const int jx = tid + 512 * i; ipv[i] = 0.f; fpv[i] = 0.f;
          if (jx < SB) { const int srow = dir == 0 ? jx : (jx < CTXL ? CTXL - 1 - jx : SB - 1 - (jx - CTXL)); const float* gr = gb + (size_t)srow * 16 + dir * 8; ipv[i] = gr[head]; fpv[i] = gr[4 + head]; } }
#pragma unroll
        for (int i = 0; i < 5; ++i) { const int jx = tid + 512 * i; if (jx < SB) { rawI[jx] = ipv[i]; rawF[jx] = fminf(fpv[i], 0.f) - __logf(1.0f + __expf(-fabsf(fpv[i]))); } }
      }
      if (tid < 256) { nbuf[tid] = 0.f; nbuf[256 + tid] = 0.f; }
      LGK0(); BARX();
      for (int c = wid; c < NCH; c += 8) {
        const int l5 = lane & 31; const float ip = rawI[c * CL + l5]; float bsum = rawF[c * CL + l5];
#pragma unroll
        for (int o = 1; o < 32; o <<= 1) { const float t = __shfl_up(bsum, o, 32); if (l5 >= o) bsum += t; }
        const float a = ip - bsum; float cm = a;
#pragma unroll
        for (int o = 1; o < 32; o <<= 1) { const float t = __shfl_up(cm, o, 32); if (l5 >= o) cm = fmaxf(cm, t); }
        if (lane < 32) { aS[c * CL + l5] = a; gT[c * CL + l5] = cm; mT[c * CL + l5] = bsum; }
        if (lane == 31) { Bc[c] = bsum; CMc[c] = cm; }
      }
      LGK0(); BARX();
      if (tid == 0) { float mp = -1e30f; for (int c = 0; c < NCH; ++c) { mP[c] = mp; mp = Bc[c] + fmaxf(mp, CMc[c]); } }
      LGK0(); BARX();
      for (int jx = tid; jx < SB; jx += 512) { const float g = fmaxf(mP[jx >> 5], gT[jx]); gT[jx] = g; mT[jx] = mT[jx] + g; }
      LGK0(); BARX();
    }
    unsigned soq[2], sov;
#pragma unroll
    for (int i = 0; i < 2; ++i) { const int c2 = 2 * wid + i, t = 2 * c2 + (lane >> 5), u = (lane & 31) ^ (t & 15), ro = dir ? 31 - t : t; soq[i] = (unsigned)(ro * EV_LD * 2 + u * 16); }
    { const int sub = 2 * wid + (lane >> 5), kk = (sub >> 2) * 8 + ((lane & 31) >> 2), s_ = (kk & ~0xC) | ((kk & 4) << 1) | ((kk & 8) >> 1), col = (sub & 3) * 32 + (lane & 3) * 8, ro = dir ? 31 - s_ : s_;
      sov = (unsigned)(ro * EV_LD * 2 + col * 2); }
#define SLO(c) (dir == 0 ? (c) * CL : ((c) * CL < CTXL ? CTXL - CL - (c) * CL : SB - CL - ((c) * CL - CTXL)))
#define DMA(c) do { const int b_ = (c) & 1; const char* rb_ = (const char*)(evb + (size_t)SLO(c) * EV_LD); \
    const char* qb_ = rb_ + (3072 + head * 256) * 2; const char* kb_ = rb_ + (4096 + head * 256) * 2; const char* vb_ = rb_ + (5120 + head * 256 + dh * 128) * 2; \
    __builtin_amdgcn_global_load_lds((const unsigned*)(qb_ + soq[0]), (LAS unsigned*)(lds + b_ * BUF + O_Q + (2 * wid) * 1024), 16, 0, 0); \
    __builtin_amdgcn_global_load_lds((const unsigned*)(qb_ + soq[1]), (LAS unsigned*)(lds + b_ * BUF + O_Q + (2 * wid + 1) * 1024), 16, 0, 0); \
    __builtin_amdgcn_global_load_lds((const unsigned*)(kb_ + soq[0]), (LAS unsigned*)(lds + b_ * BUF + O_K + (2 * wid) * 1024), 16, 0, 0); \
    __builtin_amdgcn_global_load_lds((const unsigned*)(kb_ + soq[1]), (LAS unsigned*)(lds + b_ * BUF + O_K + (2 * wid + 1) * 1024), 16, 0, 0); \
    __builtin_amdgcn_global_load_lds((const unsigned*)(vb_ + sov), (LAS unsigned*)(lds + b_ * BUF + O_V + wid * 1024), 16, 0, 0); } while (0)
    f32x16 C[4] = {};
    float nv[4] = {0.f, 0.f, 0.f, 0.f};
    const bf16x8 ones8 = {0x3F80, 0x3F80, 0x3F80, 0x3F80, 0x3F80, 0x3F80, 0x3F80, 0x3F80};
    DMA(0); DMA(1);
    asm volatile("s_waitcnt vmcnt(5)" ::: "memory"); BARX();
    for (int c = 0; c < NCH; ++c) {
      int tid = tid_o; asm volatile("" : "+v"(tid));
      const int lane = tid & 63, r32 = lane & 31, hi = lane >> 5, dcol = head * 256 + dh * 128 + dq * 32 + r32;
      const unsigned tb = ldsb + (unsigned)((c & 1) * BUF);
      const float mprev = mP[c], glast = gT[c * CL + CL - 1];
      const float decay = __expf(mprev - glast);
      const unsigned rb = (unsigned)r32 * 512u, sw = ((unsigned)r32 & 15u) << 4; unsigned hb = (unsigned)hi * 16u; asm volatile("" : "+v"(hb));
      const int slo = SLO(c);
      bf16_t pf_h[16], pf_o[16];
      if (kh == 1) {
        f32x16 pe = {}, po = {};
#pragma unroll
        for (int kk = 0; kk < 16; kk += 2) { const unsigned ad0 = tb + rb + (((unsigned)kk * 32u + hb) ^ sw), ad1 = tb + rb + (((unsigned)(kk + 1) * 32u + hb) ^ sw);
          const bf16x8 kf0 = *(const LAS bf16x8*)(uintptr_t)(ad0 + O_K), qf0 = *(const LAS bf16x8*)(uintptr_t)(ad0 + O_Q);
          const bf16x8 kf1 = *(const LAS bf16x8*)(uintptr_t)(ad1 + O_K), qf1 = *(const LAS bf16x8*)(uintptr_t)(ad1 + O_Q);
          pe = __builtin_amdgcn_mfma_f32_32x32x16_bf16(kf0, qf0, pe, 0, 0, 0);
          po = __builtin_amdgcn_mfma_f32_32x32x16_bf16(kf1, qf1, po, 0, 0, 0); }
        f32x16 p = pe + po;
        const float gt = gT[c * CL + r32]; float rowsum = 0.f;
#pragma unroll
        for (int r4 = 0; r4 < 4; ++r4) { const f32x4 a4 = *(const LAS f32x4*)(aS + c * CL + 8 * r4 + 4 * hi);
#pragma unroll
          for (int e = 0; e < 4; ++e) { const int sidx = 8 * r4 + 4 * hi + e; const float w = (sidx <= r32) ? __expf(a4[e] - gt) : 0.f; p[4 * r4 + e] *= w; rowsum += p[4 * r4 + e]; } }
        { auto rr = __builtin_amdgcn_permlane32_swap(__float_as_uint(rowsum), __float_as_uint(rowsum), false, false); rowsum = __uint_as_float(rr[0]) + __uint_as_float(rr[1]); }
        bf16x8 pa0, pa1; PK4(p, 0, pa0); PK4(p, 8, pa1);
        *(LAS bf16x8*)(lds + O_PST + (dq * 2 + 0) * 1024 + lane * 16) = pa0; *(LAS bf16x8*)(lds + O_PST + (dq * 2 + 1) * 1024 + lane * 16) = pa1;
        if (hi == 0) rsS[dq * 32 + r32] = rowsum;
      } else {
        if (dir == 1) {
          const char* hb_ = (const char*)(hfb + (size_t)slo * DM); const char* ob_ = (const char*)(evb + (size_t)slo * EV_LD + 1024);
          const unsigned ho = (unsigned)((31 - 4 * hi) * DM + dcol) * 2u, oo = (unsigned)((31 - 4 * hi) * EV_LD + dcol) * 2u;
#pragma unroll
          for (int r = 0; r < 16; ++r) { const int tc = (r & 3) + 8 * (r >> 2);
            pf_h[r] = *(const bf16_t*)(hb_ + (ho - (unsigned)(tc * DM * 2))); pf_o[r] = *(const bf16_t*)(ob_ + (oo - (unsigned)(tc * EV_LD * 2))); }
        }
        { const int s_ = tid >> 3, cb = (tid & 7) * 8; const float wt = __expf(aS[c * CL + s_] - glast);
#pragma unroll
          for (int h4 = 0; h4 < 4; ++h4) { const int c8 = cb + 64 * h4; f32x4 x0, x1;
            unpack8(*(const LAS u32x4*)(uintptr_t)(tb + O_K + (unsigned)s_ * 512u + ((unsigned)(c8 * 2) ^ (((unsigned)s_ & 15u) << 4))), x0, x1);
            *(LAS u32x4*)(lds + O_KW + (c8 >> 7) * 8192 + v_st(s_, c8 & 127)) = pack8(x0 * wt, x1 * wt); } }
        { const int t_ = tid >> 3, part = tid & 7; const LAS float* nb = nbuf + (c & 1) * 256 + part * 32; float acc = 0.f;
#pragma unroll
          for (int e = 0; e < 4; ++e) { f32x4 x0, x1; unpack8(*(const LAS u32x4*)(uintptr_t)(tb + O_Q + (unsigned)t_ * 512u + ((unsigned)(part * 64 + e * 16) ^ (((unsigned)t_ & 15u) << 4))), x0, x1);
            const f32x4 n0 = *(const LAS f32x4*)(nb + e * 8), n1 = *(const LAS f32x4*)(nb + e * 8 + 4);
            acc += x0[0] * n0[0] + x0[1] * n0[1] + x0[2] * n0[2] + x0[3] * n0[3] + x1[0] * n1[0] + x1[1] * n1[1] + x1[2] * n1[2] + x1[3] * n1[3]; }
          acc += __shfl_xor(acc, 1); acc += __shfl_xor(acc, 2); acc += __shfl_xor(acc, 4);
          if (part == 0) qnS[t_] = acc; }
      }
      LGK0(); BARX();
      f32x16 aq0 = {}, aq1 = {};
#pragma unroll
      for (int j = 0; j < 8; ++j) { const unsigned ad = tb + O_Q + rb + (((unsigned)(8 * kh + j) * 32u + hb) ^ sw);
        const bf16x8 qf = *(const LAS bf16x8*)(uintptr_t)ad; bf16x8 cf;
        if ((j & 1) == 0) { PK4(C[j >> 1], 0, cf); aq0 = __builtin_amdgcn_mfma_f32_32x32x16_bf16(qf, cf, aq0, 0, 0, 0); }
        else { PK4(C[j >> 1], 8, cf); aq1 = __builtin_amdgcn_mfma_f32_32x32x16_bf16(qf, cf, aq1, 0, 0, 0); } }
      f32x16 aqc = aq0 + aq1;
      const int vbase = (int)(tb + O_V) + v_rd_base(lane) + dq * 512;
      const int kwb = (int)(ldsb + O_KW + kh * 8192) + v_rd_base(lane);
      const s16x4 vl0 = tr_read<v_rd_off(0, 0, 0)>(vbase), vh0 = tr_read<v_rd_off(0, 0, 1)>(vbase), vl1 = tr_read<v_rd_off(0, 1, 0)>(vbase), vh1 = tr_read<v_rd_off(0, 1, 1)>(vbase);
      const s16x4 a0l0 = tr_read<v_rd_off(0, 0, 0)>(kwb), a0h0 = tr_read<v_rd_off(0, 0, 1)>(kwb), a0l1 = tr_read<v_rd_off(0, 1, 0)>(kwb), a0h1 = tr_read<v_rd_off(0, 1, 1)>(kwb);
      const s16x4 a1l0 = tr_read<v_rd_off(1, 0, 0)>(kwb), a1h0 = tr_read<v_rd_off(1, 0, 1)>(kwb), a1l1 = tr_read<v_rd_off(1, 1, 0)>(kwb), a1h1 = tr_read<v_rd_off(1, 1, 1)>(kwb);
      const s16x4 a2l0 = tr_read<v_rd_off(2, 0, 0)>(kwb), a2h0 = tr_read<v_rd_off(2, 0, 1)>(kwb), a2l1 = tr_read<v_rd_off(2, 1, 0)>(kwb), a2h1 = tr_read<v_rd_off(2, 1, 1)>(kwb);
      const s16x4 a3l0 = tr_read<v_rd_off(3, 0, 0)>(kwb), a3h0 = tr_read<v_rd_off(3, 0, 1)>(kwb), a3l1 = tr_read<v_rd_off(3, 1, 0)>(kwb), a3h1 = tr_read<v_rd_off(3, 1, 1)>(kwb);
      bf16x8 pa0 = {}, pa1 = {};
      if (kh == 0) { pa0 = *(const LAS bf16x8*)(lds + O_PST + (dq * 2 + 0) * 1024 + lane * 16); pa1 = *(const LAS bf16x8*)(lds + O_PST + (dq * 2 + 1) * 1024 + lane * 16); }
      LGK0();
      const bf16x8 vf0 = PKLH(vl0, vh0), vf1 = PKLH(vl1, vh1);
      const bf16x8 kwf[4][2] = {{PKLH(a0l0, a0h0), PKLH(a0l1, a0h1)}, {PKLH(a1l0, a1h0), PKLH(a1l1, a1h1)}, {PKLH(a2l0, a2h0), PKLH(a2l1, a2h1)}, {PKLH(a3l0, a3h0), PKLH(a3l1, a3h1)}};
      f32x16 asv = {};
      if (kh == 0) {
        asv = __builtin_amdgcn_mfma_f32_32x32x16_bf16(pa0, vf0, asv, 0, 0, 0);
        asv = __builtin_amdgcn_mfma_f32_32x32x16_bf16(pa1, vf1, asv, 0, 0, 0);
        const float ai = __expf(mprev - gT[c * CL + r32]);
        pw[r32] = rsS[dq * 32 + r32] + ai * qnS[r32]; pw[32 + r32] = ai; pw[64 + r32] = __expf(-mT[c * CL + r32]);
      } else {
#pragma unroll
        for (int r = 0; r < 16; ++r) xch[r * 64 + lane] = aqc[r];
      }
#pragma unroll
      for (int i = 0; i < 4; ++i) {
#pragma unroll
        for (int r = 0; r < 16; ++r) C[i][r] *= decay;
        C[i] = __builtin_amdgcn_mfma_f32_32x32x16_bf16(kwf[i][0], vf0, C[i], 0, 0, 0);
        C[i] = __builtin_amdgcn_mfma_f32_32x32x16_bf16(kwf[i][1], vf1, C[i], 0, 0, 0);
        if (dq == 0) {
          f32x16 na = {}; na = __builtin_amdgcn_mfma_f32_32x32x16_bf16(ones8, kwf[i][0], na, 0, 0, 0); na = __builtin_amdgcn_mfma_f32_32x32x16_bf16(ones8, kwf[i][1], na, 0, 0, 0);
          nv[i] = decay * nv[i] + na[0];
          if (hi == 0) nbuf[((c + 1) & 1) * 256 + kh * 128 + i * 32 + r32] = nv[i]; }
      }
      asm volatile("s_waitcnt vmcnt(0) lgkmcnt(0)" ::: "memory"); BARX();
      if (c + 2 < NCH) DMA(c + 2);
      if (kh == 0) {
        float hvs[16];
#pragma unroll
        for (int r4 = 0; r4 < 4; ++r4) {
          const f32x4 dn = *(const LAS f32x4*)(pw + 8 * r4 + 4 * hi), ai4 = *(const LAS f32x4*)(pw + 32 + 8 * r4 + 4 * hi), em4 = *(const LAS f32x4*)(pw + 64 + 8 * r4 + 4 * hi);
#pragma unroll
          for (int e = 0; e < 4; ++e) { const int r = 4 * r4 + e;
            hvs[r] = (asv[r] + ai4[e] * (aqc[r] + xch[r * 64 + lane])) * __builtin_amdgcn_rcpf(fmaxf(fabsf(dn[e]), em4[e])); }
        }
        if (dir == 0) {
          char* hb_ = (char*)(hfb + (size_t)slo * DM); const unsigned ho = (unsigned)((4 * hi) * DM + dcol) * 2u;
#pragma unroll
          for (int r = 0; r < 16; ++r) { const int tc = (r & 3) + 8 * (r >> 2); *(bf16_t*)(hb_ + (ho + (unsigned)(tc * DM * 2))) = f2bf(hvs[r]); }
        } else {
          char* ob_ = (char*)((bf16_t*)evb + (size_t)slo * EV_LD + 1024); const unsigned oo = (unsigned)((31 - 4 * hi) * EV_LD + dcol) * 2u;
#pragma unroll
          for (int r = 0; r < 16; ++r) { const int tc = (r & 3) + 8 * (r >> 2); *(bf16_t*)(ob_ + (oo - (unsigned)(tc * EV_LD * 2))) = f2bf(bf1(pf_o[r]) * (bf1(pf_h[r]) + hvs[r])); }
        }
      }
    }
#undef DMA
#undef SLO
  }
  asm volatile("s_waitcnt vmcnt(0) lgkmcnt(0)" ::: "memory"); BARX();
#undef BARX
#undef LGK0
}
#undef PK4
#undef PKLH
}

struct Params { const float* in[18]; float* out; unsigned char* ws; };
constexpr int LDS_BYTES = 163840, LDS_CTL = 162816, MISC_OFF = LDS_CTL + 320;

template <int MID> __device__ __forceinline__ int wmap(int n) {
    if (MID == 0) {
        const int pn = n >> 8, lc = n & 255, bj = lc >> 7, c = lc & 127;
        if (pn < 8)  return (bj ? 3072 : 0) + 128 * pn + c;
        if (pn < 16) return (bj ? 8192 : 7168) + 128 * (pn - 8) + c;
        if (pn < 24) return (bj ? 2048 : 1024) + 128 * (pn - 16) + c;
        if (pn < 36) return 4096 + 256 * (pn - 24) + lc;
        return lc < 16 ? 9216 + lc : -1;
    } else if (MID == 2) {
        if (n < 2048) return 704 + n;
        return (n - 2048 < 704) ? n - 2048 : -1;
    } else if (MID == 3) {
        const int pn = n >> 8, lc = n & 255;
        if (pn < 8) return (n >> 7) * 192 + (n & 127);
        const int bj = lc >> 7, hh = (lc & 127) >> 5, i = lc & 31;
        return (4 * (pn - 8) + hh) * 192 + 128 + 32 * bj + i;
    }
    return n;
}
template <int MID> __device__ __forceinline__ void wconv_item(const float* W, int K, int NS, bf16_t* WT, int nblk, const float* kscale, LAS float* scr, int item, int lane) {
    const int kb = item / nblk, nb = item % nblk, k0 = 64 * kb, n0 = 32 * nb;
    const int src = wmap<MID>(n0 + (lane & 31));
    const float cs = (MID == 0 && src >= 5120 && src < 6144) ? 0.0625f : 1.0f;
    float wv[32];
#pragma unroll
    for (int i = 0; i < 32; ++i) { const int kk = 2 * i + (lane >> 5); wv[i] = (src >= 0) ? W[(size_t)(k0 + kk) * NS + src] : 0.f; }
#pragma unroll
    for (int i = 0; i < 32; ++i) { const int kk = 2 * i + (lane >> 5); float v = wv[i] * cs; if (kscale) v *= kscale[k0 + kk];
        scr[kk * 33 + (lane & 31)] = v; }
    LDS_WAIT(); asm volatile("" ::: "memory");
    const int c = lane & 7;
#pragma unroll
    for (int j = 0; j < 4; ++j) { const int n = (lane >> 3) + 8 * j; const LAS float* s = scr + (8 * c) * 33 + n;
        u32x4 o; o.x = cvt_pk_bf16(s[0 * 33], s[1 * 33]); o.y = cvt_pk_bf16(s[2 * 33], s[3 * 33]); o.z = cvt_pk_bf16(s[4 * 33], s[5 * 33]); o.w = cvt_pk_bf16(s[6 * 33], s[7 * 33]);
        *(u32x4*)(WT + (size_t)(n0 + n) * K + k0 + 8 * c) = o; }
    LDS_WAIT(); asm volatile("" ::: "memory");
}

constexpr int PTR_OFF = LDS_CTL + 512;
__device__ __forceinline__ const float* inp(LAS unsigned char* lds, int i) {
    unsigned off = (unsigned)(PTR_OFF + 8 * i); asm volatile("" : "+s"(off));
    volatile LAS unsigned* t = (volatile LAS unsigned*)(lds + off);
    const unsigned lo = __builtin_amdgcn_readfirstlane(t[0]), hi = __builtin_amdgcn_readfirstlane(t[1]);
    return (const float*)(((unsigned long long)hi << 32) | lo);
}
#define PH_BEGIN int tid; asm volatile("v_mbcnt_lo_u32_b32 %0, -1, 0\n\tv_mbcnt_hi_u32_b32 %0, -1, %0" : "=v"(tid)); tid += wave0 * 64; unsigned char* ws = ws0; unsigned char* dob = dob0; asm volatile("" : "+v"(tid), "+s"(ws), "+s"(dob)); \
    const int lane = tid & 63, wave = __builtin_amdgcn_readfirstlane(tid >> 6), G = gridDim.x, bx = blockIdx.x, vcu = (G % 8 == 0) ? (bx % 8) * (G / 8) + bx / 8 : bx, gw = vcu * 8 + wave, NGW = G * 8; \
    (void)lane; (void)wave; (void)gw; (void)NGW; (void)vcu; \
    bf16_t* U = (bf16_t*)(dob + DO_U); bf16_t* H = (bf16_t*)(ws + WS_H); bf16_t* BIG = (bf16_t*)(ws + WS_BIG); float* modv = (float*)(dob + DO_MODV); \
    (void)U; (void)H; (void)BIG; (void)modv;

template <bool FINAL>
__device__ __forceinline__ void ln_phase(bf16_t* H, bf16_t* U, float* outp, const float* ln_g, const float* ln_b, const float* modn, int gw, int NGW, int lane, unsigned tmo) {
    for (int rg = gw; rg < TOK / 4; rg += NGW) {
        const int r0 = rg * 4, b = r0 / SB, s0 = r0 % SB, midx = (s0 < CTXL) ? 32 : b;
        if (FINAL && s0 < CTXL) continue;
        bf16_t* hr = H + (size_t)r0 * DM;
        f32x4 v[4][2][2]; float sm[4], sq[4];
#pragma unroll
        for (int i = 0; i < 4; ++i)
#pragma unroll
            for (int jj = 0; jj < 2; ++jj) unpack8(*(const u32x4*)(hr + (size_t)i * DM + jj * 512 + lane * 8), v[i][jj][0], v[i][jj][1]);
#pragma unroll
        for (int i = 0; i < 4; ++i) { sm[i] = 0.f;
#pragma unroll
            for (int jj = 0; jj < 2; ++jj)
#pragma unroll
                for (int q = 0; q < 2; ++q) sm[i] += (v[i][jj][q][0] + v[i][jj][q][1]) + (v[i][jj][q][2] + v[i][jj][q][3]); }
#pragma unroll
        for (int o = 1; o < 64; o <<= 1)
#pragma unroll
            for (int i = 0; i < 4; ++i) sm[i] += __shfl_xor(sm[i], o);
#pragma unroll
        for (int i = 0; i < 4; ++i) { const float mean = sm[i] * (1.0f / DM); sq[i] = 0.f;
#pragma unroll
            for (int jj = 0; jj < 2; ++jj)
#pragma unroll
                for (int q = 0; q < 2; ++q) { v[i][jj][q] = v[i][jj][q] - mean; sq[i] += (v[i][jj][q][0] * v[i][jj][q][0] + v[i][jj][q][1] * v[i][jj][q][1]) + (v[i][jj][q][2] * v[i][jj][q][2] + v[i][jj][q][3] * v[i][jj][q][3]); } }
#pragma unroll
        for (int o = 1; o < 64; o <<= 1)
#pragma unroll
            for (int i = 0; i < 4; ++i) sq[i] += __shfl_xor(sq[i], o);
        const float* mv = FINAL ? nullptr : modn + (size_t)midx * 3072;
#pragma unroll
        for (int jj = 0; jj < 2; ++jj) { const int c = jj * 512 + lane * 8;
            f32x4 gg[2], bb[2], sh[2], sc[2];
#pragma unroll
            for (int q = 0; q < 2; ++q) { gg[q] = *(const f32x4*)(ln_g + c + 4 * q); bb[q] = *(const f32x4*)(ln_b + c + 4 * q);
                if (!FINAL) { sh[q] = *(const f32x4*)(mv + c + 4 * q); sc[q] = *(const f32x4*)(mv + 1024 + c + 4 * q) + 1.0f; } }
#pragma unroll
            for (int i = 0; i < 4; ++i) { const float rstd = 1.0f / sqrtf(sq[i] * (1.0f / DM) + LN_EPS);
                f32x4 y0 = v[i][jj][0] * rstd * gg[0] + bb[0], y1 = v[i][jj][1] * rstd * gg[1] + bb[1];
                if (!FINAL) { *(u32x4*)(hr + (size_t)i * DM + c) = pack8(y0, y1); *(u32x4*)(U + (size_t)(r0 + i) * DM + c) = pack8(y0 * sc[0] + sh[0], y1 * sc[1] + sh[1]); }
                else { float* op = outp + ((size_t)b * SEQ + (s0 + i - CTXL)) * DM + c;
                    if (tmo) { const float qn = __builtin_nanf(""); y0 = (f32x4){qn, qn, qn, qn}; y1 = y0; }
                    *(f32x4*)op = y0; *(f32x4*)(op + 4) = y1; } }
        }
    }
}

__global__ void __launch_bounds__(512, 2) fwd_kernel(Params p) {
    extern __shared__ __attribute__((aligned(16))) unsigned char lds_raw[];
    LAS unsigned char* lds = (LAS unsigned char*)lds_raw;
    const int tid0 = threadIdx.x;
    volatile LAS unsigned* MISC = (volatile LAS unsigned*)(lds + MISC_OFF);
    for (int u = tid0; u < (LDS_BYTES - LDS_CTL) / 4; u += 512) ((LAS unsigned*)(lds + LDS_CTL))[u] = 0u;
    __syncthreads();
    if (tid0 < 18) { const unsigned long long a = (unsigned long long)p.in[tid0]; volatile LAS unsigned* t = (volatile LAS unsigned*)(lds + PTR_OFF); t[2 * tid0] = (unsigned)a; t[2 * tid0 + 1] = (unsigned)(a >> 32); }
    __syncthreads();
    unsigned char* const ws0 = p.ws; unsigned char* const dob0 = (unsigned char*)p.out;
    const int wave0 = __builtin_amdgcn_readfirstlane(tid0 >> 6);
    (void)xcd_barrier_post((unsigned*)(ws0 + WS_CTL) + 4096, MISC + 8);
#define GRID_BAR() do { XcdBarrier b2_; b2_.bar = (unsigned*)(ws0 + WS_CTL) + 4096; asm volatile("" : "+s"(b2_.bar)); b2_.x = xb_xcc_id(); b2_.st = (volatile LAS unsigned*)(lds + MISC_OFF) + 8; xcd_barrier(b2_); } while (0)

    {
        PH_BEGIN
        LAS float* scr = (LAS float*)(lds + wave * 16384);
        for (int j = 0; j < 2; ++j) {
            unsigned char* wb = dob + DO_W + (size_t)j * W_PAIR;
            { const float* w = inp(lds, 8) + (size_t)j * 1024 * 9232; for (int it = gw; it < 16 * 296; it += NGW) wconv_item<0>(w, 1024, 9232, (bf16_t*)(wb + W_EVIN), 296, nullptr, scr, it, lane); }
            { const float* w = inp(lds, 11) + (size_t)j * 2048 * 1024; for (int it = gw; it < 32 * 32; it += NGW)  wconv_item<1>(w, 2048, 1024, (bf16_t*)(wb + W_EVOUT), 32, nullptr, scr, it, lane); }
            { const float* w = inp(lds, 12) + (size_t)j * 1024 * 2752; for (int it = gw; it < 16 * 88; it += NGW)  wconv_item<2>(w, 1024, 2752, (bf16_t*)(wb + W_ODIN), 88, nullptr, scr, it, lane); }
            { const float* w = inp(lds, 14) + (size_t)j * 384 * 3072; const float* ks = inp(lds, 13) + j * 384; for (int it = gw; it < 6 * 96; it += NGW)   wconv_item<3>(w, 384, 3072, (bf16_t*)(wb + W_UQ), 96, ks, scr, it, lane); }
            { const float* w = inp(lds, 16) + (size_t)j * 256 * 4096; const float* ks = inp(lds, 15) + j * 256; for (int it = gw; it < 4 * 128; it += NGW)  wconv_item<1>(w, 256, 4096, (bf16_t*)(wb + W_UKV), 128, ks, scr, it, lane); }
            { const float* w = inp(lds, 17) + (size_t)j * 2048 * 1024; for (int it = gw; it < 32 * 32; it += NGW)  wconv_item<1>(w, 2048, 1024, (bf16_t*)(wb + W_ODOUT), 32, nullptr, scr, it, lane); }
        }
        __syncthreads();
        {
            const float* cvec = inp(lds, 1); const float* cctx = inp(lds, 3); const float* mod_w = inp(lds, 4); const float* mod_b = inp(lds, 5);
            LAS float* Ssil = (LAS float*)lds;
            LAS float* red = (LAS float*)(lds + 33 * 128 * 4);
            const int cl = tid & 127, kq = tid >> 7;
            for (int it = bx; it < 4 * 24; it += G) {
                const int L = it / 24, n0 = (it % 24) * 128;
                float a[33];
#pragma unroll
                for (int r = 0; r < 33; ++r) a[r] = 0.f;
                for (int kc = 0; kc < 8; ++kc) {
                    __syncthreads();
                    for (int e = tid; e < 33 * 128; e += 512) { const int r = e >> 7, k = kc * 128 + (e & 127); const float v = (r < 32) ? cvec[r * 1024 + k] : cctx[k]; Ssil[e] = fsilu(v); }
                    __syncthreads();
                    float wv[32];
#pragma unroll
                    for (int k2 = 0; k2 < 32; ++k2) wv[k2] = mod_w[((size_t)L * 1024 + kc * 128 + kq * 32 + k2) * 3072 + n0 + cl];
#pragma unroll
                    for (int k2 = 0; k2 < 32; ++k2) { const int kl = kq * 32 + k2;
#pragma unroll
                        for (int r = 0; r < 33; ++r) a[r] += Ssil[r * 128 + kl] * wv[k2]; }
                }
                __syncthreads();
#pragma unroll
                for (int r = 0; r < 33; ++r) red[(kq * 33 + r) * 128 + cl] = a[r];
                __syncthreads();
                for (int e = tid; e < 33 * 128; e += 512) { const int r = e >> 7, c = e & 127;
                    modv[((size_t)L * 33 + r) * 3072 + n0 + c] = red[(0 * 33 + r) * 128 + c] + red[(1 * 33 + r) * 128 + c] + red[(2 * 33 + r) * 128 + c] + red[(3 * 33 + r) * 128 + c] + mod_b[L * 3072 + n0 + c]; }
                __syncthreads();
            }
        }
        { float* cosT = (float*)(dob + DO_ROPE); float* sinT = cosT + 2048 * 32;
          for (int e = (vcu * 512 + tid); e < 2048 * 32; e += G * 512) {
            const int pos = e >> 5, i = e & 31; const float invf = __builtin_amdgcn_exp2f(-(float)(i & 15) * (13.287712379549449f / 16.0f));
            const float ang = (float)((i < 16) ? (pos >> 6) : (pos & 63)) * invf;
            cosT[e] = __cosf(ang); sinT[e] = __sinf(ang); } }
    }
    GRID_BAR();
    {
        PH_BEGIN
        const float* x = inp(lds, 0); const float* ctxin = inp(lds, 2);
        for (int rg = gw; rg < TOK / 4; rg += NGW) {
            const int r0 = rg * 4, b = r0 / SB, s = r0 % SB, midx = (s < CTXL) ? 32 : b;
            const float* src = (s < CTXL) ? ctxin + ((size_t)b * CTXL + s) * DM : x + ((size_t)b * SEQ + (s - CTXL)) * DM;
            const float* mv = modv + (size_t)midx * 3072;
            f32x4 v[4][4];
#pragma unroll
            for (int i = 0; i < 4; ++i)
#pragma unroll
                for (int jq = 0; jq < 4; ++jq) v[i][jq] = *(const f32x4*)(src + (size_t)i * DM + jq * 256 + lane * 4);
#pragma unroll
            for (int jq = 0; jq < 4; ++jq) { const int c = jq * 256 + lane * 4; const f32x4 sh = *(const f32x4*)(mv + c), sc = *(const f32x4*)(mv + 1024 + c) + 1.0f;
#pragma unroll
                for (int i = 0; i < 4; ++i) { const f32x4 u = v[i][jq] * sc + sh;
                    u32x2 hw, uw; hw.x = cvt_pk_bf16(v[i][jq][0], v[i][jq][1]); hw.y = cvt_pk_bf16(v[i][jq][2], v[i][jq][3]); uw.x = cvt_pk_bf16(u[0], u[1]); uw.y = cvt_pk_bf16(u[2], u[3]);
                    *(u32x2*)(H + (size_t)(r0 + i) * DM + c) = hw; *(u32x2*)(U + (size_t)(r0 + i) * DM + c) = uw; } }
        }
    }
    GRID_BAR();

    for (int j = 0; j < 2; ++j) {
        { PH_BEGIN
          pg8::Gemm g{U, (const bf16_t*)(dob + DO_W + (size_t)j * W_PAIR + W_EVIN), DM, DM, NTILE, 37, 0, 1, 1, 0}; pg8::StaticOrder S; S.init(NTILE, 37, G, bx);
          EpiEvIn E{BIG, (float*)(dob + DO_SMALL), inp(lds, 10) + j * 16}; pg8::gemm_phase(lds, tid, g, S, E); }
        GRID_BAR();
        {   PH_BEGIN
            {
                const float* cw = inp(lds, 9) + (size_t)j * 3 * 1024;
                for (int rg = gw; rg < TOK / 4; rg += NGW) {
                    const int r0 = rg * 4, s0 = r0 % SB; const bool hp = (s0 != 0 && s0 != CTXL), hn = (s0 + 3 != CTXL - 1 && s0 + 3 != SB - 1);
                    bf16_t* er = BIG + (size_t)r0 * EV_LD;
#pragma unroll
                    for (int jj = 0; jj < 2; ++jj) { const int c = jj * 512 + lane * 8; const u32x4 z4 = (u32x4){0u, 0u, 0u, 0u};
                        u32x4 pw_[6], gw_[4];
                        pw_[0] = hp ? *(const u32x4*)(er - EV_LD + 2048 + c) : z4;
#pragma unroll
                        for (int i = 0; i < 4; ++i) { pw_[1 + i] = *(const u32x4*)(er + (size_t)i * EV_LD + 2048 + c); gw_[i] = *(const u32x4*)(er + (size_t)i * EV_LD + c); }
                        pw_[5] = hn ? *(const u32x4*)(er + (size_t)4 * EV_LD + 2048 + c) : z4;
                        const f32x4 w00 = *(const f32x4*)(cw + c), w01 = *(const f32x4*)(cw + c + 4), w10 = *(const f32x4*)(cw + 1024 + c), w11 = *(const f32x4*)(cw + 1024 + c + 4),
                                    w20 = *(const f32x4*)(cw + 2048 + c), w21 = *(const f32x4*)(cw + 2048 + c + 4);
                        f32x4 p[6][2];
#pragma unroll
                        for (int i = 0; i < 6; ++i) unpack8(pw_[i], p[i][0], p[i][1]);
#pragma unroll
                        for (int i = 0; i < 4; ++i) { f32x4 g0, g1; unpack8(gw_[i], g0, g1);
                            *(u32x4*)(er + (size_t)i * EV_LD + c) = pack8(g0 * (p[i][0] * w00 + p[i + 1][0] * w10 + p[i + 2][0] * w20), g1 * (p[i][1] * w01 + p[i + 1][1] * w11 + p[i + 2][1] * w21)); } }
                }
            }
            {
                for (int it = vcu; it < NB * 8; it += G) {
                    unsigned char* w2 = ws; unsigned char* d2 = dob; asm volatile("" : "+s"(w2), "+s"(d2));
                    const int b = it >> 3, head = (it >> 1) & 3, dh = it & 1;
                    msc::scan_item((const bf16_t*)(w2 + WS_BIG) + (size_t)b * SB * EV_LD, (const float*)(d2 + DO_SMALL) + (size_t)b * SB * 16, (bf16_t*)(d2 + DO_U) + (size_t)b * SB * DM, head, dh, lds, wave0);
                }
            }
        }
        GRID_BAR();
        { PH_BEGIN
          pg8::Gemm g{BIG, (const bf16_t*)(dob + DO_W + (size_t)j * W_PAIR + W_EVOUT), EV_LD, 2048, NTILE, 4, 0, 1, 1, 0}; pg8::StaticOrder S; S.init(NTILE, 4, G, bx);
          EpiOut E{H, modv + (size_t)(2 * j) * 33 * 3072}; pg8::gemm_phase(lds, tid, g, S, E); }
        GRID_BAR();
        {   PH_BEGIN
            const int L = 2 * j;
            ln_phase<false>(H, U, nullptr, inp(lds, 6) + L * DM, inp(lds, 7) + L * DM, modv + (size_t)(L + 1) * 33 * 3072, gw, NGW, lane, 0u);
        }
        GRID_BAR();
        const bool need_ctx = (j == 0);
        { PH_BEGIN
          pg8::Gemm g{U, (const bf16_t*)(dob + DO_W + (size_t)j * W_PAIR + W_ODIN), DM, DM, NTILE, 11, 0, 1, 1, 0}; pg8::StaticOrder S; S.init(NTILE, 11, G, bx);
          EpiOdIn E{BIG}; pg8::gemm_phase(lds, tid, g, S, E); }
        GRID_BAR();
        {   PH_BEGIN
            float* rowsc = (float*)(dob + DO_ROWSC); bf16_t* KR = (bf16_t*)(dob + DO_SMALL); const float* cosT = (const float*)(dob + DO_ROPE); const float* sinT = cosT + 2048 * 32;
            for (int rg = gw; rg < TOK / 4; rg += NGW) {
                const int r0 = rg * 4, s0 = r0 % SB; const bool lat = s0 >= CTXL;
                unsigned wq[4][3], wk[4][2]; bf16_t x1[4], x2[4]; float cc[4], sn[4];
#pragma unroll
                for (int i = 0; i < 4; ++i) { const bf16_t* orow = BIG + (size_t)(r0 + i) * OD_LD + 2048;
#pragma unroll
                    for (int q = 0; q < 3; ++q) wq[i][q] = *(const unsigned*)(orow + (q * 64 + lane) * 2);
#pragma unroll
                    for (int q = 0; q < 2; ++q) wk[i][q] = *(const unsigned*)(orow + 384 + (q * 64 + lane) * 2);
                    x1[i] = orow[640 + (lane & 31)]; x2[i] = orow[672 + (lane & 31)];
                    cc[i] = 1.f; sn[i] = 0.f;
                    if (lat) { cc[i] = cosT[(s0 + i - CTXL) * 32 + (lane & 31)]; sn[i] = sinT[(s0 + i - CTXL) * 32 + (lane & 31)]; } }
                float sq[4], sk[4];
#pragma unroll
                for (int i = 0; i < 4; ++i) { sq[i] = 0.f; sk[i] = 0.f;
#pragma unroll
                    for (int q = 0; q < 3; ++q) { const float a = bflo(wq[i][q]), c = bfhi(wq[i][q]); sq[i] += a * a + c * c; }
#pragma unroll
                    for (int q = 0; q < 2; ++q) { const float a = bflo(wk[i][q]), c = bfhi(wk[i][q]); sk[i] += a * a + c * c; } }
#pragma unroll
                for (int o = 1; o < 64; o <<= 1)
#pragma unroll
                    for (int i = 0; i < 4; ++i) { sq[i] += __shfl_xor(sq[i], o); sk[i] += __shfl_xor(sk[i], o); }
#pragma unroll
                for (int i = 0; i < 4; ++i) { const size_t r = (size_t)(r0 + i);
                    if (lane == 0) { rowsc[r * 2] = 1.0f / sqrtf(sq[i] * (1.0f / 384.0f) + RMS_EPS); rowsc[r * 2 + 1] = 1.0f / sqrtf(sk[i] * (1.0f / 256.0f) + RMS_EPS); }
                    if (lane < 32) { const float a = bf1(x1[i]), c = bf1(x2[i]);
                        KR[r * 64 + lane] = f2bf(a * cc[i] - c * sn[i]); KR[r * 64 + 32 + lane] = f2bf(a * sn[i] + c * cc[i]); } }
            }
        }
        GRID_BAR();
        for (int grp = 0; grp < NGRP; ++grp) {
            { PH_BEGIN
              const float* rowsc = (const float*)(dob + DO_ROWSC); const float* cosT = (const float*)(dob + DO_ROPE);
              pg8::Gemm g{BIG + 2048, (const bf16_t*)(dob + DO_W + (size_t)j * W_PAIR + W_UQ), OD_LD, 384, need_ctx ? GT : GB * 8, 12, grp * GT, need_ctx ? 1 : 8, need_ctx ? 1 : 9, need_ctx ? 0 : 1};
              pg8::StaticOrder S; S.init(g.nM, 12, G, bx); EpiUq E{(bf16_t*)(ws + WS_BIG + BIG_Q), rowsc, cosT, cosT + 2048 * 32, grp}; pg8::gemm_phase(lds, tid, g, S, E); }
            { PH_BEGIN
              const float* rowsc = (const float*)(dob + DO_ROWSC);
              pg8::Gemm g{BIG + 2432, (const bf16_t*)(dob + DO_W + (size_t)j * W_PAIR + W_UKV), OD_LD, 256, GT, 16, grp * GT, 1, 1, 0};
              pg8::StaticOrder S; S.init(GT, 16, G, bx); EpiUkv E{(bf16_t*)(ws + WS_BIG + BIG_K), (bf16_t*)(ws + WS_BIG + BIG_V), rowsc, (const bf16_t*)(dob + DO_SMALL), grp}; pg8::gemm_phase(lds, tid, g, S, E); }
            GRID_BAR();
            {   PH_BEGIN
                const int nunits = GB * 16 * 8 + (need_ctx ? GB * 16 : 0);
                for (int un = vcu; un < nunits; un += G) {
                    unsigned char* w2 = ws; asm volatile("" : "+s"(w2));
                    const bf16_t* Qb = (const bf16_t*)(w2 + WS_BIG + BIG_Q); const bf16_t* Kb = (const bf16_t*)(w2 + WS_BIG + BIG_K); const bf16_t* Vb = (const bf16_t*)(w2 + WS_BIG + BIG_V);
                    bf16_t* BIG2 = (bf16_t*)(w2 + WS_BIG);
                    int bl, head, qb, nkeys;
                    if (un < GB * 128) { bl = un >> 7; head = (un >> 3) & 15; qb = 1 + (un & 7); nkeys = SB; }
                    else { const int u2 = un - GB * 128; bl = u2 >> 4; head = u2 & 15; qb = 0; nkeys = CTXL; }
                    const size_t bh = (size_t)(bl * 16 + head) * SB;
                    att::attn_unit(Qb + (bh + qb * 256) * 192, Kb + bh * 192, Vb + bh * 128, BIG2 + (size_t)((grp * GB + bl) * SB + qb * 256) * OD_LD + head * 128, nkeys, lds, tid);
                }
            }
            GRID_BAR();
        }
        { PH_BEGIN
          pg8::Gemm g{BIG, (const bf16_t*)(dob + DO_W + (size_t)j * W_PAIR + W_ODOUT), OD_LD, 2048, need_ctx ? NTILE : NB * 8, 4, 0, need_ctx ? 1 : 8, need_ctx ? 1 : 9, need_ctx ? 0 : 1}; pg8::StaticOrder S; S.init(g.nM, 4, G, bx);
          EpiOut E{H, modv + (size_t)(2 * j + 1) * 33 * 3072}; pg8::gemm_phase(lds, tid, g, S, E); }
        GRID_BAR();
        {   PH_BEGIN
            const int L = 2 * j + 1;
            if (need_ctx) ln_phase<false>(H, U, nullptr, inp(lds, 6) + L * DM, inp(lds, 7) + L * DM, modv + (size_t)(L + 1) * 33 * 3072, gw, NGW, lane, 0u);
            else { const unsigned tmo = __hip_atomic_load((unsigned*)(ws + WS_CTL) + 4096 + XB_TMO, __ATOMIC_RELAXED, __HIP_MEMORY_SCOPE_AGENT);
                   ln_phase<true>(H, nullptr, (float*)dob, inp(lds, 6) + L * DM, inp(lds, 7) + L * DM, nullptr, gw, NGW, lane, tmo); }
        }
        if (need_ctx) GRID_BAR();
    }
}

extern "C" void kernel_launch(void* const* d_in, const int* in_sizes, int n_in, void* d_out, int out_size, void* d_ws, size_t ws_size, hipStream_t stream) {
    static int grid = 0;
    if (grid == 0) {
        if (n_in != 18 || out_size != NB * SEQ * DM || ws_size < WS_END) { fprintf(stderr, "kernel_launch: unexpected shapes (n_in %d out %d ws %zu)\n", n_in, out_size, ws_size); grid = -1; return; }
        int dev = 0, cus = 0;
        if (hipGetDevice(&dev) != hipSuccess || hipDeviceGetAttribute(&cus, hipDeviceAttributeMultiprocessorCount, dev) != hipSuccess) { grid = -1; return; }
        if (hipFuncSetAttribute((const void*)fwd_kernel, hipFuncAttributeMaxDynamicSharedMemorySize, LDS_BYTES) != hipSuccess) { fprintf(stderr, "kernel_launch: hipFuncSetAttribute failed\n"); grid = -1; return; }
        int per_cu = 0;
        if (hipOccupancyMaxActiveBlocksPerMultiprocessor(&per_cu, (const void*)fwd_kernel, 512, LDS_BYTES) != hipSuccess || per_cu < 1) fprintf(stderr, "kernel_launch: occupancy query says %d\n", per_cu);
        (void)hipGetLastError();
        grid = cus;
    }
    if (grid < 0) return;
    if (hipMemsetAsync((char*)d_ws + WS_CTL, 0, CTL_BYTES, stream) != hipSuccess) return;
    Params p{};
    for (int i = 0; i < 18; ++i) p.in[i] = (const float*)d_in[i];
    p.out = (float*)d_out; p.ws = (unsigned char*)d_ws;
    hipLaunchKernelGGL(fwd_kernel, dim3(grid), dim3(512), LDS_BYTES, stream, p);
}
```

```cpp
#include <hip/hip_runtime.h>
#include <cstdio>
#include <cstdint>

#define LAS __attribute__((address_space(3)))
#define GAS __attribute__((address_space(1)))
typedef unsigned short bf16_t;
typedef short bf16x8 __attribute__((ext_vector_type(8)));
typedef float f32x4 __attribute__((ext_vector_type(4)));
typedef unsigned u32x4 __attribute__((ext_vector_type(4)));
typedef unsigned u32x2 __attribute__((ext_vector_type(2)));

constexpr int DM = 1024, NB = 32, SEQ = 2048, CTXL = 256, SB = SEQ + CTXL  , TOK = NB * SB  ;
constexpr int NTILE = TOK / 256;
constexpr int EV_LD = 6144;
constexpr int EV_NP = 9472;
constexpr int OD_LD = 2816;
constexpr int NGRP = 4, GB = NB / NGRP  , GT = GB * 9  , GROWS = GB * SB  ;
constexpr float ALPHA = 1.681792830507429f;
constexpr float QSCALE = 0.07216878364870322f * 1.4426950408889634f;
constexpr float LN_EPS = 1e-5f, RMS_EPS = 1e-6f;

constexpr size_t DO_U = 0;
constexpr size_t DO_W = 150994944;
constexpr size_t W_PAIR = 38010880, W_EVIN = 0, W_EVOUT = 19398656, W_ODIN = 23592960, W_UQ = 29360128, W_UKV = 31719424, W_ODOUT = 33816576;
constexpr size_t DO_MODV = DO_W + 2 * W_PAIR;
constexpr size_t DO_ROPE = DO_MODV + 1622016;
constexpr size_t DO_ROWSC = DO_ROPE + 524288;
constexpr size_t DO_SMALL = DO_ROWSC + 589824;
constexpr size_t DO_END = DO_SMALL + 9437184;
static_assert(DO_END <= 268435456, "d_out map");
constexpr size_t WS_CTL = 0, CTL_BYTES = 1 << 20;
constexpr size_t WS_H = 1 << 20;
constexpr size_t WS_BIG = WS_H + 150994944;
constexpr size_t BIG_Q = 415236096, BIG_K = BIG_Q + 113246208, BIG_V = BIG_K + 113246208;
constexpr size_t WS_END = WS_BIG + 905969664;
static_assert(WS_END <= 1073741824, "ws map");
static_assert(BIG_V + 75497472 <= 905969664, "odd map");

__device__ __forceinline__ unsigned cvt_pk_bf16(float lo, float hi) { unsigned r; asm volatile("v_cvt_pk_bf16_f32 %0, %1, %2" : "=v"(r) : "v"(lo), "v"(hi)); return r; }
__device__ __forceinline__ float bflo(unsigned w) { return __uint_as_float(w << 16); }
__device__ __forceinline__ float bfhi(unsigned w) { return __uint_as_float(w & 0xffff0000u); }
__device__ __forceinline__ float bf1(bf16_t h) { return __uint_as_float(((unsigned)h) << 16); }
__device__ __forceinline__ bf16_t f2bf(float f) { return (bf16_t)(cvt_pk_bf16(f, 0.f) & 0xffffu); }
__device__ __forceinline__ float fsigmoid(float x) { return __builtin_amdgcn_rcpf(1.0f + __builtin_amdgcn_exp2f(-1.4426950408889634f * x)); }
__device__ __forceinline__ float fsilu(float x) { return x * fsigmoid(x); }
__device__ __forceinline__ float wave_sum(float v) {
#pragma unroll
    for (int o = 1; o < 64; o <<= 1) v += __shfl_xor(v, o);
    return v;
}
#define LDS_WAIT() asm volatile("s_waitcnt lgkmcnt(0)" ::: "memory")

#define XB_TMO      128
#define XB_XCNT(j)  (256  + 64 * (j))
#define XB_XSUB(j)  (1280 + 64 * (j))
#define XB_XGEN(j)  (2304 + 64 * (j))
#define XB_TOP      3328
#define XB_TOPGEN   3392
#define XCD_BAR_WORDS 3456
#define XB_SPIN_CAP (1u << 24)
__device__ __forceinline__ unsigned xb_ld(unsigned* p)              { return __hip_atomic_load((GAS unsigned*)p, __ATOMIC_RELAXED, __HIP_MEMORY_SCOPE_AGENT); }
__device__ __forceinline__ unsigned xb_add(unsigned* p, unsigned v) { return __hip_atomic_fetch_add((GAS unsigned*)p, v, __ATOMIC_RELAXED, __HIP_MEMORY_SCOPE_AGENT); }
__device__ __forceinline__ unsigned xb_xcc_id() { return (unsigned)__builtin_amdgcn_s_getreg((3 << 11) | 20) & 0xFu; }
#define XB_SPIN(cond, bar) do { unsigned _sp = 0; while (cond) { __builtin_amdgcn_s_sleep(1); \
    if ((++_sp & 255u) == 0u) { if (xb_ld(&(bar)[XB_TMO])) break; if (_sp > XB_SPIN_CAP) { __hip_atomic_fetch_add((GAS unsigned*)&(bar)[XB_TMO], 1u, __ATOMIC_RELAXED, __HIP_MEMORY_SCOPE_AGENT); break; } } } } while (0)
struct XcdBarrier { unsigned* bar; unsigned x; volatile LAS unsigned* st; };
__device__ __forceinline__ XcdBarrier xcd_barrier_post(unsigned* bar, volatile LAS unsigned* st) {
    XcdBarrier b; b.bar = bar; b.x = xb_xcc_id(); b.st = st;
    if (threadIdx.x == 0) (void)xb_add(&bar[XB_XCNT(b.x)], 1u);
    return b;
}
__device__ __forceinline__ void xcd_barrier_complete(unsigned* bar, unsigned x, unsigned& nloc, unsigned& nx) {
    const unsigned G = gridDim.x * gridDim.y * gridDim.z;
    unsigned sum, cnt, mine, sp = 0u;
    for (;;) {
        sum = 0u; cnt = 0u; mine = 0u;
#pragma unroll
        for (unsigned j = 0; j < 16; ++j) { const unsigned c = xb_ld(&bar[XB_XCNT(j)]); sum += c; cnt += (c > 0u) ? 1u : 0u; mine = (j == x) ? c : mine; }
        if (sum == G) break;
        __builtin_amdgcn_s_sleep(1);
        if ((++sp & 255u) == 0u) { if (xb_ld(&bar[XB_TMO])) break; if (sp > XB_SPIN_CAP) { __hip_atomic_fetch_add((GAS unsigned*)&bar[XB_TMO], 1u, __ATOMIC_RELAXED, __HIP_MEMORY_SCOPE_AGENT); break; } }
    }
    nloc = mine > 0u ? mine : 1u; nx = cnt > 0u ? cnt : 1u;
}
__device__ __forceinline__ void xcd_barrier(const XcdBarrier& b) {
    asm volatile("s_waitcnt vmcnt(0)" ::: "memory");
    __syncthreads();
    if (threadIdx.x == 0) {
        unsigned* bar = b.bar;
        __builtin_amdgcn_s_waitcnt(0);
        unsigned nloc = b.st[0], nx = b.st[1];
        if (nloc == 0u) { xcd_barrier_complete(bar, b.x, nloc, nx); b.st[0] = nloc; b.st[1] = nx; }
        const unsigned old = xb_add(&bar[XB_XSUB(b.x)], 1u);
        const unsigned gen = old / nloc;
        if (old + 1u == (gen + 1u) * nloc) {
            __builtin_amdgcn_fence(__ATOMIC_RELEASE, "agent");
            asm volatile("s_waitcnt vmcnt(0)" ::: "memory");
            const unsigned og = xb_add(&bar[XB_TOP], 1u);
            const unsigned tg = og / nx;
            if (og + 1u == (tg + 1u) * nx) xb_add(&bar[XB_TOPGEN], 1u);
            else XB_SPIN(xb_ld(&bar[XB_TOPGEN]) == tg, bar);
            __builtin_amdgcn_fence(__ATOMIC_ACQUIRE, "agent");
            xb_add(&bar[XB_XGEN(b.x)], 1u);
            asm volatile("s_waitcnt vmcnt(0)" ::: "memory");
        } else {
            XB_SPIN(xb_ld(&bar[XB_XGEN(b.x)]) == gen, bar);
            __builtin_amdgcn_fence(__ATOMIC_ACQUIRE, "agent");
            asm volatile("s_waitcnt vmcnt(0)" ::: "memory");
        }
    }
    __syncthreads();
}

namespace pg8 {
constexpr int BM = 256, BK = 64, HALF = 128, HTB = HALF * BK * 2, STAGE_BYTES = 8 * HTB, NXCD = 8, WGM = 8;
__host__ __device__ __forceinline__ int lds_byte(int r, int c) { const int st = (r >> 4) * 2 + (c >> 5), rr = r & 15, cc = c & 31, ob = rr * 64 + cc * 2; return st * 1024 + (ob ^ (((ob >> 9) & 1) << 5)); }
__host__ __device__ __forceinline__ void stage_rc(int b, int& R, int& C) { const int st = b / 1024, sb = b % 1024, swz = sb ^ (((sb >> 9) & 1) << 5); R = (st >> 1) * 16 + swz / 64; C = (st & 1) * 32 + (swz % 64) / 2; }
__host__ __device__ __forceinline__ int perm32(int rho) { const int n = rho >> 4, i = rho & 15; return 8 * (i >> 2) + 4 * n + (i & 3); }
struct Unit { int pm, pn; };
struct Gemm { const bf16_t* A; const bf16_t* Bt; int lda, K, nM, nN, tbase, gsz, gstride, goff;
    __device__ __forceinline__ int ptile(int pm) const { return tbase + (pm / gsz) * gstride + goff + (pm % gsz); } };
struct StaticOrder {
    int nM, nN, nwg, G, c;
    __device__ void init(int nM_, int nN_, int G_, int c_) { nM = nM_; nN = nN_; nwg = nM * nN; G = G_; c = c_; }
    __device__ bool next(int i, Unit& u) const {
        const long L = (long)i * G + c; if (L >= nwg) return false;
        int wgid = (int)L; { const int q = nwg / NXCD, r = nwg % NXCD, xcd = wgid % NXCD, off = wgid / NXCD; wgid = (xcd < r ? xcd * (q + 1) : r * (q + 1) + (xcd - r) * q) + off; }
        const int nig = WGM * nN, gid = wgid / nig, fm = gid * WGM, gsz = (nM - fm) < WGM ? (nM - fm) : WGM;
        u.pm = fm + ((wgid % nig) % gsz); u.pn = (wgid % nig) / gsz; return true;
    }
};
template <class Epi>
__device__ __forceinline__ void gemm_phase(LAS unsigned char* lds, const int tid, const Gemm g, const StaticOrder& S, const Epi& E) {
    const int wid = __builtin_amdgcn_readfirstlane(tid >> 6), lane = tid & 63, wr = wid >> 2, wc = wid & 3, fr = lane & 15, fq = lane >> 4;
    const int K = g.K, nt = K / BK, lda = g.lda;
    unsigned voffA[2], voffB[2];
#pragma unroll
    for (int i = 0; i < 2; ++i) { int R, C; stage_rc(tid * 16 + i * 8192, R, C); const int Rb = (R & ~31) + perm32(R & 31);
        voffA[i] = (unsigned)(R * lda + C) * 2u; voffB[i] = (unsigned)(Rb * K + C) * 2u; }
    const size_t kstep = (size_t)(BK * 2);
    const size_t hstepA = (size_t)HALF * lda * 2, hstepB = (size_t)HALF * K * 2;
    const size_t tstepA = 2 * hstepA, tstepB = 2 * hstepB;
    const unsigned ldsw = (unsigned)wid * 1024u;
    const int aoff = lds_byte(wr * 64 + fr, fq * 8), boff = lds_byte(wc * 32 + fr, fq * 8);
#define PG8_SA(b, h) (((b) * 2 + (h)) * HTB)
#define PG8_SB(b, h) ((4 + (b) * 2 + (h)) * HTB)
#define PG8_STAGE(bufoff, gbase, voff) do { _Pragma("unroll") for (int _i = 0; _i < 2; ++_i) \
        __builtin_amdgcn_global_load_lds((const unsigned*)((const char*)(gbase) + (voff)[_i]), (LAS unsigned*)(lds + (bufoff) + ldsw + _i * 8192), 16, 0, 0); } while (0)
#define PG8_LDA(dst, b, h) do { _Pragma("unroll") for (int m = 0; m < 4; ++m) _Pragma("unroll") for (int k = 0; k < 2; ++k) dst[m][k] = *(const LAS bf16x8*)(lds + PG8_SA(b, h) + aoff + m * 2048 + k * 1024); } while (0)
#define PG8_LDB(dst, b, h) do { _Pragma("unroll") for (int n = 0; n < 2; ++n) _Pragma("unroll") for (int k = 0; k < 2; ++k) dst[n][k] = *(const LAS bf16x8*)(lds + PG8_SB(b, h) + boff + n * 2048 + k * 1024); } while (0)
#define PG8_MMA(ai, bj, At, Bt) do { __builtin_amdgcn_s_setprio(1); _Pragma("unroll") for (int m = 0; m < 4; ++m) _Pragma("unroll") for (int n = 0; n < 2; ++n) _Pragma("unroll") for (int k = 0; k < 2; ++k) \
        acc[ai][bj][m][n] = __builtin_amdgcn_mfma_f32_16x16x32_bf16(Bt[n][k], At[m][k], acc[ai][bj][m][n], 0, 0, 0); __builtin_amdgcn_s_setprio(0); } while (0)
#define PG8_WAIT_V(n) asm volatile("s_waitcnt vmcnt(" #n ")" ::: "memory")
#define PG8_WAIT_L(n) asm volatile("s_waitcnt lgkmcnt(" #n ")" ::: "memory")
#define PG8_BAR __builtin_amdgcn_s_barrier()
#define PG8_SCHED __builtin_amdgcn_sched_barrier(0)
    Unit cur, nxt; int ui = 0;
    if (!S.next(0, cur)) return;
    f32x4 acc[2][2][4][2];
#pragma unroll
    for (int a = 0; a < 2; ++a)
#pragma unroll
        for (int b = 0; b < 2; ++b)
#pragma unroll
            for (int m = 0; m < 4; ++m)
#pragma unroll
                for (int n = 0; n < 2; ++n) acc[a][b][m][n] = (f32x4){0.f, 0.f, 0.f, 0.f};
    bf16x8 At[4][2], B0[2][2], B1[2][2];
    int curpt = g.ptile(cur.pm);
    const char* cA = (const char*)g.A + (size_t)curpt * tstepA; const char* cB = (const char*)g.Bt + (size_t)cur.pn * tstepB;
    PG8_STAGE(PG8_SB(0, 0), cB, voffB); PG8_STAGE(PG8_SA(0, 0), cA, voffA); PG8_STAGE(PG8_SB(0, 1), cB + hstepB, voffB); PG8_STAGE(PG8_SA(0, 1), cA + hstepA, voffA);
    if (wr == 1) PG8_BAR;
    PG8_WAIT_V(4); PG8_BAR;
    PG8_STAGE(PG8_SB(1, 0), cB + kstep, voffB); PG8_STAGE(PG8_SA(1, 0), cA + kstep, voffA); PG8_STAGE(PG8_SB(1, 1), cB + hstepB + kstep, voffB);
    PG8_WAIT_V(6); PG8_BAR;
    for (;;) {
        const bool has_next = S.next(ui + 1, nxt);
        const int nxtpt = has_next ? g.ptile(nxt.pm) : curpt;
        const char* nA = has_next ? (const char*)g.A + (size_t)nxtpt * tstepA : cA; const char* nB = has_next ? (const char*)g.Bt + (size_t)nxt.pn * tstepB : cB;
#pragma unroll 1
        for (int t = 0; t < nt; t += 2) {
            const bool last = (t == nt - 2);
            const char* a1 = cA + (size_t)(t + 1) * kstep;
            const char* a2 = last ? nA : cA + (size_t)(t + 2) * kstep; const char* b2 = last ? nB : cB + (size_t)(t + 2) * kstep;
            const char* a3 = a2 + kstep; const char* b3 = b2 + kstep;
            PG8_LDB(B0, 0, 0); PG8_SCHED; PG8_LDA(At, 0, 0); PG8_STAGE(PG8_SA(1, 1), a1 + hstepA, voffA);
            PG8_WAIT_L(8); PG8_BAR; PG8_WAIT_L(0); PG8_MMA(0, 0, At, B0); PG8_BAR; PG8_SCHED;
            PG8_LDB(B1, 0, 1); PG8_STAGE(PG8_SB(0, 0), b2, voffB);
            PG8_BAR; PG8_WAIT_L(0); PG8_MMA(0, 1, At, B1); PG8_BAR;
            PG8_LDA(At, 0, 1); PG8_STAGE(PG8_SA(0, 0), a2, voffA);
            PG8_BAR; PG8_WAIT_L(0); PG8_MMA(1, 0, At, B0); PG8_BAR; PG8_SCHED;
            PG8_STAGE(PG8_SB(0, 1), b2 + hstepB, voffB);
            PG8_WAIT_V(6); PG8_BAR; PG8_MMA(1, 1, At, B1); PG8_BAR;
            PG8_LDB(B0, 1, 0); PG8_SCHED; PG8_LDA(At, 1, 0); PG8_STAGE(PG8_SA(0, 1), a2 + hstepA, voffA);
            PG8_WAIT_L(8); PG8_BAR; PG8_WAIT_L(0); PG8_MMA(0, 0, At, B0); PG8_BAR; PG8_SCHED;
            PG8_LDB(B1, 1, 1); PG8_STAGE(PG8_SB(1, 0), b3, voffB);
            PG8_BAR; PG8_WAIT_L(0); PG8_MMA(0, 1, At, B1); PG8_BAR;
            PG8_LDA(At, 1, 1); PG8_STAGE(PG8_SA(1, 0), a3, voffA);
            PG8_BAR; PG8_WAIT_L(0); PG8_MMA(1, 0, At, B0); PG8_BAR; PG8_SCHED;
            PG8_STAGE(PG8_SB(1, 1), b3 + hstepB, voffB);
            PG8_WAIT_V(6); PG8_BAR; PG8_MMA(1, 1, At, B1); PG8_BAR;
        }
        E(acc, cur.pn, curpt, wr, wc, fr, fq);
        if (!has_next) break;
#pragma unroll
        for (int a = 0; a < 2; ++a)
#pragma unroll
            for (int b = 0; b < 2; ++b)
#pragma unroll
                for (int m = 0; m < 4; ++m)
#pragma unroll
                    for (int n = 0; n < 2; ++n) acc[a][b][m][n] = (f32x4){0.f, 0.f, 0.f, 0.f};
        cur = nxt; cA = nA; cB = nB; curpt = nxtpt; ++ui;
    }
    PG8_WAIT_V(0);
    if (wr == 0) PG8_BAR;
    PG8_BAR;
#undef PG8_SA
#undef PG8_SB
#undef PG8_STAGE
#undef PG8_LDA
#undef PG8_LDB
#undef PG8_MMA
#undef PG8_WAIT_V
#undef PG8_WAIT_L
#undef PG8_BAR
#undef PG8_SCHED
}
}

typedef const f32x4 (&AccRef)[2][2][4][2];
__device__ __forceinline__ u32x4 pack8(const f32x4 a, const f32x4 b) { u32x4 w; w.x = cvt_pk_bf16(a[0], a[1]); w.y = cvt_pk_bf16(a[2], a[3]); w.z = cvt_pk_bf16(b[0], b[1]); w.w = cvt_pk_bf16(b[2], b[3]); return w; }
__device__ __forceinline__ void unpack8(const u32x4 w, f32x4& a, f32x4& b) { a = (f32x4){bflo(w.x), bfhi(w.x), bflo(w.y), bfhi(w.y)}; b = (f32x4){bflo(w.z), bfhi(w.z), bflo(w.w), bfhi(w.w)}; }
__device__ __forceinline__ f32x4 silu4(f32x4 v) { return (f32x4){fsilu(v[0]), fsilu(v[1]), fsilu(v[2]), fsilu(v[3])}; }
__device__ __forceinline__ f32x4 sigm4(f32x4 v) { return (f32x4){fsigmoid(v[0]), fsigmoid(v[1]), fsigmoid(v[2]), fsigmoid(v[3])}; }

struct EpiEvIn {
    bf16_t* EV; float* gates; const float* gate_b;
    __device__ __forceinline__ void operator()(AccRef acc, int pn, int pt, int wr, int wc, int fr, int fq) const {
        const int row0 = pt * 256 + wr * 64 + fr, cl = wc * 32 + 8 * fq;
        if (pn < 24) {
            const int kind = pn >> 3, col = kind * 1024 + (pn & 7) * 128 + cl;
#pragma unroll
            for (int ai = 0; ai < 2; ++ai)
#pragma unroll
                for (int m = 0; m < 4; ++m) {
                    const f32x4 x0 = acc[ai][0][m][0], x1 = acc[ai][0][m][1], y0 = acc[ai][1][m][0], y1 = acc[ai][1][m][1];
                    f32x4 r0, r1;
                    if (kind == 0) { r0 = x0 * silu4(y0); r1 = x1 * silu4(y1); }
                    else if (kind == 1) { r0 = sigm4(x0) * silu4(y0); r1 = sigm4(x1) * silu4(y1); }
                    else { r0 = x0 * y0; r1 = x1 * y1; }
                    *(GAS u32x4*)(EV + (size_t)(row0 + ai * 128 + m * 16) * EV_LD + col) = pack8(r0, r1);
                    asm volatile("" ::: "memory");
                }
        } else if (pn < 36) {
            const int col = 3072 + (pn - 24) * 256 + cl;
#pragma unroll
            for (int ai = 0; ai < 2; ++ai)
#pragma unroll
                for (int m = 0; m < 4; ++m)
#pragma unroll
                    for (int bj = 0; bj < 2; ++bj)
                        *(GAS u32x4*)(EV + (size_t)(row0 + ai * 128 + m * 16) * EV_LD + col + bj * 128) = pack8(acc[ai][bj][m][0], acc[ai][bj][m][1]);
        } else {
            if (wc == 0 && fq < 2) {
                const f32x4 b0 = *(const GAS f32x4*)(gate_b + 8 * fq), b1 = *(const GAS f32x4*)(gate_b + 8 * fq + 4);
#pragma unroll
                for (int ai = 0; ai < 2; ++ai)
#pragma unroll
                    for (int m = 0; m < 4; ++m) {
                        GAS float* gp = (GAS float*)gates + (size_t)(row0 + ai * 128 + m * 16) * 16 + 8 * fq;
                        *(GAS f32x4*)gp = acc[ai][0][m][0] + b0; *(GAS f32x4*)(gp + 4) = acc[ai][0][m][1] + b1;
                    }
            }
        }
    }
};
struct EpiOdIn {
    bf16_t* OD;
    __device__ __forceinline__ void operator()(AccRef acc, int pn, int pt, int wr, int wc, int fr, int fq) const {
        const int row0 = pt * 256 + wr * 64 + fr, col = pn * 256 + wc * 32 + 8 * fq;
#pragma unroll
        for (int ai = 0; ai < 2; ++ai)
#pragma unroll
            for (int m = 0; m < 4; ++m)
#pragma unroll
                for (int bj = 0; bj < 2; ++bj) {
                    f32x4 v0 = acc[ai][bj][m][0], v1 = acc[ai][bj][m][1];
                    if (pn < 8) { v0 = silu4(v0); v1 = silu4(v1); }
                    *(GAS u32x4*)(OD + (size_t)(row0 + ai * 128 + m * 16) * OD_LD + col + bj * 128) = pack8(v0, v1);
                }
    }
};
struct EpiUq {
    bf16_t* Q; const float* rowsc; const float* cosT; const float* sinT; int grp;
    __device__ __forceinline__ void operator()(AccRef acc, int pn, int pt, int wr, int wc, int fr, int fq) const {
        const int lt = pt - grp * GT, bl = lt / 9, s0 = (lt % 9) * 256 + wr * 64 + fr, row0 = pt * 256 + wr * 64 + fr;
        float sc[8];
#pragma unroll
        for (int i = 0; i < 8; ++i) sc[i] = ((const GAS float*)rowsc)[(size_t)(row0 + (i >> 2) * 128 + (i & 3) * 16) * 2];
        if (pn < 8) {
#pragma unroll
            for (int ai = 0; ai < 2; ++ai)
#pragma unroll
                for (int m = 0; m < 4; ++m) {
                    const int ro = ai * 128 + m * 16; const float scq = sc[ai * 4 + m] * QSCALE;
#pragma unroll
                    for (int bj = 0; bj < 2; ++bj) {
                        const int head = 2 * pn + bj;
                        *(GAS u32x4*)(Q + ((size_t)(bl * 16 + head) * SB + s0 + ro) * 192 + wc * 32 + 8 * fq) = pack8(acc[ai][bj][m][0] * scq, acc[ai][bj][m][1] * scq);
                    }
                }
        } else {
            const int head = 4 * (pn - 8) + wc, i0 = 8 * fq; const bool lat = (lt % 9) != 0;
#pragma unroll
            for (int ai = 0; ai < 2; ++ai) {
                f32x4 c0[4], c1[4], n0[4], n1[4];
#pragma unroll
                for (int m = 0; m < 4; ++m) {
                    c0[m] = (f32x4){1.f, 1.f, 1.f, 1.f}; c1[m] = c0[m]; n0[m] = (f32x4){0.f, 0.f, 0.f, 0.f}; n1[m] = n0[m];
                    if (lat) { const int pos = s0 + ai * 128 + m * 16 - CTXL; c0[m] = *(const GAS f32x4*)(cosT + pos * 32 + i0); c1[m] = *(const GAS f32x4*)(cosT + pos * 32 + i0 + 4);
                        n0[m] = *(const GAS f32x4*)(sinT + pos * 32 + i0); n1[m] = *(const GAS f32x4*)(sinT + pos * 32 + i0 + 4); }
                }
#pragma unroll
                for (int m = 0; m < 4; ++m) {
                    const int s = s0 + ai * 128 + m * 16; const float scq = sc[ai * 4 + m] * QSCALE;
                    const f32x4 xa0 = acc[ai][0][m][0], xa1 = acc[ai][0][m][1], xb0 = acc[ai][1][m][0], xb1 = acc[ai][1][m][1];
                    bf16_t* qp = Q + ((size_t)(bl * 16 + head) * SB + s) * 192 + 128 + i0;
                    *(GAS u32x4*)qp = pack8((xa0 * c0[m] - xb0 * n0[m]) * scq, (xa1 * c1[m] - xb1 * n1[m]) * scq);
                    *(GAS u32x4*)(qp + 32) = pack8((xa0 * n0[m] + xb0 * c0[m]) * scq, (xa1 * n1[m] + xb1 * c1[m]) * scq);
                }
                asm volatile("" ::: "memory");
            }
        }
    }
};
struct EpiUkv {
    bf16_t* Kb; bf16_t* Vb; const float* rowsc; const bf16_t* KR; int grp;
    __device__ __forceinline__ void operator()(AccRef acc, int pn, int pt, int wr, int wc, int fr, int fq) const {
        const int lt = pt - grp * GT, bl = lt / 9, s0 = (lt % 9) * 256 + wr * 64 + fr, row0 = pt * 256 + wr * 64 + fr, head = pn;
        const int c8 = ((wc & 1) * 4 + fq) * 8;
        float sc[8]; u32x4 kr[8];
#pragma unroll
        for (int i = 0; i < 8; ++i) { const int ro = (i >> 2) * 128 + (i & 3) * 16; sc[i] = ((const GAS float*)rowsc)[(size_t)(row0 + ro) * 2 + 1];
            kr[i] = (wc < 2) ? *(const GAS u32x4*)(KR + (size_t)(row0 + ro) * 64 + c8) : (u32x4){0u, 0u, 0u, 0u}; }
#pragma unroll
        for (int ai = 0; ai < 2; ++ai)
#pragma unroll
            for (int m = 0; m < 4; ++m) {
                const int ro = ai * 128 + m * 16; const float scv = sc[ai * 4 + m];
                const size_t kv = (size_t)(bl * 16 + head) * SB + s0 + ro;
                *(GAS u32x4*)(Kb + kv * 192 + wc * 32 + 8 * fq) = pack8(acc[ai][0][m][0] * scv, acc[ai][0][m][1] * scv);
                *(GAS u32x4*)(Vb + kv * 128 + wc * 32 + 8 * fq) = pack8(acc[ai][1][m][0] * scv, acc[ai][1][m][1] * scv);
                if (wc < 2) *(GAS u32x4*)(Kb + kv * 192 + 128 + c8) = kr[ai * 4 + m];
            }
    }
};
struct EpiOut {
    bf16_t* H; const float* modv  ;
    __device__ __forceinline__ void operator()(AccRef acc, int pn, int pt, int wr, int wc, int fr, int fq) const {
        const int row0 = pt * 256 + wr * 64 + fr, midx = (pt % 9 == 0) ? 32 : pt / 9;
        const float* gv = modv + (size_t)midx * 3072 + 2048;
#pragma unroll
        for (int bj = 0; bj < 2; ++bj) {
            const int col = pn * 256 + bj * 128 + wc * 32 + 8 * fq;
            const f32x4 g0 = *(const GAS f32x4*)(gv + col), g1 = *(const GAS f32x4*)(gv + col + 4);
            u32x4 hw[8];
#pragma unroll
            for (int i = 0; i < 8; ++i) hw[i] = *(const GAS u32x4*)(H + (size_t)(row0 + (i >> 2) * 128 + (i & 3) * 16) * DM + col);
#pragma unroll
            for (int i = 0; i < 8; ++i) { const int ai = i >> 2, m = i & 3;
                f32x4 h0, h1; unpack8(hw[i], h0, h1);
                *(GAS u32x4*)(H + (size_t)(row0 + ai * 128 + m * 16) * DM + col) = pack8(h0 * ALPHA + g0 * acc[ai][bj][m][0], h1 * ALPHA + g1 * acc[ai][bj][m][1]); }
            asm volatile("" ::: "memory");
        }
    }
};

namespace att {
typedef short s16x4 __attribute__((ext_vector_type(4)));
typedef float f32x16 __attribute__((ext_vector_type(16)));
constexpr int SHM_V = 16384, SHM_KN = 16384, SHM_KR = 8192, OFF_V = 0, OFF_KN = 32768, OFF_KR = 65536, OFF_WS = 81920;
constexpr float THR2 = 11.5f;
#define KSWZ(row, colB) ((row) * 256 + ((colB) ^ (((row) & 7) << 4)))
#define KSWZ2(row, colB) ((row) * 128 + ((colB) ^ ((((row) >> 1) & 7) << 4)))
#define SBAR() __builtin_amdgcn_sched_barrier(0)
__device__ __forceinline__ int crow(int r, int hi) { return (r & 3) + 8 * (r >> 2) + 4 * hi; }
__device__ __forceinline__ void partialSM(f32x16& p0, f32x16& p1, float& m_reg, float& mn, float& alpha) {
  float pmax = p0[0];
#pragma unroll
  for (int r = 1; r < 16; ++r) pmax = fmaxf(pmax, p0[r]);
#pragma unroll
  for (int r = 0; r < 16; ++r) pmax = fmaxf(pmax, p1[r]);
  { auto rr = __builtin_amdgcn_permlane32_swap(__float_as_uint(pmax), __float_as_uint(pmax), false, false);
    pmax = fmaxf(__uint_as_float(rr[0]), __uint_as_float(rr[1])); }
  if (__builtin_expect(__all(pmax - m_reg <= THR2), 1)) { mn = m_reg; alpha = 1.f; }
  else { mn = fmaxf(m_reg, pmax); alpha = __builtin_amdgcn_exp2f(m_reg - mn); m_reg = mn; }
#pragma unroll
  for (int r = 0; r < 16; ++r) p0[r] = p0[r] - mn;
#pragma unroll
  for (int r = 0; r < 16; ++r) p1[r] = p1[r] - mn;
#pragma unroll
  for (int r = 0; r < 16; ++r) p0[r] = __builtin_amdgcn_exp2f(p0[r]);
}
__device__ __forceinline__ void finishSM(f32x16& p0, f32x16& p1, float alpha, float& l_reg, bf16x8& pa0, bf16x8& pa1, bf16x8& pa2, bf16x8& pa3) {
#pragma unroll
  for (int r = 0; r < 16; ++r) p1[r] = __builtin_amdgcn_exp2f(p1[r]);
  float ps = 0;
#pragma unroll
  for (int r = 0; r < 16; ++r) ps += p0[r];
#pragma unroll
  for (int r = 0; r < 16; ++r) ps += p1[r];
  { auto rr = __builtin_amdgcn_permlane32_swap(__float_as_uint(ps), __float_as_uint(ps), false, false);
    ps = __uint_as_float(rr[0]) + __uint_as_float(rr[1]); }
  l_reg = l_reg * alpha + ps;
#define PK4(P, BASE, OUT) do { unsigned a0 = cvt_pk_bf16(P[BASE + 0], P[BASE + 1]), a1 = cvt_pk_bf16(P[BASE + 2], P[BASE + 3]);   \
    unsigned b0 = cvt_pk_bf16(P[BASE + 4], P[BASE + 5]), b1 = cvt_pk_bf16(P[BASE + 6], P[BASE + 7]);                              \
    auto r0 = __builtin_amdgcn_permlane32_swap(a0, b0, false, false); auto r1 = __builtin_amdgcn_permlane32_swap(a1, b1, false, false); \
    u32x4 w = {r0[0], r1[0], r0[1], r1[1]}; OUT = *reinterpret_cast<bf16x8*>(&w); } while (0)
  PK4(p0, 0, pa0); PK4(p0, 8, pa1); PK4(p1, 0, pa2); PK4(p1, 8, pa3);
#undef PK4
}
__device__ __forceinline__ void qkt(f32x16& p0, f32x16& p1, unsigned kn, unsigned kr, unsigned qrp, const bf16x8 (&qr)[12], int r32, int hi) {
  p0 = f32x16{}; p1 = f32x16{};
  unsigned hb = (unsigned)hi * 16u; asm volatile("" : "+v"(hb));
  const unsigned swn = ((unsigned)r32 & 7u) << 4, swr = (((unsigned)r32 >> 1) & 7u) << 4, an = kn + (unsigned)r32 * 256u, ar = kr + (unsigned)r32 * 128u;
#pragma unroll
  for (int d0 = 0; d0 < 8; ++d0) { const unsigned ad = an + (((unsigned)d0 * 32u + hb) ^ swn);
    const bf16x8 b0 = *(const LAS bf16x8*)(uintptr_t)ad;
    const bf16x8 b1 = *(const LAS bf16x8*)(uintptr_t)(ad + 8192u);
    p0 = __builtin_amdgcn_mfma_f32_32x32x16_bf16(b0, qr[d0], p0, 0, 0, 0);
    p1 = __builtin_amdgcn_mfma_f32_32x32x16_bf16(b1, qr[d0], p1, 0, 0, 0); }
#pragma unroll
  for (int d0 = 0; d0 < 4; ++d0) { const unsigned ad = ar + (((unsigned)d0 * 32u + hb) ^ swr);
    const bf16x8 b0 = *(const LAS bf16x8*)(uintptr_t)ad;
    const bf16x8 b1 = *(const LAS bf16x8*)(uintptr_t)(ad + 4096u);
    p0 = __builtin_amdgcn_mfma_f32_32x32x16_bf16(b0, qr[8 + d0], p0, 0, 0, 0);
    p1 = __builtin_amdgcn_mfma_f32_32x32x16_bf16(b1, qr[8 + d0], p1, 0, 0, 0); }
  (void)qrp;
}
__device__ __forceinline__ int v_st(int k, int c) { const int kk = (k & ~0xC) | ((k & 4) << 1) | ((k & 8) >> 1); return ((kk >> 3) * 4 + (c >> 5)) * 512 + ((kk & 7) * 32 + (c & 31)) * 2; }
__device__ __forceinline__ int v_rd_base(int lane) { return ((lane & 3) << 3) | (((lane >> 2) & 3) << 6) | (((lane >> 4) & 1) << 5) | (((lane >> 5) & 1) << 8); }
constexpr int v_rd_off(int d0, int ks, int half) { return d0 * 512 + ks * 4096 + half * 2048; }
template <int OFF> __device__ __forceinline__ s16x4 tr_read(int vb) {
  s16x4 r; asm volatile("ds_read_b64_tr_b16 %0, %1 offset:%2" : "=&v"(r) : "v"(vb), "i"(OFF) : "memory"); return r;
}
template <int D0> __device__ __forceinline__ void pv_one(f32x16& od, int vb, bf16x8 pa0, bf16x8 pa1, bf16x8 pa2, bf16x8 pa3) {
  const s16x4 l0 = tr_read<v_rd_off(D0, 0, 0)>(vb), h0 = tr_read<v_rd_off(D0, 0, 1)>(vb), l1 = tr_read<v_rd_off(D0, 1, 0)>(vb), h1 = tr_read<v_rd_off(D0, 1, 1)>(vb);
  const s16x4 l2 = tr_read<v_rd_off(D0, 2, 0)>(vb), h2 = tr_read<v_rd_off(D0, 2, 1)>(vb), l3 = tr_read<v_rd_off(D0, 3, 0)>(vb), h3 = tr_read<v_rd_off(D0, 3, 1)>(vb);
  asm volatile("s_waitcnt lgkmcnt(0)" ::: "memory"); SBAR();
#define PK(L, H) (bf16x8){L[0], L[1], L[2], L[3], H[0], H[1], H[2], H[3]}
  od = __builtin_amdgcn_mfma_f32_32x32x16_bf16(pa0, PK(l0, h0), od, 0, 0, 0);
  od = __builtin_amdgcn_mfma_f32_32x32x16_bf16(pa1, PK(l1, h1), od, 0, 0, 0);
  od = __builtin_amdgcn_mfma_f32_32x32x16_bf16(pa2, PK(l2, h2), od, 0, 0, 0);
  od = __builtin_amdgcn_mfma_f32_32x32x16_bf16(pa3, PK(l3, h3), od, 0, 0, 0);
#undef PK
}
__device__ __forceinline__ void pv_d0(f32x16* o, int vb, bf16x8 pa0, bf16x8 pa1, bf16x8 pa2, bf16x8 pa3) {
  pv_one<0>(o[0], vb, pa0, pa1, pa2, pa3); pv_one<1>(o[1], vb, pa0, pa1, pa2, pa3); pv_one<2>(o[2], vb, pa0, pa1, pa2, pa3); pv_one<3>(o[3], vb, pa0, pa1, pa2, pa3);
}
constexpr int BUFB = 40960, OFF_RV = 0, OFF_RKN = 16384, OFF_RKR = 32768, OFF_RWS = 3 * BUFB, OFF_QR = OFF_RWS + 2048  ;
__device__ __forceinline__ void attn_unit(const bf16_t* __restrict__ Qb, const bf16_t* __restrict__ Kh, const bf16_t* __restrict__ Vh, bf16_t* Zp, int seq, LAS unsigned char* lds, int tid_in) {
  int tid = tid_in; asm volatile("" : "+v"(tid));
  const int wid = __builtin_amdgcn_readfirstlane(tid >> 6), lane = tid & 63, r32 = lane & 31, hi = lane >> 5;
  LAS float* wsl = (LAS float*)(lds + OFF_RWS) + wid * 64; LAS float* li_l = wsl; LAS float* al_l = wsl + 32;
  float m_reg = -1e30f, l_reg = 0; f32x16 o[4] = {}; bf16x8 qr[12];
  const bf16_t* Qw = Qb + (size_t)(wid * 32 + r32) * 192 + hi * 8;
#pragma unroll
  for (int d0 = 0; d0 < 12; ++d0) qr[d0] = *(const GAS bf16x8*)(Qw + d0 * 16);
  const unsigned ldsb = (unsigned)(uintptr_t)lds, qrp = ldsb + (unsigned)(OFF_QR + wid * 4096);
  unsigned sov[2], sok[2], sor;
#pragma unroll
  for (int i = 0; i < 2; ++i) {
    { const int c = 2 * wid + i, sub = 2 * c + (lane >> 5), kk = (sub >> 2) * 8 + ((lane & 31) >> 2), k = (kk & ~0xC) | ((kk & 4) << 1) | ((kk & 8) >> 1), col = (sub & 3) * 32 + (lane & 3) * 8;
      sov[i] = (unsigned)(k * 128 + col) * 2u; }
    { const int c = 2 * wid + i, row = 4 * c + (lane >> 4), u = (lane & 15) ^ (row & 7); sok[i] = (unsigned)(row * 384 + u * 16); }
  }
  { const int row = 8 * wid + (lane >> 3), u = (lane & 7) ^ ((row >> 1) & 7); sor = (unsigned)(row * 384 + 256 + u * 16); }
#define DMA(j) do { const int b_ = (j) % 3; const char* vt_ = (const char*)Vh + (size_t)(j) * (64 * 128 * 2); const char* kt_ = (const char*)Kh + (size_t)(j) * (64 * 192 * 2); \
    __builtin_amdgcn_global_load_lds((const unsigned*)(vt_ + sov[0]), (LAS unsigned*)(lds + b_ * BUFB + OFF_RV + (2 * wid) * 1024), 16, 0, 0); \
    __builtin_amdgcn_global_load_lds((const unsigned*)(vt_ + sov[1]), (LAS unsigned*)(lds + b_ * BUFB + OFF_RV + (2 * wid + 1) * 1024), 16, 0, 0); \
    __builtin_amdgcn_global_load_lds((const unsigned*)(kt_ + sok[0]), (LAS unsigned*)(lds + b_ * BUFB + OFF_RKN + (2 * wid) * 1024), 16, 0, 0); \
    __builtin_amdgcn_global_load_lds((const unsigned*)(kt_ + sok[1]), (LAS unsigned*)(lds + b_ * BUFB + OFF_RKN + (2 * wid + 1) * 1024), 16, 0, 0); \
    __builtin_amdgcn_global_load_lds((const unsigned*)(kt_ + sor), (LAS unsigned*)(lds + b_ * BUFB + OFF_RKR + wid * 1024), 16, 0, 0); } while (0)
#define VMW(n) asm volatile("s_waitcnt vmcnt(" #n ")" ::: "memory")
#define BAR() do { asm volatile("" ::: "memory"); __builtin_amdgcn_s_barrier(); asm volatile("" ::: "memory"); } while (0)
#define RESC(a) do { if (__any((a) < 1.f)) { if (hi == 0) al_l[r32] = (a); asm volatile("s_waitcnt lgkmcnt(0)" ::: "memory"); \
    _Pragma("unroll") for (int d = 0; d < 4; ++d) _Pragma("unroll") for (int r = 0; r < 16; ++r) o[d][r] *= al_l[crow(r, hi)]; } } while (0)
#define KN(j) (ldsb + (unsigned)(((j) % 3) * BUFB + OFF_RKN))
#define KRP(j) (ldsb + (unsigned)(((j) % 3) * BUFB + OFF_RKR))
#define VB(j) (vb0 + ((j) % 3) * BUFB)
  const int vb0 = (int)ldsb + OFF_RV + v_rd_base(lane);
  f32x16 pA0, pA1, pB0, pB1; float mnA, mnB, alA, alB; bf16x8 pa0, pa1, pa2, pa3; const int NT = seq / 64;
  DMA(0); DMA(1);
  VMW(5); BAR();
  qkt(pA0, pA1, KN(0), KRP(0), qrp, qr, r32, hi); partialSM(pA0, pA1, m_reg, mnA, alA);
  VMW(0); BAR();
  DMA(2);
  if (wid < 4) {
    for (int j = 1; j + 1 < NT; j += 2) {
      SBAR(); qkt(pB0, pB1, KN(j), KRP(j), qrp, qr, r32, hi);
      finishSM(pA0, pA1, alA, l_reg, pa0, pa1, pa2, pa3); SBAR();
      pv_d0(o, VB(j - 1), pa0, pa1, pa2, pa3); partialSM(pB0, pB1, m_reg, mnB, alB);
      VMW(0); BAR();
      DMA(j + 2);
      RESC(alB);
      SBAR(); qkt(pA0, pA1, KN(j + 1), KRP(j + 1), qrp, qr, r32, hi);
      finishSM(pB0, pB1, alB, l_reg, pa0, pa1, pa2, pa3); SBAR();
      pv_d0(o, VB(j), pa0, pa1, pa2, pa3); partialSM(pA0, pA1, m_reg, mnA, alA);
      VMW(0); BAR();
      if (j + 3 < NT) DMA(j + 3);
      RESC(alA);
    }
  } else {
    for (int j = 1; j + 1 < NT; j += 2) {
      SBAR(); finishSM(pA0, pA1, alA, l_reg, pa0, pa1, pa2, pa3); SBAR();
      pv_d0(o, VB(j - 1), pa0, pa1, pa2, pa3); SBAR();
      qkt(pB0, pB1, KN(j), KRP(j), qrp, qr, r32, hi); partialSM(pB0, pB1, m_reg, mnB, alB);
      VMW(0); BAR();
      DMA(j + 2);
      RESC(alB);
      SBAR(); finishSM(pB0, pB1, alB, l_reg, pa0, pa1, pa2, pa3); SBAR();
      pv_d0(o, VB(j), pa0, pa1, pa2, pa3); SBAR();
      qkt(pA0, pA1, KN(j + 1), KRP(j + 1), qrp, qr, r32, hi); partialSM(pA0, pA1, m_reg, mnA, alA);
      VMW(0); BAR();
      if (j + 3 < NT) DMA(j + 3);
      RESC(alA);
    }
  }
  SBAR(); qkt(pB0, pB1, KN(NT - 1), KRP(NT - 1), qrp, qr, r32, hi);
  finishSM(pA0, pA1, alA, l_reg, pa0, pa1, pa2, pa3); SBAR();
  pv_d0(o, VB(NT - 2), pa0, pa1, pa2, pa3); partialSM(pB0, pB1, m_reg, mnB, alB);
  RESC(alB);
  int r32e = r32, hie = hi; asm volatile("" : "+v"(r32e), "+v"(hie));
  GAS bf16_t* Zw = (GAS bf16_t*)Zp + (size_t)(wid * 32 + 4 * hie) * OD_LD + r32e;
  bf16_t zv[16][4];
#pragma unroll
  for (int r = 0; r < 16; ++r) { const int orow = (r & 3) + 8 * (r >> 2);
#pragma unroll
    for (int d0 = 0; d0 < 4; ++d0) zv[r][d0] = Zw[(size_t)orow * OD_LD + d0 * 32]; }
  SBAR();
  finishSM(pB0, pB1, alB, l_reg, pa0, pa1, pa2, pa3); SBAR();
  pv_d0(o, VB(NT - 1), pa0, pa1, pa2, pa3);
  if (hi == 0) li_l[r32] = l_reg; asm volatile("s_waitcnt lgkmcnt(0)" ::: "memory");
  float rli[16];
#pragma unroll
  for (int r = 0; r < 16; ++r) rli[r] = __builtin_amdgcn_rcpf(li_l[crow(r, hi)]);
#pragma unroll
  for (int r = 0; r < 16; ++r) { const int orow = (r & 3) + 8 * (r >> 2);
#pragma unroll
    for (int d0 = 0; d0 < 4; ++d0) Zw[(size_t)orow * OD_LD + d0 * 32] = f2bf(o[d0][r] * rli[r] * bf1(zv[r][d0])); }
  VMW(0); BAR();
#undef DMA
#undef VMW
#undef BAR
#undef RESC
#undef KN
#undef KRP
#undef VB
}
}

namespace msc {
using att::f32x16; using att::s16x4; using att::crow; using att::v_st; using att::v_rd_base; using att::v_rd_off; using att::tr_read;
constexpr int CL = 32, NCH = SB / CL;
constexpr int BUF = 40960, O_Q = 0, O_K = 16384, O_V = 32768, O_KW = 81920, O_X = 98304, O_A = 114688, O_G = O_A + 9216, O_M = O_G + 9216, O_MP = O_M + 9216, O_N = 142848, O_QN = 144896, O_PW = 145408, O_PST = 148480, O_RS = 156672;
#define PK4(P, BASE, OUT) do { unsigned a0 = cvt_pk_bf16(P[BASE + 0], P[BASE + 1]), a1 = cvt_pk_bf16(P[BASE + 2], P[BASE + 3]);   \
    unsigned b0 = cvt_pk_bf16(P[BASE + 4], P[BASE + 5]), b1 = cvt_pk_bf16(P[BASE + 6], P[BASE + 7]);                              \
    auto r0 = __builtin_amdgcn_permlane32_swap(a0, b0, false, false); auto r1 = __builtin_amdgcn_permlane32_swap(a1, b1, false, false); \
    u32x4 w = {r0[0], r1[0], r0[1], r1[1]}; OUT = *reinterpret_cast<bf16x8*>(&w); } while (0)
#define PKLH(L, H) (bf16x8){L[0], L[1], L[2], L[3], H[0], H[1], H[2], H[3]}
__device__ __forceinline__ void scan_item(const bf16_t* evb  , const float* gb  , bf16_t* hfb  ,
                                          int head, int dh, LAS unsigned char* lds, int wave0) {
  int tid; asm volatile("v_mbcnt_lo_u32_b32 %0, -1, 0\n\tv_mbcnt_hi_u32_b32 %0, -1, %0" : "=v"(tid)); tid += wave0 * 64;
  const int tid_o = tid; const int wid = wave0, lane = tid & 63, r32 = lane & 31, hi = lane >> 5, kh = wid >> 2, dq = wid & 3; (void)r32; (void)hi;
  const unsigned ldsb = (unsigned)(uintptr_t)lds;
  LAS float* aS = (LAS float*)(lds + O_A); LAS float* gT = (LAS float*)(lds + O_G); LAS float* mT = (LAS float*)(lds + O_M); LAS float* mP = (LAS float*)(lds + O_MP);
  LAS float* nbuf = (LAS float*)(lds + O_N); LAS float* qnS = (LAS float*)(lds + O_QN); LAS float* pw = (LAS float*)(lds + O_PW) + wid * 96;
  LAS float* xch = (LAS float*)(lds + O_X) + dq * 1024; LAS float* rsS = (LAS float*)(lds + O_RS);
#define BARX() do { asm volatile("" ::: "memory"); __builtin_amdgcn_s_barrier(); asm volatile("" ::: "memory"); } while (0)
#define LGK0() do { asm volatile("s_waitcnt lgkmcnt(0)" ::: "memory"); __builtin_amdgcn_sched_barrier(0); } while (0)
  for (int dir = 0; dir < 2; ++dir) {
    asm volatile("s_waitcnt vmcnt(0) lgkmcnt(0)" ::: "memory"); BARX();
    {
      LAS float* rawI = (LAS float*)lds; LAS float* rawF = rawI + SB; LAS float* Bc = rawF + SB; LAS float* CMc = Bc + 128;
      {
        float ipv[5], fpv[5];
#pragma unroll
        for (int i = 0; i < 5; ++i) { const int jx = tid + 512 * i; ipv[i] = 0.f; fpv[i] = 0.f;
          if (jx < SB) { const int srow = dir == 0 ? jx : (jx < CTXL ? CTXL - 1 - jx : SB - 1 - (jx - CTXL)); const GAS float* gr = (const GAS float*)gb + (size_t)srow * 16 + dir * 8; ipv[i] = gr[head]; fpv[i] = gr[4 + head]; } }
#pragma unroll
        for (int i = 0; i < 5; ++i) { const int jx = tid + 512 * i; if (jx < SB) { rawI[jx] = ipv[i]; rawF[jx] = fminf(fpv[i], 0.f) - __logf(1.0f + __expf(-fabsf(fpv[i]))); } }
      }
      if (tid < 256) { nbuf[tid] = 0.f; nbuf[256 + tid] = 0.f; }
      LGK0(); BARX();
      for (int c = wid; c < NCH; c += 8) {
        const int l5 = lane & 31; const float ip = rawI[c * CL + l5]; float bsum = rawF[c * CL + l5];
#pragma unroll
        for (int o = 1; o < 32; o <<= 1) { const float t = __shfl_up(bsum, o, 32); if (l5 >= o) bsum += t; }
        const float a = ip - bsum; float cm = a;
#pragma unroll
        for (int o = 1; o < 32; o <<= 1) { const float t = __shfl_up(cm, o, 32); if (l5 >= o) cm = fmaxf(cm, t); }
        if (lane < 32) { aS[c * CL + l5] = a; gT[c * CL + l5] = cm; mT[c * CL + l5] = bsum; }
        if (lane == 31) { Bc[c] = bsum; CMc[c] = cm; }
      }
      LGK0(); BARX();
      if (tid == 0) { float mp = -1e30f; for (int c = 0; c < NCH; ++c) { mP[c] = mp; mp = Bc[c] + fmaxf(mp, CMc[c]); } }
      LGK0(); BARX();
      for (int jx = tid; jx < SB; jx += 512) { const float g = fmaxf(mP[jx >> 5], gT[jx]); gT[jx] = g; mT[jx] = mT[jx] + g; }
      LGK0(); BARX();
    }
    unsigned soq[2], sov;
#pragma unroll
    for (int i = 0; i < 2; ++i) { const int c2 = 2 * wid + i, t = 2 * c2 + (lane >> 5), u = (lane & 31) ^ (t & 15), ro = dir ? 31 - t : t; soq[i] = (unsigned)(ro * EV_LD * 2 + u * 16); }
    { const int sub = 2 * wid + (lane >> 5), kk = (sub >> 2) * 8 + ((lane & 31) >> 2), s_ = (kk & ~0xC) | ((kk & 4) << 1) | ((kk & 8) >> 1), col = (sub & 3) * 32 + (lane & 3) * 8, ro = dir ? 31 - s_ : s_;
      sov = (unsigned)(ro * EV_LD * 2 + col * 2); }
#define SLO(c) (dir == 0 ? (c) * CL : ((c) * CL < CTXL ? CTXL - CL - (c) * CL : SB - CL - ((c) * CL - CTXL)))
#define DMA(c) do { const int b_ = (c) & 1; const char* rb_ = (const char*)(evb + (size_t)SLO(c) * EV_LD); \
    const char* qb_ = rb_ + (3072 + head * 256) * 2; const char* kb_ = rb_ + (4096 + head * 256) * 2; const char* vb_ = rb_ + (5120 + head * 256 + dh * 128) * 2; \
    __builtin_amdgcn_global_load_lds((const unsigned*)(qb_ + soq[0]), (LAS unsigned*)(lds + b_ * BUF + O_Q + (2 * wid) * 1024), 16, 0, 0); \
    __builtin_amdgcn_global_load_lds((const unsigned*)(qb_ + soq[1]), (LAS unsigned*)(lds + b_ * BUF + O_Q + (2 * wid + 1) * 1024), 16, 0, 0); \
    __builtin_amdgcn_global_load_lds((const unsigned*)(kb_ + soq[0]), (LAS unsigned*)(lds + b_ * BUF + O_K + (2 * wid) * 1024), 16, 0, 0); \
    __builtin_amdgcn_global_load_lds((const unsigned*)(kb_ + soq[1]), (LAS unsigned*)(lds + b_ * BUF + O_K + (2 * wid + 1) * 1024), 16, 0, 0); \
    __builtin_amdgcn_global_load_lds((const unsigned*)(vb_ + sov), (LAS unsigned*)(lds + b_ * BUF + O_V + wid * 1024), 16, 0, 0); } while (0)
    f32x16 C[4] = {};
    float nv[4] = {0.f, 0.f, 0.f, 0.f};
    const bf16x8 ones8 = {0x3F80, 0x3F80, 0x3F80, 0x3F80, 0x3F80, 0x3F80, 0x3F80, 0x3F80};
    DMA(0); DMA(1);
    asm volatile("s_waitcnt vmcnt(5)" ::: "memory"); BARX();
    for (int c = 0; c < NCH; ++c) {
      int tid = tid_o; asm volatile("" : "+v"(tid));
      const int lane = tid & 63, r32 = lane & 31, hi = lane >> 5, dcol = head * 256 + dh * 128 + dq * 32 + r32;
      const unsigned tb = ldsb + (unsigned)((c & 1) * BUF);
      const float mprev = mP[c], glast = gT[c * CL + CL - 1];
      const float decay = __expf(mprev - glast);
      const unsigned rb = (unsigned)r32 * 512u, sw = ((unsigned)r32 & 15u) << 4; unsigned hb = (unsigned)hi * 16u; asm volatile("" : "+v"(hb));
      const int slo = SLO(c);
      bf16_t pf_h[16], pf_o[16];
      if (kh == 1) {
        f32x16 pe = {}, po = {};
#pragma unroll
        for (int kk = 0; kk < 16; kk += 2) { const unsigned ad0 = tb + rb + (((unsigned)kk * 32u + hb) ^ sw), ad1 = tb + rb + (((unsigned)(kk + 1) * 32u + hb) ^ sw);
          const bf16x8 kf0 = *(const LAS bf16x8*)(uintptr_t)(ad0 + O_K), qf0 = *(const LAS bf16x8*)(uintptr_t)(ad0 + O_Q);
          const bf16x8 kf1 = *(const LAS bf16x8*)(uintptr_t)(ad1 + O_K), qf1 = *(const LAS bf16x8*)(uintptr_t)(ad1 + O_Q);
          pe = __builtin_amdgcn_mfma_f32_32x32x16_bf16(kf0, qf0, pe, 0, 0, 0);
          po = __builtin_amdgcn_mfma_f32_32x32x16_bf16(kf1, qf1, po, 0, 0, 0); }
        f32x16 p = pe + po;
        const float gt = gT[c * CL + r32]; float rowsum = 0.f;
#pragma unroll
        for (int r4 = 0; r4 < 4; ++r4) { const f32x4 a4 = *(const LAS f32x4*)(aS + c * CL + 8 * r4 + 4 * hi);
#pragma unroll
          for (int e = 0; e < 4; ++e) { const int sidx = 8 * r4 + 4 * hi + e; const float w = (sidx <= r32) ? __expf(a4[e] - gt) : 0.f; p[4 * r4 + e] *= w; rowsum += p[4 * r4 + e]; } }
        { auto rr = __builtin_amdgcn_permlane32_swap(__float_as_uint(rowsum), __float_as_uint(rowsum), false, false); rowsum = __uint_as_float(rr[0]) + __uint_as_float(rr[1]); }
        bf16x8 pa0, pa1; PK4(p, 0, pa0); PK4(p, 8, pa1);
        *(LAS bf16x8*)(lds + O_PST + (dq * 2 + 0) * 1024 + lane * 16) = pa0; *(LAS bf16x8*)(lds + O_PST + (dq * 2 + 1) * 1024 + lane * 16) = pa1;
        if (hi == 0) rsS[dq * 32 + r32] = rowsum;
      } else {
        if (dir == 1) {
          const char* hb_ = (const char*)(hfb + (size_t)slo * DM); const char* ob_ = (const char*)(evb + (size_t)slo * EV_LD + 1024);
          const unsigned ho = (unsigned)((31 - 4 * hi) * DM + dcol) * 2u, oo = (unsigned)((31 - 4 * hi) * EV_LD + dcol) * 2u;
#pragma unroll
          for (int r = 0; r < 16; ++r) { const int tc = (r & 3) + 8 * (r >> 2);
            pf_h[r] = *(const GAS bf16_t*)(hb_ + (ho - (unsigned)(tc * DM * 2))); pf_o[r] = *(const GAS bf16_t*)(ob_ + (oo - (unsigned)(tc * EV_LD * 2))); }
        }
        { const int s_ = tid >> 3, cb = (tid & 7) * 8; const float wt = __expf(aS[c * CL + s_] - glast);
#pragma unroll
          for (int h4 = 0; h4 < 4; ++h4) { const int c8 = cb + 64 * h4; f32x4 x0, x1;
            unpack8(*(const LAS u32x4*)(uintptr_t)(tb + O_K + (unsigned)s_ * 512u + ((unsigned)(c8 * 2) ^ (((unsigned)s_ & 15u) << 4))), x0, x1);
            *(LAS u32x4*)(lds + O_KW + (c8 >> 7) * 8192 + v_st(s_, c8 & 127)) = pack8(x0 * wt, x1 * wt); } }
        { const int t_ = tid >> 3, part = tid & 7; const LAS float* nb = nbuf + (c & 1) * 256 + part * 32; float acc = 0.f;
#pragma unroll
          for (int e = 0; e < 4; ++e) { f32x4 x0, x1; unpack8(*(const LAS u32x4*)(uintptr_t)(tb + O_Q + (unsigned)t_ * 512u + ((unsigned)(part * 64 + e * 16) ^ (((unsigned)t_ & 15u) << 4))), x0, x1);
            const f32x4 n0 = *(const LAS f32x4*)(nb + e * 8), n1 = *(const LAS f32x4*)(nb + e * 8 + 4);
            acc += x0[0] * n0[0] + x0[1] * n0[1] + x0[2] * n0[2] + x0[3] * n0[3] + x1[0] * n1[0] + x1[1] * n1[1] + x1[2] * n1[2] + x1[3] * n1[3]; }
          acc += __shfl_xor(acc, 1); acc += __shfl_xor(acc, 2); acc += __shfl_xor(acc, 4);
          if (part == 0) qnS[t_] = acc; }
      }
      LGK0(); BARX();
      f32x16 aq0 = {}, aq1 = {};
#pragma unroll
      for (int j = 0; j < 8; ++j) { const unsigned ad = tb + O_Q + rb + (((unsigned)(8 * kh + j) * 32u + hb) ^ sw);
        const bf16x8 qf = *(const LAS bf16x8*)(uintptr_t)ad; bf16x8 cf;
        if ((j & 1) == 0) { PK4(C[j >> 1], 0, cf); aq0 = __builtin_amdgcn_mfma_f32_32x32x16_bf16(qf, cf, aq0, 0, 0, 0); }
        else { PK4(C[j >> 1], 8, cf); aq1 = __builtin_amdgcn_mfma_f32_32x32x16_bf16(qf, cf, aq1, 0, 0, 0); } }
      f32x16 aqc = aq0 + aq1;
      const int vbase = (int)(tb + O_V) + v_rd_base(lane) + dq * 512;
      const int kwb = (int)(ldsb + O_KW + kh * 8192) + v_rd_base(lane);
      const s16x4 vl0 = tr_read<v_rd_off(0, 0, 0)>(vbase), vh0 = tr_read<v_rd_off(0, 0, 1)>(vbase), vl1 = tr_read<v_rd_off(0, 1, 0)>(vbase), vh1 = tr_read<v_rd_off(0, 1, 1)>(vbase);
      const s16x4 a0l0 = tr_read<v_rd_off(0, 0, 0)>(kwb), a0h0 = tr_read<v_rd_off(0, 0, 1)>(kwb), a0l1 = tr_read<v_rd_off(0, 1, 0)>(kwb), a0h1 = tr_read<v_rd_off(0, 1, 1)>(kwb);
      const s16x4 a1l0 = tr_read<v_rd_off(1, 0, 0)>(kwb), a1h0 = tr_read<v_rd_off(1, 0, 1)>(kwb), a1l1 = tr_read<v_rd_off(1, 1, 0)>(kwb), a1h1 = tr_read<v_rd_off(1, 1, 1)>(kwb);
      const s16x4 a2l0 = tr_read<v_rd_off(2, 0, 0)>(kwb), a2h0 = tr_read<v_rd_off(2, 0, 1)>(kwb), a2l1 = tr_read<v_rd_off(2, 1, 0)>(kwb), a2h1 = tr_read<v_rd_off(2, 1, 1)>(kwb);
      const s16x4 a3l0 = tr_read<v_rd_off(3, 0, 0)>(kwb), a3h0 = tr_read<v_rd_off(3, 0, 1)>(kwb), a3l1 = tr_read<v_rd_off(3, 1, 0)>(kwb), a3h1 = tr_read<v_rd_off(3, 1, 1)>(kwb);
      bf16x8 pa0 = {}, pa1 = {};
      if (kh == 0) { pa0 = *(const LAS bf16x8*)(lds + O_PST + (dq * 2 + 0) * 1024 + lane * 16); pa1 = *(const LAS bf16x8*)(lds + O_PST + (dq * 2 + 1) * 1024 + lane * 16); }
      LGK0();
      const bf16x8 vf0 = PKLH(vl0, vh0), vf1 = PKLH(vl1, vh1);
      const bf16x8 kwf[4][2] = {{PKLH(a0l0, a0h0), PKLH(a0l1, a0h1)}, {PKLH(a1l0, a1h0), PKLH(a1l1, a1h1)}, {PKLH(a2l0, a2h0), PKLH(a2l1, a2h1)}, {PKLH(a3l0, a3h0), PKLH(a3l1, a3h1)}};
      f32x16 asv = {};
      if (kh == 0) {
        asv = __builtin_amdgcn_mfma_f32_32x32x16_bf16(pa0, vf0, asv, 0, 0, 0);
        asv = __builtin_amdgcn_mfma_f32_32x32x16_bf16(pa1, vf1, asv, 0, 0, 0);
        const float ai = __expf(mprev - gT[c * CL + r32]);
        pw[r32] = rsS[dq * 32 + r32] + ai * qnS[r32]; pw[32 + r32] = ai; pw[64 + r32] = __expf(-mT[c * CL + r32]);
      } else {
#pragma unroll
        for (int r = 0; r < 16; ++r) xch[r * 64 + lane] = aqc[r];
      }
#pragma unroll
      for (int i = 0; i < 4; ++i) {
#pragma unroll
        for (int r = 0; r < 16; ++r) C[i][r] *= decay;
        C[i] = __builtin_amdgcn_mfma_f32_32x32x16_bf16(kwf[i][0], vf0, C[i], 0, 0, 0);
        C[i] = __builtin_amdgcn_mfma_f32_32x32x16_bf16(kwf[i][1], vf1, C[i], 0, 0, 0);
        if (dq == 0) {
          f32x16 na = {}; na = __builtin_amdgcn_mfma_f32_32x32x16_bf16(ones8, kwf[i][0], na, 0, 0, 0); na = __builtin_amdgcn_mfma_f32_32x32x16_bf16(ones8, kwf[i][1], na, 0, 0, 0);
          nv[i] = decay * nv[i] + na[0];
          if (hi == 0) nbuf[((c + 1) & 1) * 256 + kh * 128 + i * 32 + r32] = nv[i]; }
      }
      asm volatile("s_waitcnt vmcnt(0) lgkmcnt(0)" ::: "memory"); BARX();
      if (c + 2 < NCH) DMA(c + 2);
      if (kh == 0) {
        float hvs[16];
#pragma unroll
        for (int r4 = 0; r4 < 4; ++r4) {
          const f32x4 dn = *(const LAS f32x4*)(pw + 8 * r4 + 4 * hi), ai4 = *(const LAS f32x4*)(pw + 32 + 8 * r4 + 4 * hi), em4 = *(const LAS f32x4*)(pw + 64 + 8 * r4 + 4 * hi);
#pragma unroll
          for (int e = 0; e < 4; ++e) { const int r = 4 * r4 + e;
            hvs[r] = (asv[r] + ai4[e] * (aqc[r] + xch[r * 64 + lane])) * __builtin_amdgcn_rcpf(fmaxf(fabsf(dn[e]), em4[e])); }
        }
        if (dir == 0) {
          char* hb_ = (char*)(hfb + (size_t)slo * DM); const unsigned ho = (unsigned)((4 * hi) * DM + dcol) * 2u;
#pragma unroll
          for (int r = 0; r < 16; ++r) { const int tc = (r & 3) + 8 * (r >> 2); *(GAS bf16_t*)(hb_ + (ho + (unsigned)(tc * DM * 2))) = f2bf(hvs[r]); }
        } else {
          char* ob_ = (char*)((bf16_t*)evb + (size_t)slo * EV_LD + 1024); const unsigned oo = (unsigned)((31 - 4 * hi) * EV_LD + dcol) * 2u;
#pragma unroll
          for (int r = 0; r < 16; ++r) { const int tc = (r & 3) + 8 * (r >> 2); *(GAS bf16_t*)(ob_ + (oo - (unsigned)(tc * EV_LD * 2))) = f2bf(bf1(pf_o[r]) * (bf1(pf_h[r]) + hvs[r])); }
        }
      }
    }
#undef DMA
#undef SLO
  }
  asm volatile("s_waitcnt vmcnt(0) lgkmcnt(0)" ::: "memory"); BARX();
#undef BARX
#undef LGK0
}
#undef PK4
#undef PKLH
}

struct Params { const float* in[18]; float* out; unsigned char* ws; };
constexpr int LDS_BYTES = 163840, LDS_CTL = 162816, MISC_OFF = LDS_CTL + 320;

template <int MID> __device__ __forceinline__ int wmap(int n) {
    if (MID == 0) {
        const int pn = n >> 8, lc = n & 255, bj = lc >> 7, c = lc & 127;
        if (pn < 8)  return (bj ? 3072 : 0) + 128 * pn + c;
        if (pn < 16) return (bj ? 8192 : 7168) + 128 * (pn - 8) + c;
        if (pn < 24) return (bj ? 2048 : 1024) + 128 * (pn - 16) + c;
        if (pn < 36) return 4096 + 256 * (pn - 24) + lc;
        return lc < 16 ? 9216 + lc : -1;
    } else if (MID == 2) {
        if (n < 2048) return 704 + n;
        return (n - 2048 < 704) ? n - 2048 : -1;
    } else if (MID == 3) {
        const int pn = n >> 8, lc = n & 255;
        if (pn < 8) return (n >> 7) * 192 + (n & 127);
        const int bj = lc >> 7, hh = (lc & 127) >> 5, i = lc & 31;
        return (4 * (pn - 8) + hh) * 192 + 128 + 32 * bj + i;
    }
    return n;
}
template <int MID> __device__ __forceinline__ void wconv_item(const float* W, int K, int NS, bf16_t* WT, int nblk, const float* kscale, LAS float* scr, int item, int lane) {
    const int kb = item / nblk, nb = item % nblk, k0 = 64 * kb, n0 = 32 * nb;
    const int src = wmap<MID>(n0 + (lane & 31));
    const float cs = (MID == 0 && src >= 5120 && src < 6144) ? 0.0625f : 1.0f;
    float wv[32];
#pragma unroll
    for (int i = 0; i < 32; ++i) { const int kk = 2 * i + (lane >> 5); wv[i] = (src >= 0) ? ((const GAS float*)W)[(size_t)(k0 + kk) * NS + src] : 0.f; }
#pragma unroll
    for (int i = 0; i < 32; ++i) { const int kk = 2 * i + (lane >> 5); float v = wv[i] * cs; if (kscale) v *= ((const GAS float*)kscale)[k0 + kk];
        scr[kk * 33 + (lane & 31)] = v; }
    LDS_WAIT(); asm volatile("" ::: "memory");
    const int c = lane & 7;
#pragma unroll
    for (int j = 0; j < 4; ++j) { const int n = (lane >> 3) + 8 * j; const LAS float* s = scr + (8 * c) * 33 + n;
        u32x4 o; o.x = cvt_pk_bf16(s[0 * 33], s[1 * 33]); o.y = cvt_pk_bf16(s[2 * 33], s[3 * 33]); o.z = cvt_pk_bf16(s[4 * 33], s[5 * 33]); o.w = cvt_pk_bf16(s[6 * 33], s[7 * 33]);
        *(GAS u32x4*)(WT + (size_t)(n0 + n) * K + k0 + 8 * c) = o; }
    LDS_WAIT(); asm volatile("" ::: "memory");
}

constexpr int PTR_OFF = LDS_CTL + 512;
__device__ __forceinline__ const float* inp(LAS unsigned char* lds, int i) {
    unsigned off = (unsigned)(PTR_OFF + 8 * i); asm volatile("" : "+s"(off));
    volatile LAS unsigned* t = (volatile LAS unsigned*)(lds + off);
    const unsigned lo = __builtin_amdgcn_readfirstlane(t[0]), hi = __builtin_amdgcn_readfirstlane(t[1]);
    return (const float*)(((unsigned long long)hi << 32) | lo);
}
#define PH_BEGIN int tid; asm volatile("v_mbcnt_lo_u32_b32 %0, -1, 0\n\tv_mbcnt_hi_u32_b32 %0, -1, %0" : "=v"(tid)); tid += wave0 * 64; unsigned char* ws = ws0; unsigned char* dob = dob0; asm volatile("" : "+v"(tid), "+s"(ws), "+s"(dob)); \
    const int lane = tid & 63, wave = __builtin_amdgcn_readfirstlane(tid >> 6), G = gridDim.x, bx = blockIdx.x, vcu = (G % 8 == 0) ? (bx % 8) * (G / 8) + bx / 8 : bx, gw = vcu * 8 + wave, NGW = G * 8; \
    (void)lane; (void)wave; (void)gw; (void)NGW; (void)vcu; \
    bf16_t* U = (bf16_t*)(dob + DO_U); bf16_t* H = (bf16_t*)(ws + WS_H); bf16_t* BIG = (bf16_t*)(ws + WS_BIG); float* modv = (float*)(dob + DO_MODV); \
    (void)U; (void)H; (void)BIG; (void)modv;

template <bool FINAL>
__device__ __forceinline__ void ln_phase(bf16_t* H, bf16_t* U, float* outp, const float* ln_g, const float* ln_b, const float* modn, int gw, int NGW, int lane, unsigned tmo) {
    for (int rg = gw; rg < TOK / 4; rg += NGW) {
        const int r0 = rg * 4, b = r0 / SB, s0 = r0 % SB, midx = (s0 < CTXL) ? 32 : b;
        if (FINAL && s0 < CTXL) continue;
        bf16_t* hr = H + (size_t)r0 * DM;
        f32x4 v[4][2][2]; float sm[4], sq[4];
#pragma unroll
        for (int i = 0; i < 4; ++i)
#pragma unroll
            for (int jj = 0; jj < 2; ++jj) unpack8(*(const GAS u32x4*)(hr + (size_t)i * DM + jj * 512 + lane * 8), v[i][jj][0], v[i][jj][1]);
#pragma unroll
        for (int i = 0; i < 4; ++i) { sm[i] = 0.f;
#pragma unroll
            for (int jj = 0; jj < 2; ++jj)
#pragma unroll
                for (int q = 0; q < 2; ++q) sm[i] += (v[i][jj][q][0] + v[i][jj][q][1]) + (v[i][jj][q][2] + v[i][jj][q][3]); }
#pragma unroll
        for (int o = 1; o < 64; o <<= 1)
#pragma unroll
            for (int i = 0; i < 4; ++i) sm[i] += __shfl_xor(sm[i], o);
#pragma unroll
        for (int i = 0; i < 4; ++i) { const float mean = sm[i] * (1.0f / DM); sq[i] = 0.f;
#pragma unroll
            for (int jj = 0; jj < 2; ++jj)
#pragma unroll
                for (int q = 0; q < 2; ++q) { v[i][jj][q] = v[i][jj][q] - mean; sq[i] += (v[i][jj][q][0] * v[i][jj][q][0] + v[i][jj][q][1] * v[i][jj][q][1]) + (v[i][jj][q][2] * v[i][jj][q][2] + v[i][jj][q][3] * v[i][jj][q][3]); } }
#pragma unroll
        for (int o = 1; o < 64; o <<= 1)
#pragma unroll
            for (int i = 0; i < 4; ++i) sq[i] += __shfl_xor(sq[i], o);
        const float* mv = FINAL ? nullptr : modn + (size_t)midx * 3072;
#pragma unroll
        for (int jj = 0; jj < 2; ++jj) { const int c = jj * 512 + lane * 8;
            f32x4 gg[2], bb[2], sh[2], sc[2];
#pragma unroll
            for (int q = 0; q < 2; ++q) { gg[q] = *(const GAS f32x4*)(ln_g + c + 4 * q); bb[q] = *(const GAS f32x4*)(ln_b + c + 4 * q);
                if (!FINAL) { sh[q] = *(const GAS f32x4*)(mv + c + 4 * q); sc[q] = *(const GAS f32x4*)(mv + 1024 + c + 4 * q) + 1.0f; } }
#pragma unroll
            for (int i = 0; i < 4; ++i) { const float rstd = 1.0f / sqrtf(sq[i] * (1.0f / DM) + LN_EPS);
                f32x4 y0 = v[i][jj][0] * rstd * gg[0] + bb[0], y1 = v[i][jj][1] * rstd * gg[1] + bb[1];
                if (!FINAL) { *(GAS u32x4*)(hr + (size_t)i * DM + c) = pack8(y0, y1); *(GAS u32x4*)(U + (size_t)(r0 + i) * DM + c) = pack8(y0 * sc[0] + sh[0], y1 * sc[1] + sh[1]); }
                else { float* op = outp + ((size_t)b * SEQ + (s0 + i - CTXL)) * DM + c;
                    if (tmo) { const float qn = __builtin_nanf(""); y0 = (f32x4){qn, qn, qn, qn}; y1 = y0; }
                    *(GAS f32x4*)op = y0; *(GAS f32x4*)(op + 4) = y1; } }
        }
    }
}

__global__ void __launch_bounds__(512, 2) fwd_kernel(Params p) {
    extern __shared__ __attribute__((aligned(16))) unsigned char lds_raw[];
    LAS unsigned char* lds = (LAS unsigned char*)lds_raw;
    const int tid0 = threadIdx.x;
    volatile LAS unsigned* MISC = (volatile LAS unsigned*)(lds + MISC_OFF);
    for (int u = tid0; u < (LDS_BYTES - LDS_CTL) / 4; u += 512) ((LAS unsigned*)(lds + LDS_CTL))[u] = 0u;
    __syncthreads();
    if (tid0 < 18) { const unsigned long long a = (unsigned long long)p.in[tid0]; volatile LAS unsigned* t = (volatile LAS unsigned*)(lds + PTR_OFF); t[2 * tid0] = (unsigned)a; t[2 * tid0 + 1] = (unsigned)(a >> 32); }
    __syncthreads();
    unsigned char* const ws0 = p.ws; unsigned char* const dob0 = (unsigned char*)p.out;
    const int wave0 = __builtin_amdgcn_readfirstlane(tid0 >> 6);
    (void)xcd_barrier_post((unsigned*)(ws0 + WS_CTL) + 4096, MISC + 8);
#define GRID_BAR() do { XcdBarrier b2_; b2_.bar = (unsigned*)(ws0 + WS_CTL) + 4096; asm volatile("" : "+s"(b2_.bar)); b2_.x = xb_xcc_id(); b2_.st = (volatile LAS unsigned*)(lds + MISC_OFF) + 8; xcd_barrier(b2_); } while (0)

    {
        PH_BEGIN
        LAS float* scr = (LAS float*)(lds + wave * 16384);
        for (int j = 0; j < 2; ++j) {
            unsigned char* wb = dob + DO_W + (size_t)j * W_PAIR;
            { const float* w = inp(lds, 8) + (size_t)j * 1024 * 9232; for (int it = gw; it < 16 * 296; it += NGW) wconv_item<0>(w, 1024, 9232, (bf16_t*)(wb + W_EVIN), 296, nullptr, scr, it, lane); }
            { const float* w = inp(lds, 11) + (size_t)j * 2048 * 1024; for (int it = gw; it < 32 * 32; it += NGW)  wconv_item<1>(w, 2048, 1024, (bf16_t*)(wb + W_EVOUT), 32, nullptr, scr, it, lane); }
            { const float* w = inp(lds, 12) + (size_t)j * 1024 * 2752; for (int it = gw; it < 16 * 88; it += NGW)  wconv_item<2>(w, 1024, 2752, (bf16_t*)(wb + W_ODIN), 88, nullptr, scr, it, lane); }
            { const float* w = inp(lds, 14) + (size_t)j * 384 * 3072; const float* ks = inp(lds, 13) + j * 384; for (int it = gw; it < 6 * 96; it += NGW)   wconv_item<3>(w, 384, 3072, (bf16_t*)(wb + W_UQ), 96, ks, scr, it, lane); }
            { const float* w = inp(lds, 16) + (size_t)j * 256 * 4096; const float* ks = inp(lds, 15) + j * 256; for (int it = gw; it < 4 * 128; it += NGW)  wconv_item<1>(w, 256, 4096, (bf16_t*)(wb + W_UKV), 128, ks, scr, it, lane); }
            { const float* w = inp(lds, 17) + (size_t)j * 2048 * 1024; for (int it = gw; it < 32 * 32; it += NGW)  wconv_item<1>(w, 2048, 1024, (bf16_t*)(wb + W_ODOUT), 32, nullptr, scr, it, lane); }
        }
        __syncthreads();
        {
            const float* cvec = inp(lds, 1); const float* cctx = inp(lds, 3); const float* mod_w = inp(lds, 4); const float* mod_b = inp(lds, 5);
            LAS float* Ssil = (LAS float*)lds;
            LAS float* red = (LAS float*)(lds + 33 * 128 * 4);
            const int cl = tid & 127, kq = tid >> 7;
            for (int it = bx; it < 4 * 24; it += G) {
                const int L = it / 24, n0 = (it % 24) * 128;
                float a[33];
#pragma unroll
                for (int r = 0; r < 33; ++r) a[r] = 0.f;
                for (int kc = 0; kc < 8; ++kc) {
                    __syncthreads();
                    for (int e = tid; e < 33 * 128; e += 512) { const int r = e >> 7, k = kc * 128 + (e & 127); const float v = (r < 32) ? ((const GAS float*)cvec)[r * 1024 + k] : ((const GAS float*)cctx)[k]; Ssil[e] = fsilu(v); }
                    __syncthreads();
                    float wv[32];
#pragma unroll
                    for (int k2 = 0; k2 < 32; ++k2) wv[k2] = ((const GAS float*)mod_w)[((size_t)L * 1024 + kc * 128 + kq * 32 + k2) * 3072 + n0 + cl];
#pragma unroll
                    for (int k2 = 0; k2 < 32; ++k2) { const int kl = kq * 32 + k2;
#pragma unroll
                        for (int r = 0; r < 33; ++r) a[r] += Ssil[r * 128 + kl] * wv[k2]; }
                }
                __syncthreads();
#pragma unroll
                for (int r = 0; r < 33; ++r) red[(kq * 33 + r) * 128 + cl] = a[r];
                __syncthreads();
                for (int e = tid; e < 33 * 128; e += 512) { const int r = e >> 7, c = e & 127;
                    ((GAS float*)modv)[((size_t)L * 33 + r) * 3072 + n0 + c] = red[(0 * 33 + r) * 128 + c] + red[(1 * 33 + r) * 128 + c] + red[(2 * 33 + r) * 128 + c] + red[(3 * 33 + r) * 128 + c] + ((const GAS float*)mod_b)[L * 3072 + n0 + c]; }
                __syncthreads();
            }
        }
        { float* cosT = (float*)(dob + DO_ROPE); float* sinT = cosT + 2048 * 32;
          for (int e = (vcu * 512 + tid); e < 2048 * 32; e += G * 512) {
            const int pos = e >> 5, i = e & 31; const float invf = __builtin_amdgcn_exp2f(-(float)(i & 15) * (13.287712379549449f / 16.0f));
            const float ang = (float)((i < 16) ? (pos >> 6) : (pos & 63)) * invf;
            ((GAS float*)cosT)[e] = __cosf(ang); ((GAS float*)sinT)[e] = __sinf(ang); } }
    }
    GRID_BAR();
    {
        PH_BEGIN
        const float* x = inp(lds, 0); const float* ctxin = inp(lds, 2);
        for (int rg = gw; rg < TOK / 4; rg += NGW) {
            const int r0 = rg * 4, b = r0 / SB, s = r0 % SB, midx = (s < CTXL) ? 32 : b;
            const float* src = (s < CTXL) ? ctxin + ((size_t)b * CTXL + s) * DM : x + ((size_t)b * SEQ + (s - CTXL)) * DM;
            const float* mv = modv + (size_t)midx * 3072;
            f32x4 v[4][4];
#pragma unroll
            for (int i = 0; i < 4; ++i)
#pragma unroll
                for (int jq = 0; jq < 4; ++jq) v[i][jq] = *(const GAS f32x4*)(src + (size_t)i * DM + jq * 256 + lane * 4);
#pragma unroll
            for (int jq = 0; jq < 4; ++jq) { const int c = jq * 256 + lane * 4; const f32x4 sh = *(const GAS f32x4*)(mv + c), sc = *(const GAS f32x4*)(mv + 1024 + c) + 1.0f;
#pragma unroll
                for (int i = 0; i < 4; ++i) { const f32x4 u = v[i][jq] * sc + sh;
                    u32x2 hw, uw; hw.x = cvt_pk_bf16(v[i][jq][0], v[i][jq][1]); hw.y = cvt_pk_bf16(v[i][jq][2], v[i][jq][3]); uw.x = cvt_pk_bf16(u[0], u[1]); uw.y = cvt_pk_bf16(u[2], u[3]);
                    *(GAS u32x2*)(H + (size_t)(r0 + i) * DM + c) = hw; *(GAS u32x2*)(U + (size_t)(r0 + i) * DM + c) = uw; } }
        }
    }
    GRID_BAR();

    for (int j = 0; j < 2; ++j) {
        { PH_BEGIN
          pg8::Gemm g{U, (const bf16_t*)(dob + DO_W + (size_t)j * W_PAIR + W_EVIN), DM, DM, NTILE, 37, 0, 1, 1, 0}; pg8::StaticOrder S; S.init(NTILE, 37, G, bx);
          EpiEvIn E{BIG, (float*)(dob + DO_SMALL), inp(lds, 10) + j * 16}; pg8::gemm_phase(lds, tid, g, S, E); }
        GRID_BAR();
        {   PH_BEGIN
            {
                const float* cw = inp(lds, 9) + (size_t)j * 3 * 1024;
                for (int rg = gw; rg < TOK / 4; rg += NGW) {
                    const int r0 = rg * 4, s0 = r0 % SB; const bool hp = (s0 != 0 && s0 != CTXL), hn = (s0 + 3 != CTXL - 1 && s0 + 3 != SB - 1);
                    bf16_t* er = BIG + (size_t)r0 * EV_LD;
#pragma unroll
                    for (int jj = 0; jj < 2; ++jj) { const int c = jj * 512 + lane * 8; const u32x4 z4 = (u32x4){0u, 0u, 0u, 0u};
                        u32x4 pw_[6], gw_[4];
                        pw_[0] = hp ? *(const GAS u32x4*)(er - EV_LD + 2048 + c) : z4;
#pragma unroll
                        for (int i = 0; i < 4; ++i) { pw_[1 + i] = *(const GAS u32x4*)(er + (size_t)i * EV_LD + 2048 + c); gw_[i] = *(const GAS u32x4*)(er + (size_t)i * EV_LD + c); }
                        pw_[5] = hn ? *(const GAS u32x4*)(er + (size_t)4 * EV_LD + 2048 + c) : z4;
                        const f32x4 w00 = *(const GAS f32x4*)(cw + c), w01 = *(const GAS f32x4*)(cw + c + 4), w10 = *(const GAS f32x4*)(cw + 1024 + c), w11 = *(const GAS f32x4*)(cw + 1024 + c + 4),
                                    w20 = *(const GAS f32x4*)(cw + 2048 + c), w21 = *(const GAS f32x4*)(cw + 2048 + c + 4);
                        f32x4 p[6][2];
#pragma unroll
                        for (int i = 0; i < 6; ++i) unpack8(pw_[i], p[i][0], p[i][1]);
#pragma unroll
                        for (int i = 0; i < 4; ++i) { f32x4 g0, g1; unpack8(gw_[i], g0, g1);
                            *(GAS u32x4*)(er + (size_t)i * EV_LD + c) = pack8(g0 * (p[i][0] * w00 + p[i + 1][0] * w10 + p[i + 2][0] * w20), g1 * (p[i][1] * w01 + p[i + 1][1] * w11 + p[i + 2][1] * w21)); } }
                }
            }
            {
                for (int it = vcu; it < NB * 8; it += G) {
                    unsigned char* w2 = ws; unsigned char* d2 = dob; asm volatile("" : "+s"(w2), "+s"(d2));
                    const int b = it >> 3, head = (it >> 1) & 3, dh = it & 1;
                    msc::scan_item((const bf16_t*)(w2 + WS_BIG) + (size_t)b * SB * EV_LD, (const float*)(d2 + DO_SMALL) + (size_t)b * SB * 16, (bf16_t*)(d2 + DO_U) + (size_t)b * SB * DM, head, dh, lds, wave0);
                }
            }
        }
        GRID_BAR();
        { PH_BEGIN
          pg8::Gemm g{BIG, (const bf16_t*)(dob + DO_W + (size_t)j * W_PAIR + W_EVOUT), EV_LD, 2048, NTILE, 4, 0, 1, 1, 0}; pg8::StaticOrder S; S.init(NTILE, 4, G, bx);
          EpiOut E{H, modv + (size_t)(2 * j) * 33 * 3072}; pg8::gemm_phase(lds, tid, g, S, E); }
        GRID_BAR();
        {   PH_BEGIN
            const int L = 2 * j;
            ln_phase<false>(H, U, nullptr, inp(lds, 6) + L * DM, inp(lds, 7) + L * DM, modv + (size_t)(L + 1) * 33 * 3072, gw, NGW, lane, 0u);
        }
        GRID_BAR();
        const bool need_ctx = (j == 0);
        { PH_BEGIN
          pg8::Gemm g{U, (const bf16_t*)(dob + DO_W + (size_t)j * W_PAIR + W_ODIN), DM, DM, NTILE, 11, 0, 1, 1, 0}; pg8::StaticOrder S; S.init(NTILE, 11, G, bx);
          EpiOdIn E{BIG}; pg8::gemm_phase(lds, tid, g, S, E); }
        GRID_BAR();
        {   PH_BEGIN
            float* rowsc = (float*)(dob + DO_ROWSC); bf16_t* KR = (bf16_t*)(dob + DO_SMALL); const float* cosT = (const float*)(dob + DO_ROPE); const float* sinT = cosT + 2048 * 32;
            for (int rg = gw; rg < TOK / 4; rg += NGW) {
                const int r0 = rg * 4, s0 = r0 % SB; const bool lat = s0 >= CTXL;
                unsigned wq[4][3], wk[4][2]; bf16_t x1[4], x2[4]; float cc[4], sn[4];
#pragma unroll
                for (int i = 0; i < 4; ++i) { const GAS bf16_t* orow = (const GAS bf16_t*)BIG + (size_t)(r0 + i) * OD_LD + 2048;
#pragma unroll
                    for (int q = 0; q < 3; ++q) wq[i][q] = *(const GAS unsigned*)(orow + (q * 64 + lane) * 2);
#pragma unroll
                    for (int q = 0; q < 2; ++q) wk[i][q] = *(const GAS unsigned*)(orow + 384 + (q * 64 + lane) * 2);
                    x1[i] = orow[640 + (lane & 31)]; x2[i] = orow[672 + (lane & 31)];
                    cc[i] = 1.f; sn[i] = 0.f;
                    if (lat) { cc[i] = ((const GAS float*)cosT)[(s0 + i - CTXL) * 32 + (lane & 31)]; sn[i] = ((const GAS float*)sinT)[(s0 + i - CTXL) * 32 + (lane & 31)]; } }
                float sq[4], sk[4];
#pragma unroll
                for (int i = 0; i < 4; ++i) { sq[i] = 0.f; sk[i] = 0.f;
#pragma unroll
                    for (int q = 0; q < 3; ++q) { const float a = bflo(wq[i][q]), c = bfhi(wq[i][q]); sq[i] += a * a + c * c; }
#pragma unroll
                    for (int q = 0; q < 2; ++q) { const float a = bflo(wk[i][q]), c = bfhi(wk[i][q]); sk[i] += a * a + c * c; } }
#pragma unroll
                for (int o = 1; o < 64; o <<= 1)
#pragma unroll
                    for (int i = 0; i < 4; ++i) { sq[i] += __shfl_xor(sq[i], o); sk[i] += __shfl_xor(sk[i], o); }
#pragma unroll
                for (int i = 0; i < 4; ++i) { const size_t r = (size_t)(r0 + i);
                    if (lane == 0) { ((GAS float*)rowsc)[r * 2] = 1.0f / sqrtf(sq[i] * (1.0f / 384.0f) + RMS_EPS); ((GAS float*)rowsc)[r * 2 + 1] = 1.0f / sqrtf(sk[i] * (1.0f / 256.0f) + RMS_EPS); }
                    if (lane < 32) { const float a = bf1(x1[i]), c = bf1(x2[i]);
                        ((GAS bf16_t*)KR)[r * 64 + lane] = f2bf(a * cc[i] - c * sn[i]); ((GAS bf16_t*)KR)[r * 64 + 32 + lane] = f2bf(a * sn[i] + c * cc[i]); } }
            }
        }
        GRID_BAR();
        for (int grp = 0; grp < NGRP; ++grp) {
            { PH_BEGIN
              const float* rowsc = (const float*)(dob + DO_ROWSC); const float* cosT = (const float*)(dob + DO_ROPE);
              pg8::Gemm g{BIG + 2048, (const bf16_t*)(dob + DO_W + (size_t)j * W_PAIR + W_UQ), OD_LD, 384, need_ctx ? GT : GB * 8, 12, grp * GT, need_ctx ? 1 : 8, need_ctx ? 1 : 9, need_ctx ? 0 : 1};
              pg8::StaticOrder S; S.init(g.nM, 12, G, bx); EpiUq E{(bf16_t*)(ws + WS_BIG + BIG_Q), rowsc, cosT, cosT + 2048 * 32, grp}; pg8::gemm_phase(lds, tid, g, S, E); }
            { PH_BEGIN
              const float* rowsc = (const float*)(dob + DO_ROWSC);
              pg8::Gemm g{BIG + 2432, (const bf16_t*)(dob + DO_W + (size_t)j * W_PAIR + W_UKV), OD_LD, 256, GT, 16, grp * GT, 1, 1, 0};
              pg8::StaticOrder S; S.init(GT, 16, G, bx); EpiUkv E{(bf16_t*)(ws + WS_BIG + BIG_K), (bf16_t*)(ws + WS_BIG + BIG_V), rowsc, (const bf16_t*)(dob + DO_SMALL), grp}; pg8::gemm_phase(lds, tid, g, S, E); }
            GRID_BAR();
            {   PH_BEGIN
                const int nunits = GB * 16 * 8 + (need_ctx ? GB * 16 : 0);
                for (int un = vcu; un < nunits; un += G) {
                    unsigned char* w2 = ws; asm volatile("" : "+s"(w2));
                    const bf16_t* Qb = (const bf16_t*)(w2 + WS_BIG + BIG_Q); const bf16_t* Kb = (const bf16_t*)(w2 + WS_BIG + BIG_K); const bf16_t* Vb = (const bf16_t*)(w2 + WS_BIG + BIG_V);
                    bf16_t* BIG2 = (bf16_t*)(w2 + WS_BIG);
                    int bl, head, qb, nkeys;
                    if (un < GB * 128) { bl = un >> 7; head = (un >> 3) & 15; qb = 1 + (un & 7); nkeys = SB; }
                    else { const int u2 = un - GB * 128; bl = u2 >> 4; head = u2 & 15; qb = 0; nkeys = CTXL; }
                    const size_t bh = (size_t)(bl * 16 + head) * SB;
                    att::attn_unit(Qb + (bh + qb * 256) * 192, Kb + bh * 192, Vb + bh * 128, BIG2 + (size_t)((grp * GB + bl) * SB + qb * 256) * OD_LD + head * 128, nkeys, lds, tid);
                }
            }
            GRID_BAR();
        }
        { PH_BEGIN
          pg8::Gemm g{BIG, (const bf16_t*)(dob + DO_W + (size_t)j * W_PAIR + W_ODOUT), OD_LD, 2048, need_ctx ? NTILE : NB * 8, 4, 0, need_ctx ? 1 : 8, need_ctx ? 1 : 9, need_ctx ? 0 : 1}; pg8::StaticOrder S; S.init(g.nM, 4, G, bx);
          EpiOut E{H, modv + (size_t)(2 * j + 1) * 33 * 3072}; pg8::gemm_phase(lds, tid, g, S, E); }
        GRID_BAR();
        {   PH_BEGIN
            const int L = 2 * j + 1;
            if (need_ctx) ln_phase<false>(H, U, nullptr, inp(lds, 6) + L * DM, inp(lds, 7) + L * DM, modv + (size_t)(L + 1) * 33 * 3072, gw, NGW, lane, 0u);
            else { const unsigned tmo = __hip_atomic_load((GAS unsigned*)(ws + WS_CTL) + 4096 + XB_TMO, __ATOMIC_RELAXED, __HIP_MEMORY_SCOPE_AGENT);
                   ln_phase<true>(H, nullptr, (float*)dob, inp(lds, 6) + L * DM, inp(lds, 7) + L * DM, nullptr, gw, NGW, lane, tmo); }
        }
        if (need_ctx) GRID_BAR();
    }
}

extern "C" void kernel_launch(void* const* d_in, const int* in_sizes, int n_in, void* d_out, int out_size, void* d_ws, size_t ws_size, hipStream_t stream) {
    static int grid = 0;
    if (grid == 0) {
        if (n_in != 18 || out_size != NB * SEQ * DM || ws_size < WS_END) { fprintf(stderr, "kernel_launch: unexpected shapes (n_in %d out %d ws %zu)\n", n_in, out_size, ws_size); grid = -1; return; }
        int dev = 0, cus = 0;
        if (hipGetDevice(&dev) != hipSuccess || hipDeviceGetAttribute(&cus, hipDeviceAttributeMultiprocessorCount, dev) != hipSuccess) { grid = -1; return; }
        if (hipFuncSetAttribute((const void*)fwd_kernel, hipFuncAttributeMaxDynamicSharedMemorySize, LDS_BYTES) != hipSuccess) { fprintf(stderr, "kernel_launch: hipFuncSetAttribute failed\n"); grid = -1; return; }
        int per_cu = 0;
        if (hipOccupancyMaxActiveBlocksPerMultiprocessor(&per_cu, (const void*)fwd_kernel, 512, LDS_BYTES) != hipSuccess || per_cu < 1) fprintf(stderr, "kernel_launch: occupancy query says %d\n", per_cu);
        (void)hipGetLastError();
        grid = cus;
    }
    if (grid < 0) return;
    if (hipMemsetAsync((char*)d_ws + WS_CTL, 0, CTL_BYTES, stream) != hipSuccess) return;
    Params p{};
    for (int i = 0; i < 18; ++i) p.in[i] = (const float*)d_in[i];
    p.out = (float*)d_out; p.ws = (unsigned char*)d_ws;
    hipLaunchKernelGGL(fwd_kernel, dim3(grid), dim3(512), LDS_BYTES, stream, p);
}
```

```cpp
#include <hip/hip_runtime.h>
#include <cstdio>
#include <cstdint>

#define LAS __attribute__((address_space(3)))
#define GAS __attribute__((address_space(1)))
typedef unsigned short bf16_t;
typedef short bf16x8 __attribute__((ext_vector_type(8)));
typedef float f32x4 __attribute__((ext_vector_type(4)));
typedef unsigned u32x4 __attribute__((ext_vector_type(4)));
typedef unsigned u32x2 __attribute__((ext_vector_type(2)));

constexpr int DM = 1024, NB = 32, SEQ = 2048, CTXL = 256, SB = SEQ + CTXL  , TOK = NB * SB  ;
constexpr int NTILE = TOK / 256;
constexpr int EV_LD = 6144;
constexpr int EV_NP = 9472;
constexpr int OD_LD = 2816;
constexpr int NGRP = 4, GB = NB / NGRP  , GT = GB * 9  , GROWS = GB * SB  ;
constexpr float ALPHA = 1.681792830507429f;
constexpr float QSCALE = 0.07216878364870322f * 1.4426950408889634f;
constexpr float LN_EPS = 1e-5f, RMS_EPS = 1e-6f;

constexpr size_t DO_U = 0;
constexpr size_t DO_W = 150994944;
constexpr size_t W_PAIR = 38010880, W_EVIN = 0, W_EVOUT = 19398656, W_ODIN = 23592960, W_UQ = 29360128, W_UKV = 31719424, W_ODOUT = 33816576;
constexpr size_t DO_MODV = DO_W + 2 * W_PAIR;
constexpr size_t DO_ROPE = DO_MODV + 1622016;
constexpr size_t DO_ROWSC = DO_ROPE + 524288;
constexpr size_t DO_SMALL = DO_ROWSC + 589824;
constexpr size_t DO_END = DO_SMALL + 9437184;
static_assert(DO_END <= 268435456, "d_out map");
constexpr size_t WS_CTL = 0, CTL_BYTES = 1 << 20;
constexpr size_t WS_H = 1 << 20;
constexpr size_t WS_BIG = WS_H + 150994944;
constexpr size_t BIG_Q = 415236096, BIG_K = BIG_Q + 113246208, BIG_V = BIG_K + 113246208;
constexpr size_t WS_END = WS_BIG + 905969664;
static_assert(WS_END <= 1073741824, "ws map");
static_assert(BIG_V + 75497472 <= 905969664, "odd map");

__device__ __forceinline__ unsigned cvt_pk_bf16(float lo, float hi) { unsigned r; asm volatile("v_cvt_pk_bf16_f32 %0, %1, %2" : "=v"(r) : "v"(lo), "v"(hi)); return r; }
__device__ __forceinline__ float bflo(unsigned w) { return __uint_as_float(w << 16); }
__device__ __forceinline__ float bfhi(unsigned w) { return __uint_as_float(w & 0xffff0000u); }
__device__ __forceinline__ float bf1(bf16_t h) { return __uint_as_float(((unsigned)h) << 16); }
__device__ __forceinline__ bf16_t f2bf(float f) { return (bf16_t)(cvt_pk_bf16(f, 0.f) & 0xffffu); }
__device__ __forceinline__ float fsigmoid(float x) { return __builtin_amdgcn_rcpf(1.0f + __builtin_amdgcn_exp2f(-1.4426950408889634f * x)); }
__device__ __forceinline__ float fsilu(float x) { return x * fsigmoid(x); }
__device__ __forceinline__ float wave_sum(float v) {
#pragma unroll
    for (int o = 1; o < 64; o <<= 1) v += __shfl_xor(v, o);
    return v;
}
#define LDS_WAIT() asm volatile("s_waitcnt lgkmcnt(0)" ::: "memory")

#define XB_TMO      128
#define XB_XCNT(j)  (256  + 64 * (j))
#define XB_XSUB(j)  (1280 + 64 * (j))
#define XB_XGEN(j)  (2304 + 64 * (j))
#define XB_TOP      3328
#define XB_TOPGEN   3392
#define XCD_BAR_WORDS 3456
#define XB_SPIN_CAP (1u << 24)
__device__ __forceinline__ unsigned xb_ld(unsigned* p)              { return __hip_atomic_load((GAS unsigned*)p, __ATOMIC_RELAXED, __HIP_MEMORY_SCOPE_AGENT); }
__device__ __forceinline__ unsigned xb_add(unsigned* p, unsigned v) { return __hip_atomic_fetch_add((GAS unsigned*)p, v, __ATOMIC_RELAXED, __HIP_MEMORY_SCOPE_AGENT); }
__device__ __forceinline__ unsigned xb_xcc_id() { return (unsigned)__builtin_amdgcn_s_getreg((3 << 11) | 20) & 0xFu; }
#define XB_SPIN(cond, bar) do { unsigned _sp = 0; while (cond) { __builtin_amdgcn_s_sleep(1); \
    if ((++_sp & 255u) == 0u) { if (xb_ld(&(bar)[XB_TMO])) break; if (_sp > XB_SPIN_CAP) { __hip_atomic_fetch_add((GAS unsigned*)&(bar)[XB_TMO], 1u, __ATOMIC_RELAXED, __HIP_MEMORY_SCOPE_AGENT); break; } } } } while (0)
struct XcdBarrier { unsigned* bar; unsigned x; volatile LAS unsigned* st; };
__device__ __forceinline__ XcdBarrier xcd_barrier_post(unsigned* bar, volatile LAS unsigned* st) {
    XcdBarrier b; b.bar = bar; b.x = xb_xcc_id(); b.st = st;
    if (threadIdx.x == 0) (void)xb_add(&bar[XB_XCNT(b.x)], 1u);
    return b;
}
__device__ __forceinline__ void xcd_barrier_complete(unsigned* bar, unsigned x, unsigned& nloc, unsigned& nx) {
    const unsigned G = gridDim.x * gridDim.y * gridDim.z;
    unsigned sum, cnt, mine, sp = 0u;
    for (;;) {
        sum = 0u; cnt = 0u; mine = 0u;
#pragma unroll
        for (unsigned j = 0; j < 16; ++j) { const unsigned c = xb_ld(&bar[XB_XCNT(j)]); sum += c; cnt += (c > 0u) ? 1u : 0u; mine = (j == x) ? c : mine; }
        if (sum == G) break;
        __builtin_amdgcn_s_sleep(1);
        if ((++sp & 255u) == 0u) { if (xb_ld(&bar[XB_TMO])) break; if (sp > XB_SPIN_CAP) { __hip_atomic_fetch_add((GAS unsigned*)&bar[XB_TMO], 1u, __ATOMIC_RELAXED, __HIP_MEMORY_SCOPE_AGENT); break; } }
    }
    nloc = mine > 0u ? mine : 1u; nx = cnt > 0u ? cnt : 1u;
}
__device__ __forceinline__ void xcd_barrier(const XcdBarrier& b) {
    asm volatile("s_waitcnt vmcnt(0)" ::: "memory");
    __syncthreads();
    if (threadIdx.x == 0) {
        unsigned* bar = b.bar;
        __builtin_amdgcn_s_waitcnt(0);
        unsigned nloc = b.st[0], nx = b.st[1];
        if (nloc == 0u) { xcd_barrier_complete(bar, b.x, nloc, nx); b.st[0] = nloc; b.st[1] = nx; }
        const unsigned old = xb_add(&bar[XB_XSUB(b.x)], 1u);
        const unsigned gen = old / nloc;
        if (old + 1u == (gen + 1u) * nloc) {
            __builtin_amdgcn_fence(__ATOMIC_RELEASE, "agent");
            asm volatile("s_waitcnt vmcnt(0)" ::: "memory");
            const unsigned og = xb_add(&bar[XB_TOP], 1u);
            const unsigned tg = og / nx;
            if (og + 1u == (tg + 1u) * nx) xb_add(&bar[XB_TOPGEN], 1u);
            else XB_SPIN(xb_ld(&bar[XB_TOPGEN]) == tg, bar);
            __builtin_amdgcn_fence(__ATOMIC_ACQUIRE, "agent");
            xb_add(&bar[XB_XGEN(b.x)], 1u);
            asm volatile("s_waitcnt vmcnt(0)" ::: "memory");
        } else {
            XB_SPIN(xb_ld(&bar[XB_XGEN(b.x)]) == gen, bar);
            __builtin_amdgcn_fence(__ATOMIC_ACQUIRE, "agent");
            asm volatile("s_waitcnt vmcnt(0)" ::: "memory");
        }
    }
    __syncthreads();
}

namespace pg8 {
constexpr int BM = 256, BK = 64, HALF = 128, HTB = HALF * BK * 2, STAGE_BYTES = 8 * HTB, NXCD = 8, WGM = 8;
__host__ __device__ __forceinline__ int lds_byte(int r, int c) { const int st = (r >> 4) * 2 + (c >> 5), rr = r & 15, cc = c & 31, ob = rr * 64 + cc * 2; return st * 1024 + (ob ^ (((ob >> 9) & 1) << 5)); }
__host__ __device__ __forceinline__ void stage_rc(int b, int& R, int& C) { const int st = b / 1024, sb = b % 1024, swz = sb ^ (((sb >> 9) & 1) << 5); R = (st >> 1) * 16 + swz / 64; C = (st & 1) * 32 + (swz % 64) / 2; }
__host__ __device__ __forceinline__ int perm32(int rho) { const int n = rho >> 4, i = rho & 15; return 8 * (i >> 2) + 4 * n + (i & 3); }
struct Unit { int pm, pn; };
struct Gemm { const bf16_t* A; const bf16_t* Bt; int lda, K, nM, nN, tbase, gsz, gstride, goff;
    __device__ __forceinline__ int ptile(int pm) const { return tbase + (pm / gsz) * gstride + goff + (pm % gsz); } };
struct StaticOrder {
    int nM, nN, nwg, G, c;
    __device__ void init(int nM_, int nN_, int G_, int c_) { nM = nM_; nN = nN_; nwg = nM * nN; G = G_; c = c_; }
    __device__ bool next(int i, Unit& u) const {
        const long L = (long)i * G + c; if (L >= nwg) return false;
        int wgid = (int)L; { const int q = nwg / NXCD, r = nwg % NXCD, xcd = wgid % NXCD, off = wgid / NXCD; wgid = (xcd < r ? xcd * (q + 1) : r * (q + 1) + (xcd - r) * q) + off; }
        const int nig = WGM * nN, gid = wgid / nig, fm = gid * WGM, gsz = (nM - fm) < WGM ? (nM - fm) : WGM;
        u.pm = fm + ((wgid % nig) % gsz); u.pn = (wgid % nig) / gsz; return true;
    }
};
template <class Epi>
__device__ __forceinline__ void gemm_phase(LAS unsigned char* lds, const int tid, const Gemm g, const StaticOrder& S, const Epi& E) {
    const int wid = __builtin_amdgcn_readfirstlane(tid >> 6), lane = tid & 63, wr = wid >> 2, wc = wid & 3, fr = lane & 15, fq = lane >> 4;
    const int K = g.K, nt = K / BK, lda = g.lda;
    unsigned voffA[2], voffB[2];
#pragma unroll
    for (int i = 0; i < 2; ++i) { int R, C; stage_rc(tid * 16 + i * 8192, R, C); const int Rb = (R & ~31) + perm32(R & 31);
        voffA[i] = (unsigned)(R * lda + C) * 2u; voffB[i] = (unsigned)(Rb * K + C) * 2u; }
    const size_t kstep = (size_t)(BK * 2);
    const size_t hstepA = (size_t)HALF * lda * 2, hstepB = (size_t)HALF * K * 2;
    const size_t tstepA = 2 * hstepA, tstepB = 2 * hstepB;
    const unsigned ldsw = (unsigned)wid * 1024u;
    const int aoff = lds_byte(wr * 64 + fr, fq * 8), boff = lds_byte(wc * 32 + fr, fq * 8);
#define PG8_SA(b, h) (((b) * 2 + (h)) * HTB)
#define PG8_SB(b, h) ((4 + (b) * 2 + (h)) * HTB)
#define PG8_STAGE(bufoff, gbase, voff) do { _Pragma("unroll") for (int _i = 0; _i < 2; ++_i) \
        __builtin_amdgcn_global_load_lds((const unsigned*)((const char*)(gbase) + (voff)[_i]), (LAS unsigned*)(lds + (bufoff) + ldsw + _i * 8192), 16, 0, 0); } while (0)
#define PG8_LDA(dst, b, h) do { _Pragma("unroll") for (int m = 0; m < 4; ++m) _Pragma("unroll") for (int k = 0; k < 2; ++k) dst[m][k] = *(const LAS bf16x8*)(lds + PG8_SA(b, h) + aoff + m * 2048 + k * 1024); } while (0)
#define PG8_LDB(dst, b, h) do { _Pragma("unroll") for (int n = 0; n < 2; ++n) _Pragma("unroll") for (int k = 0; k < 2; ++k) dst[n][k] = *(const LAS bf16x8*)(lds + PG8_SB(b, h) + boff + n * 2048 + k * 1024); } while (0)
#define PG8_MMA(ai, bj, At, Bt) do { __builtin_amdgcn_s_setprio(1); _Pragma("unroll") for (int m = 0; m < 4; ++m) _Pragma("unroll") for (int n = 0; n < 2; ++n) _Pragma("unroll") for (int k = 0; k < 2; ++k) \
        acc[ai][bj][m][n] = __builtin_amdgcn_mfma_f32_16x16x32_bf16(Bt[n][k], At[m][k], acc[ai][bj][m][n], 0, 0, 0); __builtin_amdgcn_s_setprio(0); } while (0)
#define PG8_WAIT_V(n) asm volatile("s_waitcnt vmcnt(" #n ")" ::: "memory")
#define PG8_WAIT_L(n) asm volatile("s_waitcnt lgkmcnt(" #n ")" ::: "memory")
#define PG8_BAR __builtin_amdgcn_s_barrier()
#define PG8_SCHED __builtin_amdgcn_sched_barrier(0)
    Unit cur, nxt; int ui = 0;
    if (!S.next(0, cur)) return;
    f32x4 acc[2][2][4][2];
#pragma unroll
    for (int a = 0; a < 2; ++a)
#pragma unroll
        for (int b = 0; b < 2; ++b)
#pragma unroll
            for (int m = 0; m < 4; ++m)
#pragma unroll
                for (int n = 0; n < 2; ++n) acc[a][b][m][n] = (f32x4){0.f, 0.f, 0.f, 0.f};
    bf16x8 At[4][2], B0[2][2], B1[2][2];
    int curpt = g.ptile(cur.pm);
    const char* cA = (const char*)g.A + (size_t)curpt * tstepA; const char* cB = (const char*)g.Bt + (size_t)cur.pn * tstepB;
    PG8_STAGE(PG8_SB(0, 0), cB, voffB); PG8_STAGE(PG8_SA(0, 0), cA, voffA); PG8_STAGE(PG8_SB(0, 1), cB + hstepB, voffB); PG8_STAGE(PG8_SA(0, 1), cA + hstepA, voffA);
    if (wr == 1) PG8_BAR;
    PG8_WAIT_V(4); PG8_BAR;
    PG8_STAGE(PG8_SB(1, 0), cB + kstep, voffB); PG8_STAGE(PG8_SA(1, 0), cA + kstep, voffA); PG8_STAGE(PG8_SB(1, 1), cB + hstepB + kstep, voffB);
    PG8_WAIT_V(6); PG8_BAR;
    for (;;) {
        const bool has_next = S.next(ui + 1, nxt);
        const int nxtpt = has_next ? g.ptile(nxt.pm) : curpt;
        const char* nA = has_next ? (const char*)g.A + (size_t)nxtpt * tstepA : cA; const char* nB = has_next ? (const char*)g.Bt + (size_t)nxt.pn * tstepB : cB;
#pragma unroll 1
        for (int t = 0; t < nt; t += 2) {
            const bool last = (t == nt - 2);
            const char* a1 = cA + (size_t)(t + 1) * kstep;
            const char* a2 = last ? nA : cA + (size_t)(t + 2) * kstep; const char* b2 = last ? nB : cB + (size_t)(t + 2) * kstep;
            const char* a3 = a2 + kstep; const char* b3 = b2 + kstep;
            PG8_LDB(B0, 0, 0); PG8_SCHED; PG8_LDA(At, 0, 0); PG8_STAGE(PG8_SA(1, 1), a1 + hstepA, voffA);
            PG8_WAIT_L(8); PG8_BAR; PG8_WAIT_L(0); PG8_MMA(0, 0, At, B0); PG8_BAR; PG8_SCHED;
            PG8_LDB(B1, 0, 1); PG8_STAGE(PG8_SB(0, 0), b2, voffB);
            PG8_BAR; PG8_WAIT_L(0); PG8_MMA(0, 1, At, B1); PG8_BAR;
            PG8_LDA(At, 0, 1); PG8_STAGE(PG8_SA(0, 0), a2, voffA);
            PG8_BAR; PG8_WAIT_L(0); PG8_MMA(1, 0, At, B0); PG8_BAR; PG8_SCHED;
            PG8_STAGE(PG8_SB(0, 1), b2 + hstepB, voffB);
            PG8_WAIT_V(6); PG8_BAR; PG8_MMA(1, 1, At, B1); PG8_BAR;
            PG8_LDB(B0, 1, 0); PG8_SCHED; PG8_LDA(At, 1, 0); PG8_STAGE(PG8_SA(0, 1), a2 + hstepA, voffA);
            PG8_WAIT_L(8); PG8_BAR; PG8_WAIT_L(0); PG8_MMA(0, 0, At, B0); PG8_BAR; PG8_SCHED;
            PG8_LDB(B1, 1, 1); PG8_STAGE(PG8_SB(1, 0), b3, voffB);
            PG8_BAR; PG8_WAIT_L(0); PG8_MMA(0, 1, At, B1); PG8_BAR;
            PG8_LDA(At, 1, 1); PG8_STAGE(PG8_SA(1, 0), a3, voffA);
            PG8_BAR; PG8_WAIT_L(0); PG8_MMA(1, 0, At, B0); PG8_BAR; PG8_SCHED;
            PG8_STAGE(PG8_SB(1, 1), b3 + hstepB, voffB);
            PG8_WAIT_V(6); PG8_BAR; PG8_MMA(1, 1, At, B1); PG8_BAR;
        }
        E(acc, cur.pn, curpt, wr, wc, fr, fq);
        if (!has_next) break;
#pragma unroll
        for (int a = 0; a < 2; ++a)
#pragma unroll
            for (int b = 0; b < 2; ++b)
#pragma unroll
                for (int m = 0; m < 4; ++m)
#pragma unroll
                    for (int n = 0; n < 2; ++n) acc[a][b][m][n] = (f32x4){0.f, 0.f, 0.f, 0.f};
        cur = nxt; cA = nA; cB = nB; curpt = nxtpt; ++ui;
    }
    PG8_WAIT_V(0);
    if (wr == 0) PG8_BAR;
    PG8_BAR;
#undef PG8_SA
#undef PG8_SB
#undef PG8_STAGE
#undef PG8_LDA
#undef PG8_LDB
#undef PG8_MMA
#undef PG8_WAIT_V
#undef PG8_WAIT_L
#undef PG8_BAR
#undef PG8_SCHED
}
}

typedef const f32x4 (&AccRef)[2][2][4][2];
__device__ __forceinline__ u32x4 pack8(const f32x4 a, const f32x4 b) { u32x4 w; w.x = cvt_pk_bf16(a[0], a[1]); w.y = cvt_pk_bf16(a[2], a[3]); w.z = cvt_pk_bf16(b[0], b[1]); w.w = cvt_pk_bf16(b[2], b[3]); return w; }
__device__ __forceinline__ void unpack8(const u32x4 w, f32x4& a, f32x4& b) { a = (f32x4){bflo(w.x), bfhi(w.x), bflo(w.y), bfhi(w.y)}; b = (f32x4){bflo(w.z), bfhi(w.z), bflo(w.w), bfhi(w.w)}; }
__device__ __forceinline__ f32x4 silu4(f32x4 v) { return (f32x4){fsilu(v[0]), fsilu(v[1]), fsilu(v[2]), fsilu(v[3])}; }
__device__ __forceinline__ f32x4 sigm4(f32x4 v) { return (f32x4){fsigmoid(v[0]), fsigmoid(v[1]), fsigmoid(v[2]), fsigmoid(v[3])}; }

struct EpiEvIn {
    bf16_t* EV; float* gates; const float* gate_b;
    __device__ __forceinline__ void operator()(AccRef acc, int pn, int pt, int wr, int wc, int fr, int fq) const {
        const int row0 = pt * 256 + wr * 64 + fr, cl = wc * 32 + 8 * fq;
        if (pn < 24) {
            const int kind = pn >> 3, col = kind * 1024 + (pn & 7) * 128 + cl;
#pragma unroll
            for (int ai = 0; ai < 2; ++ai)
#pragma unroll
                for (int m = 0; m < 4; ++m) {
                    const f32x4 x0 = acc[ai][0][m][0], x1 = acc[ai][0][m][1], y0 = acc[ai][1][m][0], y1 = acc[ai][1][m][1];
                    f32x4 r0, r1;
                    if (kind == 0) { r0 = x0 * silu4(y0); r1 = x1 * silu4(y1); }
                    else if (kind == 1) { r0 = sigm4(x0) * silu4(y0); r1 = sigm4(x1) * silu4(y1); }
                    else { r0 = x0 * y0; r1 = x1 * y1; }
                    *(GAS u32x4*)(EV + (size_t)(row0 + ai * 128 + m * 16) * EV_LD + col) = pack8(r0, r1);
                    asm volatile("" ::: "memory");
                }
        } else if (pn < 36) {
            const int col = 3072 + (pn - 24) * 256 + cl;
#pragma unroll
            for (int ai = 0; ai < 2; ++ai)
#pragma unroll
                for (int m = 0; m < 4; ++m)
#pragma unroll
                    for (int bj = 0; bj < 2; ++bj)
                        *(GAS u32x4*)(EV + (size_t)(row0 + ai * 128 + m * 16) * EV_LD + col + bj * 128) = pack8(acc[ai][bj][m][0], acc[ai][bj][m][1]);
        } else {
            if (wc == 0 && fq < 2) {
                const f32x4 b0 = *(const GAS f32x4*)(gate_b + 8 * fq), b1 = *(const GAS f32x4*)(gate_b + 8 * fq + 4);
#pragma unroll
                for (int ai = 0; ai < 2; ++ai)
#pragma unroll
                    for (int m = 0; m < 4; ++m) {
                        GAS float* gp = (GAS float*)gates + (size_t)(row0 + ai * 128 + m * 16) * 16 + 8 * fq;
                        *(GAS f32x4*)gp = acc[ai][0][m][0] + b0; *(GAS f32x4*)(gp + 4) = acc[ai][0][m][1] + b1;
                    }
            }
        }
    }
};
struct EpiOdIn {
    bf16_t* OD;
    __device__ __forceinline__ void operator()(AccRef acc, int pn, int pt, int wr, int wc, int fr, int fq) const {
        const int row0 = pt * 256 + wr * 64 + fr, col = pn * 256 + wc * 32 + 8 * fq;
#pragma unroll
        for (int ai = 0; ai < 2; ++ai)
#pragma unroll
            for (int m = 0; m < 4; ++m)
#pragma unroll
                for (int bj = 0; bj < 2; ++bj) {
                    f32x4 v0 = acc[ai][bj][m][0], v1 = acc[ai][bj][m][1];
                    if (pn < 8) { v0 = silu4(v0); v1 = silu4(v1); }
                    *(GAS u32x4*)(OD + (size_t)(row0 + ai * 128 + m * 16) * OD_LD + col + bj * 128) = pack8(v0, v1);
                }
    }
};
struct EpiUq {
    bf16_t* Q; const float* rowsc; const float* cosT; const float* sinT; int grp;
    __device__ __forceinline__ void operator()(AccRef acc, int pn, int pt, int wr, int wc, int fr, int fq) const {
        const int lt = pt - grp * GT, bl = lt / 9, s0 = (lt % 9) * 256 + wr * 64 + fr, row0 = pt * 256 + wr * 64 + fr;
        float sc[8];
#pragma unroll
        for (int i = 0; i < 8; ++i) sc[i] = ((const GAS float*)rowsc)[(size_t)(row0 + (i >> 2) * 128 + (i & 3) * 16) * 2];
        if (pn < 8) {
#pragma unroll
            for (int ai = 0; ai < 2; ++ai)
#pragma unroll
                for (int m = 0; m < 4; ++m) {
                    const int ro = ai * 128 + m * 16; const float scq = sc[ai * 4 + m] * QSCALE;
#pragma unroll
                    for (int bj = 0; bj < 2; ++bj) {
                        const int head = 2 * pn + bj;
                        *(GAS u32x4*)(Q + ((size_t)(bl * 16 + head) * SB + s0 + ro) * 192 + wc * 32 + 8 * fq) = pack8(acc[ai][bj][m][0] * scq, acc[ai][bj][m][1] * scq);
                    }
                }
        } else {
            const int head = 4 * (pn - 8) + wc, i0 = 8 * fq; const bool lat = (lt % 9) != 0;
#pragma unroll
            for (int ai = 0; ai < 2; ++ai) {
                f32x4 c0[4], c1[4], n0[4], n1[4];
#pragma unroll
                for (int m = 0; m < 4; ++m) {
                    c0[m] = (f32x4){1.f, 1.f, 1.f, 1.f}; c1[m] = c0[m]; n0[m] = (f32x4){0.f, 0.f, 0.f, 0.f}; n1[m] = n0[m];
                    if (lat) { const int pos = s0 + ai * 128 + m * 16 - CTXL; c0[m] = *(const GAS f32x4*)(cosT + pos * 32 + i0); c1[m] = *(const GAS f32x4*)(cosT + pos * 32 + i0 + 4);
                        n0[m] = *(const GAS f32x4*)(sinT + pos * 32 + i0); n1[m] = *(const GAS f32x4*)(sinT + pos * 32 + i0 + 4); }
                }
#pragma unroll
                for (int m = 0; m < 4; ++m) {
                    const int s = s0 + ai * 128 + m * 16; const float scq = sc[ai * 4 + m] * QSCALE;
                    const f32x4 xa0 = acc[ai][0][m][0], xa1 = acc[ai][0][m][1], xb0 = acc[ai][1][m][0], xb1 = acc[ai][1][m][1];
                    bf16_t* qp = Q + ((size_t)(bl * 16 + head) * SB + s) * 192 + 128 + i0;
                    *(GAS u32x4*)qp = pack8((xa0 * c0[m] - xb0 * n0[m]) * scq, (xa1 * c1[m] - xb1 * n1[m]) * scq);
                    *(GAS u32x4*)(qp + 32) = pack8((xa0 * n0[m] + xb0 * c0[m]) * scq, (xa1 * n1[m] + xb1 * c1[m]) * scq);
                }
                asm volatile("" ::: "memory");
            }
        }
    }
};
struct EpiUkv {
    bf16_t* Kb; bf16_t* Vb; const float* rowsc; const bf16_t* KR; int grp;
    __device__ __forceinline__ void operator()(AccRef acc, int pn, int pt, int wr, int wc, int fr, int fq) const {
        const int lt = pt - grp * GT, bl = lt / 9, s0 = (lt % 9) * 256 + wr * 64 + fr, row0 = pt * 256 + wr * 64 + fr, head = pn;
        const int c8 = ((wc & 1) * 4 + fq) * 8;
        float sc[8]; u32x4 kr[8];
#pragma unroll
        for (int i = 0; i < 8; ++i) { const int ro = (i >> 2) * 128 + (i & 3) * 16; sc[i] = ((const GAS float*)rowsc)[(size_t)(row0 + ro) * 2 + 1];
            kr[i] = (wc < 2) ? *(const GAS u32x4*)(KR + (size_t)(row0 + ro) * 64 + c8) : (u32x4){0u, 0u, 0u, 0u}; }
#pragma unroll
        for (int ai = 0; ai < 2; ++ai)
#pragma unroll
            for (int m = 0; m < 4; ++m) {
                const int ro = ai * 128 + m * 16; const float scv = sc[ai * 4 + m];
                const size_t kv = (size_t)(bl * 16 + head) * SB + s0 + ro;
                *(GAS u32x4*)(Kb + kv * 192 + wc * 32 + 8 * fq) = pack8(acc[ai][0][m][0] * scv, acc[ai][0][m][1] * scv);
                *(GAS u32x4*)(Vb + kv * 128 + wc * 32 + 8 * fq) = pack8(acc[ai][1][m][0] * scv, acc[ai][1][m][1] * scv);
                if (wc < 2) *(GAS u32x4*)(Kb + kv * 192 + 128 + c8) = kr[ai * 4 + m];
            }
    }
};
struct EpiOut {
    bf16_t* H; const float* modv  ;
    __device__ __forceinline__ void operator()(AccRef acc, int pn, int pt, int wr, int wc, int fr, int fq) const {
        const int row0 = pt * 256 + wr * 64 + fr, midx = (pt % 9 == 0) ? 32 : pt / 9;
        const float* gv = modv + (size_t)midx * 3072 + 2048;
#pragma unroll
        for (int bj = 0; bj < 2; ++bj) {
            const int col = pn * 256 + bj * 128 + wc * 32 + 8 * fq;
            const f32x4 g0 = *(const GAS f32x4*)(gv + col), g1 = *(const GAS f32x4*)(gv + col + 4);
            u32x4 hw[8];
#pragma unroll
            for (int i = 0; i < 8; ++i) hw[i] = *(const GAS u32x4*)(H + (size_t)(row0 + (i >> 2) * 128 + (i & 3) * 16) * DM + col);
#pragma unroll
            for (int i = 0; i < 8; ++i) { const int ai = i >> 2, m = i & 3;
                f32x4 h0, h1; unpack8(hw[i], h0, h1);
                *(GAS u32x4*)(H + (size_t)(row0 + ai * 128 + m * 16) * DM + col) = pack8(h0 * ALPHA + g0 * acc[ai][bj][m][0], h1 * ALPHA + g1 * acc[ai][bj][m][1]); }
            asm volatile("" ::: "memory");
        }
    }
};

namespace att {
typedef short s16x4 __attribute__((ext_vector_type(4)));
typedef float f32x16 __attribute__((ext_vector_type(16)));
constexpr int SHM_V = 16384, SHM_KN = 16384, SHM_KR = 8192, OFF_V = 0, OFF_KN = 32768, OFF_KR = 65536, OFF_WS = 81920;
constexpr float THR2 = 11.5f;
#define KSWZ(row, colB) ((row) * 256 + ((colB) ^ (((row) & 7) << 4)))
#define KSWZ2(row, colB) ((row) * 128 + ((colB) ^ ((((row) >> 1) & 7) << 4)))
#define SBAR() __builtin_amdgcn_sched_barrier(0)
__device__ __forceinline__ int crow(int r, int hi) { return (r & 3) + 8 * (r >> 2) + 4 * hi; }
__device__ __forceinline__ void partialSM(f32x16& p0, f32x16& p1, float& m_reg, float& mn, float& alpha) {
  float pmax = p0[0];
#pragma unroll
  for (int r = 1; r < 16; ++r) pmax = fmaxf(pmax, p0[r]);
#pragma unroll
  for (int r = 0; r < 16; ++r) pmax = fmaxf(pmax, p1[r]);
  { auto rr = __builtin_amdgcn_permlane32_swap(__float_as_uint(pmax), __float_as_uint(pmax), false, false);
    pmax = fmaxf(__uint_as_float(rr[0]), __uint_as_float(rr[1])); }
  if (__builtin_expect(__all(pmax - m_reg <= THR2), 1)) { mn = m_reg; alpha = 1.f; }
  else { mn = fmaxf(m_reg, pmax); alpha = __builtin_amdgcn_exp2f(m_reg - mn); m_reg = mn; }
#pragma unroll
  for (int r = 0; r < 16; ++r) p0[r] = p0[r] - mn;
#pragma unroll
  for (int r = 0; r < 16; ++r) p1[r] = p1[r] - mn;
#pragma unroll
  for (int r = 0; r < 16; ++r) p0[r] = __builtin_amdgcn_exp2f(p0[r]);
}
__device__ __forceinline__ void finishSM(f32x16& p0, f32x16& p1, float alpha, float& l_reg, bf16x8& pa0, bf16x8& pa1, bf16x8& pa2, bf16x8& pa3) {
#pragma unroll
  for (int r = 0; r < 16; ++r) p1[r] = __builtin_amdgcn_exp2f(p1[r]);
  float ps = 0;
#pragma unroll
  for (int r = 0; r < 16; ++r) ps += p0[r];
#pragma unroll
  for (int r = 0; r < 16; ++r) ps += p1[r];
  { auto rr = __builtin_amdgcn_permlane32_swap(__float_as_uint(ps), __float_as_uint(ps), false, false);
    ps = __uint_as_float(rr[0]) + __uint_as_float(rr[1]); }
  l_reg = l_reg * alpha + ps;
#define PK4(P, BASE, OUT) do { unsigned a0 = cvt_pk_bf16(P[BASE + 0], P[BASE + 1]), a1 = cvt_pk_bf16(P[BASE + 2], P[BASE + 3]);   \
    unsigned b0 = cvt_pk_bf16(P[BASE + 4], P[BASE + 5]), b1 = cvt_pk_bf16(P[BASE + 6], P[BASE + 7]);                              \
    auto r0 = __builtin_amdgcn_permlane32_swap(a0, b0, false, false); auto r1 = __builtin_amdgcn_permlane32_swap(a1, b1, false, false); \
    u32x4 w = {r0[0], r1[0], r0[1], r1[1]}; OUT = *reinterpret_cast<bf16x8*>(&w); } while (0)
  PK4(p0, 0, pa0); PK4(p0, 8, pa1); PK4(p1, 0, pa2); PK4(p1, 8, pa3);
#undef PK4
}
__device__ __forceinline__ void qkt(f32x16& p0, f32x16& p1, unsigned kn, unsigned kr, unsigned qrp, const bf16x8 (&qr)[12], int r32, int hi) {
  p0 = f32x16{}; p1 = f32x16{};
  unsigned hb = (unsigned)hi * 16u; asm volatile("" : "+v"(hb));
  const unsigned swn = ((unsigned)r32 & 7u) << 4, swr = (((unsigned)r32 >> 1) & 7u) << 4, an = kn + (unsigned)r32 * 256u, ar = kr + (unsigned)r32 * 128u;
#pragma unroll
  for (int d0 = 0; d0 < 8; ++d0) { const unsigned ad = an + (((unsigned)d0 * 32u + hb) ^ swn);
    const bf16x8 b0 = *(const LAS bf16x8*)(uintptr_t)ad;
    const bf16x8 b1 = *(const LAS bf16x8*)(uintptr_t)(ad + 8192u);
    p0 = __builtin_amdgcn_mfma_f32_32x32x16_bf16(b0, qr[d0], p0, 0, 0, 0);
    p1 = __builtin_amdgcn_mfma_f32_32x32x16_bf16(b1, qr[d0], p1, 0, 0, 0); }
#pragma unroll
  for (int d0 = 0; d0 < 4; ++d0) { const unsigned ad = ar + (((unsigned)d0 * 32u + hb) ^ swr);
    const bf16x8 b0 = *(const LAS bf16x8*)(uintptr_t)ad;
    const bf16x8 b1 = *(const LAS bf16x8*)(uintptr_t)(ad + 4096u);
    p0 = __builtin_amdgcn_mfma_f32_32x32x16_bf16(b0, qr[8 + d0], p0, 0, 0, 0);
    p1 = __builtin_amdgcn_mfma_f32_32x32x16_bf16(b1, qr[8 + d0], p1, 0, 0, 0); }
  (void)qrp;
}
__device__ __forceinline__ int v_st(int k, int c) { const int kk = (k & ~0xC) | ((k & 4) << 1) | ((k & 8) >> 1); return ((kk >> 3) * 4 + (c >> 5)) * 512 + ((kk & 7) * 32 + (c & 31)) * 2; }
__device__ __forceinline__ int v_rd_base(int lane) { return ((lane & 3) << 3) | (((lane >> 2) & 3) << 6) | (((lane >> 4) & 1) << 5) | (((lane >> 5) & 1) << 8); }
constexpr int v_rd_off(int d0, int ks, int half) { return d0 * 512 + ks * 4096 + half * 2048; }
template <int OFF> __device__ __forceinline__ s16x4 tr_read(int vb) {
  s16x4 r; asm volatile("ds_read_b64_tr_b16 %0, %1 offset:%2" : "=&v"(r) : "v"(vb), "i"(OFF) : "memory"); return r;
}
template <int D0> __device__ __forceinline__ void pv_one(f32x16& od, int vb, bf16x8 pa0, bf16x8 pa1, bf16x8 pa2, bf16x8 pa3) {
  const s16x4 l0 = tr_read<v_rd_off(D0, 0, 0)>(vb), h0 = tr_read<v_rd_off(D0, 0, 1)>(vb), l1 = tr_read<v_rd_off(D0, 1, 0)>(vb), h1 = tr_read<v_rd_off(D0, 1, 1)>(vb);
  const s16x4 l2 = tr_read<v_rd_off(D0, 2, 0)>(vb), h2 = tr_read<v_rd_off(D0, 2, 1)>(vb), l3 = tr_read<v_rd_off(D0, 3, 0)>(vb), h3 = tr_read<v_rd_off(D0, 3, 1)>(vb);
  asm volatile("s_waitcnt lgkmcnt(0)" ::: "memory"); SBAR();
#define PK(L, H) (bf16x8){L[0], L[1], L[2], L[3], H[0], H[1], H[2], H[3]}
  od = __builtin_amdgcn_mfma_f32_32x32x16_bf16(pa0, PK(l0, h0), od, 0, 0, 0);
  od = __builtin_amdgcn_mfma_f32_32x32x16_bf16(pa1, PK(l1, h1), od, 0, 0, 0);
  od = __builtin_amdgcn_mfma_f32_32x32x16_bf16(pa2, PK(l2, h2), od, 0, 0, 0);
  od = __builtin_amdgcn_mfma_f32_32x32x16_bf16(pa3, PK(l3, h3), od, 0, 0, 0);
#undef PK
}
__device__ __forceinline__ void pv_d0(f32x16* o, int vb, bf16x8 pa0, bf16x8 pa1, bf16x8 pa2, bf16x8 pa3) {
  pv_one<0>(o[0], vb, pa0, pa1, pa2, pa3); pv_one<1>(o[1], vb, pa0, pa1, pa2, pa3); pv_one<2>(o[2], vb, pa0, pa1, pa2, pa3); pv_one<3>(o[3], vb, pa0, pa1, pa2, pa3);
}
constexpr int BUFB = 40960, OFF_RV = 0, OFF_RKN = 16384, OFF_RKR = 32768, OFF_RWS = 3 * BUFB, OFF_QR = OFF_RWS + 2048  ;
__device__ __forceinline__ void attn_unit(const bf16_t* __restrict__ Qb, const bf16_t* __restrict__ Kh, const bf16_t* __restrict__ Vh, bf16_t* Zp, int seq, LAS unsigned char* lds, int tid_in) {
  int tid = tid_in; asm volatile("" : "+v"(tid));
  const int wid = __builtin_amdgcn_readfirstlane(tid >> 6), lane = tid & 63, r32 = lane & 31, hi = lane >> 5;
  LAS float* wsl = (LAS float*)(lds + OFF_RWS) + wid * 64; LAS float* li_l = wsl; LAS float* al_l = wsl + 32;
  float m_reg = -1e30f, l_reg = 0; f32x16 o[4] = {}; bf16x8 qr[12];
  const bf16_t* Qw = Qb + (size_t)(wid * 32 + r32) * 192 + hi * 8;
#pragma unroll
  for (int d0 = 0; d0 < 12; ++d0) qr[d0] = *(const GAS bf16x8*)(Qw + d0 * 16);
  const unsigned ldsb = (unsigned)(uintptr_t)lds, qrp = ldsb + (unsigned)(OFF_QR + wid * 4096);
  unsigned sov[2], sok[2], sor;
#pragma unroll
  for (int i = 0; i < 2; ++i) {
    { const int c = 2 * wid + i, sub = 2 * c + (lane >> 5), kk = (sub >> 2) * 8 + ((lane & 31) >> 2), k = (kk & ~0xC) | ((kk & 4) << 1) | ((kk & 8) >> 1), col = (sub & 3) * 32 + (lane & 3) * 8;
      sov[i] = (unsigned)(k * 128 + col) * 2u; }
    { const int c = 2 * wid + i, row = 4 * c + (lane >> 4), u = (lane & 15) ^ (row & 7); sok[i] = (unsigned)(row * 384 + u * 16); }
  }
  { const int row = 8 * wid + (lane >> 3), u = (lane & 7) ^ ((row >> 1) & 7); sor = (unsigned)(row * 384 + 256 + u * 16); }
#define DMA(j) do { const int b_ = (j) % 3; const char* vt_ = (const char*)Vh + (size_t)(j) * (64 * 128 * 2); const char* kt_ = (const char*)Kh + (size_t)(j) * (64 * 192 * 2); \
    __builtin_amdgcn_global_load_lds((const unsigned*)(vt_ + sov[0]), (LAS unsigned*)(lds + b_ * BUFB + OFF_RV + (2 * wid) * 1024), 16, 0, 0); \
    __builtin_amdgcn_global_load_lds((const unsigned*)(vt_ + sov[1]), (LAS unsigned*)(lds + b_ * BUFB + OFF_RV + (2 * wid + 1) * 1024), 16, 0, 0); \
    __builtin_amdgcn_global_load_lds((const unsigned*)(kt_ + sok[0]), (LAS unsigned*)(lds + b_ * BUFB + OFF_RKN + (2 * wid) * 1024), 16, 0, 0); \
    __builtin_amdgcn_global_load_lds((const unsigned*)(kt_ + sok[1]), (LAS unsigned*)(lds + b_ * BUFB + OFF_RKN + (2 * wid + 1) * 1024), 16, 0, 0); \
    __builtin_amdgcn_global_load_lds((const unsigned*)(kt_ + sor), (LAS unsigned*)(lds + b_ * BUFB + OFF_RKR + wid * 1024), 16, 0, 0); } while (0)
#define VMW(n) asm volatile("s_waitcnt vmcnt(" #n ")" ::: "memory")
#define BAR() do { asm volatile("" ::: "memory"); __builtin_amdgcn_s_barrier(); asm volatile("" ::: "memory"); } while (0)
#define RESC(a) do { if (__any((a) < 1.f)) { if (hi == 0) al_l[r32] = (a); asm volatile("s_waitcnt lgkmcnt(0)" ::: "memory"); \
    _Pragma("unroll") for (int d = 0; d < 4; ++d) _Pragma("unroll") for (int r = 0; r < 16; ++r) o[d][r] *= al_l[crow(r, hi)]; } } while (0)
#define KN(j) (ldsb + (unsigned)(((j) % 3) * BUFB + OFF_RKN))
#define KRP(j) (ldsb + (unsigned)(((j) % 3) * BUFB + OFF_RKR))
#define VB(j) (vb0 + ((j) % 3) * BUFB)
  const int vb0 = (int)ldsb + OFF_RV + v_rd_base(lane);
  f32x16 pA0, pA1, pB0, pB1; float mnA, mnB, alA, alB; bf16x8 pa0, pa1, pa2, pa3; const int NT = seq / 64;
  DMA(0); DMA(1);
  VMW(5); BAR();
  qkt(pA0, pA1, KN(0), KRP(0), qrp, qr, r32, hi); partialSM(pA0, pA1, m_reg, mnA, alA);
  VMW(0); BAR();
  DMA(2);
  if (wid < 4) {
    for (int j = 1; j + 1 < NT; j += 2) {
      SBAR(); qkt(pB0, pB1, KN(j), KRP(j), qrp, qr, r32, hi);
      finishSM(pA0, pA1, alA, l_reg, pa0, pa1, pa2, pa3); SBAR();
      pv_d0(o, VB(j - 1), pa0, pa1, pa2, pa3); partialSM(pB0, pB1, m_reg, mnB, alB);
      VMW(0); BAR();
      DMA(j + 2);
      RESC(alB);
      SBAR(); qkt(pA0, pA1, KN(j + 1), KRP(j + 1), qrp, qr, r32, hi);
      finishSM(pB0, pB1, alB, l_reg, pa0, pa1, pa2, pa3); SBAR();
      pv_d0(o, VB(j), pa0, pa1, pa2, pa3); partialSM(pA0, pA1, m_reg, mnA, alA);
      VMW(0); BAR();
      if (j + 3 < NT) DMA(j + 3);
      RESC(alA);
    }
  } else {
    for (int j = 1; j + 1 < NT; j += 2) {
      SBAR(); finishSM(pA0, pA1, alA, l_reg, pa0, pa1, pa2, pa3); SBAR();
      pv_d0(o, VB(j - 1), pa0, pa1, pa2, pa3); SBAR();
      qkt(pB0, pB1, KN(j), KRP(j), qrp, qr, r32, hi); partialSM(pB0, pB1, m_reg, mnB, alB);
      VMW(0); BAR();
      DMA(j + 2);
      RESC(alB);
      SBAR(); finishSM(pB0, pB1, alB, l_reg, pa0, pa1, pa2, pa3); SBAR();
      pv_d0(o, VB(j), pa0, pa1, pa2, pa3); SBAR();
      qkt(pA0, pA1, KN(j + 1), KRP(j + 1), qrp, qr, r32, hi); partialSM(pA0, pA1, m_reg, mnA, alA);
      VMW(0); BAR();
      if (j + 3 < NT) DMA(j + 3);
      RESC(alA);
    }
  }
  SBAR(); qkt(pB0, pB1, KN(NT - 1), KRP(NT - 1), qrp, qr, r32, hi);
  finishSM(pA0, pA1, alA, l_reg, pa0, pa1, pa2, pa3); SBAR();
  pv_d0(o, VB(NT - 2), pa0, pa1, pa2, pa3); partialSM(pB0, pB1, m_reg, mnB, alB);
  RESC(alB);
  int r32e = r32, hie = hi; asm volatile("" : "+v"(r32e), "+v"(hie));
  GAS bf16_t* Zw = (GAS bf16_t*)Zp + (size_t)(wid * 32 + 4 * hie) * OD_LD + r32e;
  bf16_t zv[16][4];
#pragma unroll
  for (int r = 0; r < 16; ++r) { const int orow = (r & 3) + 8 * (r >> 2);
#pragma unroll
    for (int d0 = 0; d0 < 4; ++d0) zv[r][d0] = Zw[(size_t)orow * OD_LD + d0 * 32]; }
  SBAR();
  finishSM(pB0, pB1, alB, l_reg, pa0, pa1, pa2, pa3); SBAR();
  pv_d0(o, VB(NT - 1), pa0, pa1, pa2, pa3);
  if (hi == 0) li_l[r32] = l_reg; asm volatile("s_waitcnt lgkmcnt(0)" ::: "memory");
  float rli[16];
#pragma unroll
  for (int r = 0; r < 16; ++r) rli[r] = __builtin_amdgcn_rcpf(li_l[crow(r, hi)]);
#pragma unroll
  for (int r = 0; r < 16; ++r) { const int orow = (r & 3) + 8 * (r >> 2);
#pragma unroll
    for (int d0 = 0; d0 < 4; ++d0) Zw[(size_t)orow * OD_LD + d0 * 32] = f2bf(o[d0][r] * rli[r] * bf1(zv[r][d0])); }
  VMW(0); BAR();
#undef DMA
#undef VMW
#undef BAR
#undef RESC
#undef KN
#undef KRP
#undef VB
}
}

namespace msc {
using att::f32x16; using att::s16x4; using att::crow; using att::v_st; using att::v_rd_base; using att::v_rd_off; using att::tr_read;
constexpr int CL = 32, NCH = SB / CL;
constexpr int BUF = 40960, O_Q = 0, O_K = 16384, O_V = 32768, O_KW = 81920, O_X = 98304, O_A = 114688, O_G = O_A + 9216, O_M = O_G + 9216, O_MP = O_M + 9216, O_N = 142848, O_QN = 144896, O_PW = 145408, O_PST = 148480, O_RS = 156672;
#define PK4(P, BASE, OUT) do { unsigned a0 = cvt_pk_bf16(P[BASE + 0], P[BASE + 1]), a1 = cvt_pk_bf16(P[BASE + 2], P[BASE + 3]);   \
    unsigned b0 = cvt_pk_bf16(P[BASE + 4], P[BASE + 5]), b1 = cvt_pk_bf16(P[BASE + 6], P[BASE + 7]);                              \
    auto r0 = __builtin_amdgcn_permlane32_swap(a0, b0, false, false); auto r1 = __builtin_amdgcn_permlane32_swap(a1, b1, false, false); \
    u32x4 w = {r0[0], r1[0], r0[1], r1[1]}; OUT = *reinterpret_cast<bf16x8*>(&w); } while (0)
#define PKLH(L, H) (bf16x8){L[0], L[1], L[2], L[3], H[0], H[1], H[2], H[3]}
__device__ __forceinline__ void scan_item(const bf16_t* evb  , const float* gb  , bf16_t* hfb  ,
                                          int head, int dh, LAS unsigned char* lds, int wave0) {
  int tid; asm volatile("v_mbcnt_lo_u32_b32 %0, -1, 0\n\tv_mbcnt_hi_u32_b32 %0, -1, %0" : "=v"(tid)); tid += wave0 * 64;
  const int tid_o = tid; const int wid = wave0, lane = tid & 63, r32 = lane & 31, hi = lane >> 5, kh = wid >> 2, dq = wid & 3; (void)r32; (void)hi;
  const unsigned ldsb = (unsigned)(uintptr_t)lds;
  LAS float* aS = (LAS float*)(lds + O_A); LAS float* gT = (LAS float*)(lds + O_G); LAS float* mT = (LAS float*)(lds + O_M); LAS float* mP = (LAS float*)(lds + O_MP);
  LAS float* nbuf = (LAS float*)(lds + O_N); LAS float* qnS = (LAS float*)(lds + O_QN); LAS float* pw = (LAS float*)(lds + O_PW) + wid * 96;
  LAS float* xch = (LAS float*)(lds + O_X) + dq * 1024; LAS float* rsS = (LAS float*)(lds + O_RS);
#define BARX() do { asm volatile("" ::: "memory"); __builtin_amdgcn_s_barrier(); asm volatile("" ::: "memory"); } while (0)
#define LGK0() do { asm volatile("s_waitcnt lgkmcnt(0)" ::: "memory"); __builtin_amdgcn_sched_barrier(0); } while (0)
  for (int dir = 0; dir < 2; ++dir) {
    asm volatile("s_waitcnt vmcnt(0) lgkmcnt(0)" ::: "memory"); BARX();
    {
      LAS float* rawI = (LAS float*)lds; LAS float* rawF = rawI + SB; LAS float* Bc = rawF + SB; LAS float* CMc = Bc + 128;
      {
        float ipv[5], fpv[5];
#pragma unroll
        for (int i = 0; i < 5; ++i) { const int jx = tid + 512 * i; ipv[i] = 0.f; fpv[i] = 0.f;
          if (jx < SB) { const int srow = dir == 0 ? jx : (jx < CTXL ? CTXL - 1 - jx : SB - 1 - (jx - CTXL)); const GAS float* gr = (const GAS float*)gb + (size_t)srow * 16 + dir * 8; ipv[i] = gr[head]; fpv[i] = gr[4 + head]; } }
#pragma unroll
        for (int i = 0; i < 5; ++i) { const int jx = tid + 512 * i; if (jx < SB) { rawI[jx] = ipv[i]; rawF[jx] = fminf(fpv[i], 0.f) - __logf(1.0f + __expf(-fabsf(fpv[i]))); } }
      }
      if (tid < 256) { nbuf[tid] = 0.f; nbuf[256 + tid] = 0.f; }
      LGK0(); BARX();
      for (int c = wid; c < NCH; c += 8) {
        const int l5 = lane & 31; const float ip = rawI[c * CL + l5]; float bsum = rawF[c * CL + l5];
#pragma unroll
        for (int o = 1; o < 32; o <<= 1) { const float t = __shfl_up(bsum, o, 32); if (l5 >= o) bsum += t; }
        const float a = ip - bsum; float cm = a;
#pragma unroll
        for (int o = 1; o < 32; o <<= 1) { const float t = __shfl_up(cm, o, 32); if (l5 >= o) cm = fmaxf(cm, t); }
        if (lane < 32) { aS[c * CL + l5] = a; gT[c * CL + l5] = cm; mT[c * CL + l5] = bsum; }
        if (lane == 31) { Bc[c] = bsum; CMc[c] = cm; }
      }
      LGK0(); BARX();
      if (tid == 0) { float mp = -1e30f; for (int c = 0; c < NCH; ++c) { mP[c] = mp; mp = Bc[c] + fmaxf(mp, CMc[c]); } }
      LGK0(); BARX();
      for (int jx = tid; jx < SB; jx += 512) { const float g = fmaxf(mP[jx >> 5], gT[jx]); gT[jx] = g; mT[jx] = mT[jx] + g; }
      LGK0(); BARX();
    }
    unsigned soq[2], sov;
#pragma unroll
    for (int i = 0; i < 2; ++i) { const int c2 = 2 * wid + i, t = 2 * c2 + (lane >> 5), u = (lane & 31) ^ (t & 15), ro = dir ? 31 - t : t; soq[i] = (unsigned)(ro * EV_LD * 2 + u * 16); }
    { const int sub = 2 * wid + (lane >> 5), kk = (sub >> 2) * 8 + ((lane & 31) >> 2), s_ = (kk & ~0xC) | ((kk & 4) << 1) | ((kk & 8) >> 1), col = (sub & 3) * 32 + (lane & 3) * 8, ro = dir ? 31 - s_ : s_;
      sov = (unsigned)(ro * EV_LD * 2 + col * 2); }
#define SLO(c) (dir == 0 ? (c) * CL : ((c) * CL < CTXL ? CTXL - CL - (c) * CL : SB - CL - ((c) * CL - CTXL)))
#define DMA(c) do { const int b_ = (c) & 1; const char* rb_ = (const char*)(evb + (size_t)SLO(c) * EV_LD); \
    const char* qb_ = rb_ + (3072 + head * 256) * 2; const char* kb_ = rb_ + (4096 + head * 256) * 2; const char* vb_ = rb_ + (5120 + head * 256 + dh * 128) * 2; \
    __builtin_amdgcn_global_load_lds((const unsigned*)(qb_ + soq[0]), (LAS unsigned*)(lds + b_ * BUF + O_Q + (2 * wid) * 1024), 16, 0, 0); \
    __builtin_amdgcn_global_load_lds((const unsigned*)(qb_ + soq[1]), (LAS unsigned*)(lds + b_ * BUF + O_Q + (2 * wid + 1) * 1024), 16, 0, 0); \
    __builtin_amdgcn_global_load_lds((const unsigned*)(kb_ + soq[0]), (LAS unsigned*)(lds + b_ * BUF + O_K + (2 * wid) * 1024), 16, 0, 0); \
    __builtin_amdgcn_global_load_lds((const unsigned*)(kb_ + soq[1]), (LAS unsigned*)(lds + b_ * BUF + O_K + (2 * wid + 1) * 1024), 16, 0, 0); \
    __builtin_amdgcn_global_load_lds((const unsigned*)(vb_ + sov), (LAS unsigned*)(lds + b_ * BUF + O_V + wid * 1024), 16, 0, 0); } while (0)
    f32x16 C[4] = {};
    float nv[4] = {0.f, 0.f, 0.f, 0.f};
    const bf16x8 ones8 = {0x3F80, 0x3F80, 0x3F80, 0x3F80, 0x3F80, 0x3F80, 0x3F80, 0x3F80};
    DMA(0); DMA(1);
    asm volatile("s_waitcnt vmcnt(5)" ::: "memory"); BARX();
    for (int c = 0; c < NCH; ++c) {
      int tid = tid_o; asm volatile("" : "+v"(tid));
      const int lane = tid & 63, r32 = lane & 31, hi = lane >> 5, dcol = head * 256 + dh * 128 + dq * 32 + r32;
      const unsigned tb = ldsb + (unsigned)((c & 1) * BUF);
      const float mprev = mP[c], glast = gT[c * CL + CL - 1];
      const float decay = __expf(mprev - glast);
      const unsigned rb = (unsigned)r32 * 512u, sw = ((unsigned)r32 & 15u) << 4; unsigned hb = (unsigned)hi * 16u; asm volatile("" : "+v"(hb));
      const int slo = SLO(c);
      unsigned pf_h[16], pf_o[16];
      if (dir == 1 && kh == 0) {
        const char* hb_ = (const char*)(hfb + (size_t)slo * DM); const char* ob_ = (const char*)(evb + (size_t)slo * EV_LD + 1024);
        const unsigned ho = (unsigned)((31 - 4 * hi) * DM + dcol) * 2u, oo = (unsigned)((31 - 4 * hi) * EV_LD + dcol) * 2u;
#pragma unroll
        for (int r = 0; r < 16; ++r) { const int tc = (r & 3) + 8 * (r >> 2);
          pf_h[r] = *(const GAS bf16_t*)(hb_ + (ho - (unsigned)(tc * DM * 2))); pf_o[r] = *(const GAS bf16_t*)(ob_ + (oo - (unsigned)(tc * EV_LD * 2))); }
      }
      if (kh == 1) {
        f32x16 pe = {}, po = {};
#pragma unroll
        for (int kk = 0; kk < 16; kk += 2) { const unsigned ad0 = tb + rb + (((unsigned)kk * 32u + hb) ^ sw), ad1 = tb + rb + (((unsigned)(kk + 1) * 32u + hb) ^ sw);
          const bf16x8 kf0 = *(const LAS bf16x8*)(uintptr_t)(ad0 + O_K), qf0 = *(const LAS bf16x8*)(uintptr_t)(ad0 + O_Q);
          const bf16x8 kf1 = *(const LAS bf16x8*)(uintptr_t)(ad1 + O_K), qf1 = *(const LAS bf16x8*)(uintptr_t)(ad1 + O_Q);
          pe = __builtin_amdgcn_mfma_f32_32x32x16_bf16(kf0, qf0, pe, 0, 0, 0);
          po = __builtin_amdgcn_mfma_f32_32x32x16_bf16(kf1, qf1, po, 0, 0, 0); }
        f32x16 p = pe + po;
        const float gt = gT[c * CL + r32]; float rowsum = 0.f;
#pragma unroll
        for (int r4 = 0; r4 < 4; ++r4) { const f32x4 a4 = *(const LAS f32x4*)(aS + c * CL + 8 * r4 + 4 * hi);
#pragma unroll
          for (int e = 0; e < 4; ++e) { const int sidx = 8 * r4 + 4 * hi + e; const float w = (sidx <= r32) ? __expf(a4[e] - gt) : 0.f; p[4 * r4 + e] *= w; rowsum += p[4 * r4 + e]; } }
        { auto rr = __builtin_amdgcn_permlane32_swap(__float_as_uint(rowsum), __float_as_uint(rowsum), false, false); rowsum = __uint_as_float(rr[0]) + __uint_as_float(rr[1]); }
        bf16x8 pa0, pa1; PK4(p, 0, pa0); PK4(p, 8, pa1);
        *(LAS bf16x8*)(lds + O_PST + (dq * 2 + 0) * 1024 + lane * 16) = pa0; *(LAS bf16x8*)(lds + O_PST + (dq * 2 + 1) * 1024 + lane * 16) = pa1;
        if (hi == 0) rsS[dq * 32 + r32] = rowsum;
      } else {
        { const int s_ = tid >> 3, cb = (tid & 7) * 8; const float wt = __expf(aS[c * CL + s_] - glast);
#pragma unroll
          for (int h4 = 0; h4 < 4; ++h4) { const int c8 = cb + 64 * h4; f32x4 x0, x1;
            unpack8(*(const LAS u32x4*)(uintptr_t)(tb + O_K + (unsigned)s_ * 512u + ((unsigned)(c8 * 2) ^ (((unsigned)s_ & 15u) << 4))), x0, x1);
            *(LAS u32x4*)(lds + O_KW + (c8 >> 7) * 8192 + v_st(s_, c8 & 127)) = pack8(x0 * wt, x1 * wt); } }
        { const int t_ = tid >> 3, part = tid & 7; const LAS float* nb = nbuf + (c & 1) * 256 + part * 32; float acc = 0.f;
#pragma unroll
          for (int e = 0; e < 4; ++e) { f32x4 x0, x1; unpack8(*(const LAS u32x4*)(uintptr_t)(tb + O_Q + (unsigned)t_ * 512u + ((unsigned)(part * 64 + e * 16) ^ (((unsigned)t_ & 15u) << 4))), x0, x1);
            const f32x4 n0 = *(const LAS f32x4*)(nb + e * 8), n1 = *(const LAS f32x4*)(nb + e * 8 + 4);
            acc += x0[0] * n0[0] + x0[1] * n0[1] + x0[2] * n0[2] + x0[3] * n0[3] + x1[0] * n1[0] + x1[1] * n1[1] + x1[2] * n1[2] + x1[3] * n1[3]; }
          acc += __shfl_xor(acc, 1); acc += __shfl_xor(acc, 2); acc += __shfl_xor(acc, 4);
          if (part == 0) qnS[t_] = acc; }
      }
      LGK0(); BARX();
      f32x16 aq0 = {}, aq1 = {};
#pragma unroll
      for (int j = 0; j < 8; ++j) { const unsigned ad = tb + O_Q + rb + (((unsigned)(8 * kh + j) * 32u + hb) ^ sw);
        const bf16x8 qf = *(const LAS bf16x8*)(uintptr_t)ad; bf16x8 cf;
        if ((j & 1) == 0) { PK4(C[j >> 1], 0, cf); aq0 = __builtin_amdgcn_mfma_f32_32x32x16_bf16(qf, cf, aq0, 0, 0, 0); }
        else { PK4(C[j >> 1], 8, cf); aq1 = __builtin_amdgcn_mfma_f32_32x32x16_bf16(qf, cf, aq1, 0, 0, 0); } }
      f32x16 aqc = aq0 + aq1;
      const int vbase = (int)(tb + O_V) + v_rd_base(lane) + dq * 512;
      const int kwb = (int)(ldsb + O_KW + kh * 8192) + v_rd_base(lane);
      const s16x4 vl0 = tr_read<v_rd_off(0, 0, 0)>(vbase), vh0 = tr_read<v_rd_off(0, 0, 1)>(vbase), vl1 = tr_read<v_rd_off(0, 1, 0)>(vbase), vh1 = tr_read<v_rd_off(0, 1, 1)>(vbase);
      const s16x4 a0l0 = tr_read<v_rd_off(0, 0, 0)>(kwb), a0h0 = tr_read<v_rd_off(0, 0, 1)>(kwb), a0l1 = tr_read<v_rd_off(0, 1, 0)>(kwb), a0h1 = tr_read<v_rd_off(0, 1, 1)>(kwb);
      const s16x4 a1l0 = tr_read<v_rd_off(1, 0, 0)>(kwb), a1h0 = tr_read<v_rd_off(1, 0, 1)>(kwb), a1l1 = tr_read<v_rd_off(1, 1, 0)>(kwb), a1h1 = tr_read<v_rd_off(1, 1, 1)>(kwb);
      const s16x4 a2l0 = tr_read<v_rd_off(2, 0, 0)>(kwb), a2h0 = tr_read<v_rd_off(2, 0, 1)>(kwb), a2l1 = tr_read<v_rd_off(2, 1, 0)>(kwb), a2h1 = tr_read<v_rd_off(2, 1, 1)>(kwb);
      const s16x4 a3l0 = tr_read<v_rd_off(3, 0, 0)>(kwb), a3h0 = tr_read<v_rd_off(3, 0, 1)>(kwb), a3l1 = tr_read<v_rd_off(3, 1, 0)>(kwb), a3h1 = tr_read<v_rd_off(3, 1, 1)>(kwb);
      bf16x8 pa0 = {}, pa1 = {};
      if (kh == 0) { pa0 = *(const LAS bf16x8*)(lds + O_PST + (dq * 2 + 0) * 1024 + lane * 16); pa1 = *(const LAS bf16x8*)(lds + O_PST + (dq * 2 + 1) * 1024 + lane * 16); }
      LGK0();
      const bf16x8 vf0 = PKLH(vl0, vh0), vf1 = PKLH(vl1, vh1);
      const bf16x8 kwf[4][2] = {{PKLH(a0l0, a0h0), PKLH(a0l1, a0h1)}, {PKLH(a1l0, a1h0), PKLH(a1l1, a1h1)}, {PKLH(a2l0, a2h0), PKLH(a2l1, a2h1)}, {PKLH(a3l0, a3h0), PKLH(a3l1, a3h1)}};
      f32x16 asv = {};
      if (kh == 0) {
        asv = __builtin_amdgcn_mfma_f32_32x32x16_bf16(pa0, vf0, asv, 0, 0, 0);
        asv = __builtin_amdgcn_mfma_f32_32x32x16_bf16(pa1, vf1, asv, 0, 0, 0);
        const float ai = __expf(mprev - gT[c * CL + r32]);
        pw[r32] = rsS[dq * 32 + r32] + ai * qnS[r32]; pw[32 + r32] = ai; pw[64 + r32] = __expf(-mT[c * CL + r32]);
      } else {
#pragma unroll
        for (int r = 0; r < 16; ++r) xch[r * 64 + lane] = aqc[r];
      }
#pragma unroll
      for (int i = 0; i < 4; ++i) {
#pragma unroll
        for (int r = 0; r < 16; ++r) C[i][r] *= decay;
        C[i] = __builtin_amdgcn_mfma_f32_32x32x16_bf16(kwf[i][0], vf0, C[i], 0, 0, 0);
        C[i] = __builtin_amdgcn_mfma_f32_32x32x16_bf16(kwf[i][1], vf1, C[i], 0, 0, 0);
        if (dq == 0) {
          f32x16 na = {}; na = __builtin_amdgcn_mfma_f32_32x32x16_bf16(ones8, kwf[i][0], na, 0, 0, 0); na = __builtin_amdgcn_mfma_f32_32x32x16_bf16(ones8, kwf[i][1], na, 0, 0, 0);
          nv[i] = decay * nv[i] + na[0];
          if (hi == 0) nbuf[((c + 1) & 1) * 256 + kh * 128 + i * 32 + r32] = nv[i]; }
      }
      asm volatile("s_waitcnt vmcnt(0) lgkmcnt(0)" ::: "memory"); BARX();
      if (dir == 1 && kh == 0) {
#pragma unroll
        for (int r = 0; r < 16; ++r) asm volatile("" : "+v"(pf_h[r]), "+v"(pf_o[r]));
      }
      if (c + 2 < NCH) DMA(c + 2);
      if (kh == 0) {
        float hvs[16];
#pragma unroll
        for (int r4 = 0; r4 < 4; ++r4) {
          const f32x4 dn = *(const LAS f32x4*)(pw + 8 * r4 + 4 * hi), ai4 = *(const LAS f32x4*)(pw + 32 + 8 * r4 + 4 * hi), em4 = *(const LAS f32x4*)(pw + 64 + 8 * r4 + 4 * hi);
#pragma unroll
          for (int e = 0; e < 4; ++e) { const int r = 4 * r4 + e;
            hvs[r] = (asv[r] + ai4[e] * (aqc[r] + xch[r * 64 + lane])) * __builtin_amdgcn_rcpf(fmaxf(fabsf(dn[e]), em4[e])); }
        }
        if (dir == 0) {
          char* hb_ = (char*)(hfb + (size_t)slo * DM); const unsigned ho = (unsigned)((4 * hi) * DM + dcol) * 2u;
#pragma unroll
          for (int r = 0; r < 16; ++r) { const int tc = (r & 3) + 8 * (r >> 2); *(GAS bf16_t*)(hb_ + (ho + (unsigned)(tc * DM * 2))) = f2bf(hvs[r]); }
        } else {
          char* ob_ = (char*)((bf16_t*)evb + (size_t)slo * EV_LD + 1024); const unsigned oo = (unsigned)((31 - 4 * hi) * EV_LD + dcol) * 2u;
#pragma unroll
          for (int r = 0; r < 16; ++r) { const int tc = (r & 3) + 8 * (r >> 2); *(GAS bf16_t*)(ob_ + (oo - (unsigned)(tc * EV_LD * 2))) = f2bf(bflo(pf_o[r]) * (bflo(pf_h[r]) + hvs[r])); }
        }
      }
    }
#undef DMA
#undef SLO
  }
  asm volatile("s_waitcnt vmcnt(0) lgkmcnt(0)" ::: "memory"); BARX();
#undef BARX
#undef LGK0
}
#undef PK4
#undef PKLH
}

struct Params { const float* in[18]; float* out; unsigned char* ws; };
constexpr int LDS_BYTES = 163840, LDS_CTL = 162816, MISC_OFF = LDS_CTL + 320;

template <int MID> __device__ __forceinline__ int wmap(int n) {
    if (MID == 0) {
        const int pn = n >> 8, lc = n & 255, bj = lc >> 7, c = lc & 127;
        if (pn < 8)  return (bj ? 3072 : 0) + 128 * pn + c;
        if (pn < 16) return (bj ? 8192 : 7168) + 128 * (pn - 8) + c;
        if (pn < 24) return (bj ? 2048 : 1024) + 128 * (pn - 16) + c;
        if (pn < 36) return 4096 + 256 * (pn - 24) + lc;
        return lc < 16 ? 9216 + lc : -1;
    } else if (MID == 2) {
        if (n < 2048) return 704 + n;
        return (n - 2048 < 704) ? n - 2048 : -1;
    } else if (MID == 3) {
        const int pn = n >> 8, lc = n & 255;
        if (pn < 8) return (n >> 7) * 192 + (n & 127);
        const int bj = lc >> 7, hh = (lc & 127) >> 5, i = lc & 31;
        return (4 * (pn - 8) + hh) * 192 + 128 + 32 * bj + i;
    }
    return n;
}
template <int MID> __device__ __forceinline__ void wconv_item(const float* W, int K, int NS, bf16_t* WT, int nblk, const float* kscale, LAS float* scr, int item, int lane) {
    const int kb = item / nblk, nb = item % nblk, k0 = 64 * kb, n0 = 32 * nb;
    const int src = wmap<MID>(n0 + (lane & 31));
    const float cs = (MID == 0 && src >= 5120 && src < 6144) ? 0.0625f : 1.0f;
    float wv[32];
#pragma unroll
    for (int i = 0; i < 32; ++i) { const int kk = 2 * i + (lane >> 5); wv[i] = (src >= 0) ? ((const GAS float*)W)[(size_t)(k0 + kk) * NS + src] : 0.f; }
#pragma unroll
    for (int i = 0; i < 32; ++i) { const int kk = 2 * i + (lane >> 5); float v = wv[i] * cs; if (kscale) v *= ((const GAS float*)kscale)[k0 + kk];
        scr[kk * 33 + (lane & 31)] = v; }
    LDS_WAIT(); asm volatile("" ::: "memory");
    const int c = lane & 7;
#pragma unroll
    for (int j = 0; j < 4; ++j) { const int n = (lane >> 3) + 8 * j; const LAS float* s = scr + (8 * c) * 33 + n;
        u32x4 o; o.x = cvt_pk_bf16(s[0 * 33], s[1 * 33]); o.y = cvt_pk_bf16(s[2 * 33], s[3 * 33]); o.z = cvt_pk_bf16(s[4 * 33], s[5 * 33]); o.w = cvt_pk_bf16(s[6 * 33], s[7 * 33]);
        *(GAS u32x4*)(WT + (size_t)(n0 + n) * K + k0 + 8 * c) = o; }
    LDS_WAIT(); asm volatile("" ::: "memory");
}

constexpr int PTR_OFF = LDS_CTL + 512;
__device__ __forceinline__ const float* inp(LAS unsigned char* lds, int i) {
    unsigned off = (unsigned)(PTR_OFF + 8 * i); asm volatile("" : "+s"(off));
    volatile LAS unsigned* t = (volatile LAS unsigned*)(lds + off);
    const unsigned lo = __builtin_amdgcn_readfirstlane(t[0]), hi = __builtin_amdgcn_readfirstlane(t[1]);
    return (const float*)(((unsigned long long)hi << 32) | lo);
}
#define PH_BEGIN int tid; asm volatile("v_mbcnt_lo_u32_b32 %0, -1, 0\n\tv_mbcnt_hi_u32_b32 %0, -1, %0" : "=v"(tid)); tid += wave0 * 64; unsigned char* ws = ws0; unsigned char* dob = dob0; asm volatile("" : "+v"(tid), "+s"(ws), "+s"(dob)); \
    const int lane = tid & 63, wave = __builtin_amdgcn_readfirstlane(tid >> 6), G = gridDim.x, bx = blockIdx.x, vcu = (G % 8 == 0) ? (bx % 8) * (G / 8) + bx / 8 : bx, gw = vcu * 8 + wave, NGW = G * 8; \
    (void)lane; (void)wave; (void)gw; (void)NGW; (void)vcu; \
    bf16_t* U = (bf16_t*)(dob + DO_U); bf16_t* H = (bf16_t*)(ws + WS_H); bf16_t* BIG = (bf16_t*)(ws + WS_BIG); float* modv = (float*)(dob + DO_MODV); \
    (void)U; (void)H; (void)BIG; (void)modv;

template <bool FINAL>
__device__ __forceinline__ void ln_phase(bf16_t* H, bf16_t* U, float* outp, const float* ln_g, const float* ln_b, const float* modn, int gw, int NGW, int lane, unsigned tmo) {
    for (int rg = gw; rg < TOK / 4; rg += NGW) {
        const int r0 = rg * 4, b = r0 / SB, s0 = r0 % SB, midx = (s0 < CTXL) ? 32 : b;
        if (FINAL && s0 < CTXL) continue;
        bf16_t* hr = H + (size_t)r0 * DM;
        f32x4 v[4][2][2]; float sm[4], sq[4];
#pragma unroll
        for (int i = 0; i < 4; ++i)
#pragma unroll
            for (int jj = 0; jj < 2; ++jj) unpack8(*(const GAS u32x4*)(hr + (size_t)i * DM + jj * 512 + lane * 8), v[i][jj][0], v[i][jj][1]);
#pragma unroll
        for (int i = 0; i < 4; ++i) { sm[i] = 0.f;
#pragma unroll
            for (int jj = 0; jj < 2; ++jj)
#pragma unroll
                for (int q = 0; q < 2; ++q) sm[i] += (v[i][jj][q][0] + v[i][jj][q][1]) + (v[i][jj][q][2] + v[i][jj][q][3]); }
#pragma unroll
        for (int o = 1; o < 64; o <<= 1)
#pragma unroll
            for (int i = 0; i < 4; ++i) sm[i] += __shfl_xor(sm[i], o);
#pragma unroll
        for (int i = 0; i < 4; ++i) { const float mean = sm[i] * (1.0f / DM); sq[i] = 0.f;
#pragma unroll
            for (int jj = 0; jj < 2; ++jj)
#pragma unroll
                for (int q = 0; q < 2; ++q) { v[i][jj][q] = v[i][jj][q] - mean; sq[i] += (v[i][jj][q][0] * v[i][jj][q][0] + v[i][jj][q][1] * v[i][jj][q][1]) + (v[i][jj][q][2] * v[i][jj][q][2] + v[i][jj][q][3] * v[i][jj][q][3]); } }
#pragma unroll
        for (int o = 1; o < 64; o <<= 1)
#pragma unroll
            for (int i = 0; i < 4; ++i) sq[i] += __shfl_xor(sq[i], o);
        const float* mv = FINAL ? nullptr : modn + (size_t)midx * 3072;
#pragma unroll
        for (int jj = 0; jj < 2; ++jj) { const int c = jj * 512 + lane * 8;
            f32x4 gg[2], bb[2], sh[2], sc[2];
#pragma unroll
            for (int q = 0; q < 2; ++q) { gg[q] = *(const GAS f32x4*)(ln_g + c + 4 * q); bb[q] = *(const GAS f32x4*)(ln_b + c + 4 * q);
                if (!FINAL) { sh[q] = *(const GAS f32x4*)(mv + c + 4 * q); sc[q] = *(const GAS f32x4*)(mv + 1024 + c + 4 * q) + 1.0f; } }
#pragma unroll
            for (int i = 0; i < 4; ++i) { const float rstd = 1.0f / sqrtf(sq[i] * (1.0f / DM) + LN_EPS);
                f32x4 y0 = v[i][jj][0] * rstd * gg[0] + bb[0], y1 = v[i][jj][1] * rstd * gg[1] + bb[1];
                if (!FINAL) { *(GAS u32x4*)(hr + (size_t)i * DM + c) = pack8(y0, y1); *(GAS u32x4*)(U + (size_t)(r0 + i) * DM + c) = pack8(y0 * sc[0] + sh[0], y1 * sc[1] + sh[1]); }
                else { float* op = outp + ((size_t)b * SEQ + (s0 + i - CTXL)) * DM + c;
                    if (tmo) { const float qn = __builtin_nanf(""); y0 = (f32x4){qn, qn, qn, qn}; y1 = y0; }
                    *(GAS f32x4*)op = y0; *(GAS f32x4*)(op + 4) = y1; } }
        }
    }
}

__global__ void __launch_bounds__(512, 2) fwd_kernel(Params p) {
    extern __shared__ __attribute__((aligned(16))) unsigned char lds_raw[];
    LAS unsigned char* lds = (LAS unsigned char*)lds_raw;
    const int tid0 = threadIdx.x;
    volatile LAS unsigned* MISC = (volatile LAS unsigned*)(lds + MISC_OFF);
    for (int u = tid0; u < (LDS_BYTES - LDS_CTL) / 4; u += 512) ((LAS unsigned*)(lds + LDS_CTL))[u] = 0u;
    __syncthreads();
    if (tid0 < 18) { const unsigned long long a = (unsigned long long)p.in[tid0]; volatile LAS unsigned* t = (volatile LAS unsigned*)(lds + PTR_OFF); t[2 * tid0] = (unsigned)a; t[2 * tid0 + 1] = (unsigned)(a >> 32); }
    __syncthreads();
    unsigned char* const ws0 = p.ws; unsigned char* const dob0 = (unsigned char*)p.out;
    const int wave0 = __builtin_amdgcn_readfirstlane(tid0 >> 6);
    (void)xcd_barrier_post((unsigned*)(ws0 + WS_CTL) + 4096, MISC + 8);
#define GRID_BAR() do { XcdBarrier b2_; b2_.bar = (unsigned*)(ws0 + WS_CTL) + 4096; asm volatile("" : "+s"(b2_.bar)); b2_.x = xb_xcc_id(); b2_.st = (volatile LAS unsigned*)(lds + MISC_OFF) + 8; xcd_barrier(b2_); } while (0)

    {
        PH_BEGIN
        LAS float* scr = (LAS float*)(lds + wave * 16384);
        for (int j = 0; j < 2; ++j) {
            unsigned char* wb = dob + DO_W + (size_t)j * W_PAIR;
            { const float* w = inp(lds, 8) + (size_t)j * 1024 * 9232; for (int it = gw; it < 16 * 296; it += NGW) wconv_item<0>(w, 1024, 9232, (bf16_t*)(wb + W_EVIN), 296, nullptr, scr, it, lane); }
            { const float* w = inp(lds, 11) + (size_t)j * 2048 * 1024; for (int it = gw; it < 32 * 32; it += NGW)  wconv_item<1>(w, 2048, 1024, (bf16_t*)(wb + W_EVOUT), 32, nullptr, scr, it, lane); }
            { const float* w = inp(lds, 12) + (size_t)j * 1024 * 2752; for (int it = gw; it < 16 * 88; it += NGW)  wconv_item<2>(w, 1024, 2752, (bf16_t*)(wb + W_ODIN), 88, nullptr, scr, it, lane); }
            { const float* w = inp(lds, 14) + (size_t)j * 384 * 3072; const float* ks = inp(lds, 13) + j * 384; for (int it = gw; it < 6 * 96; it += NGW)   wconv_item<3>(w, 384, 3072, (bf16_t*)(wb + W_UQ), 96, ks, scr, it, lane); }
            { const float* w = inp(lds, 16) + (size_t)j * 256 * 4096; const float* ks = inp(lds, 15) + j * 256; for (int it = gw; it < 4 * 128; it += NGW)  wconv_item<1>(w, 256, 4096, (bf16_t*)(wb + W_UKV), 128, ks, scr, it, lane); }
            { const float* w = inp(lds, 17) + (size_t)j * 2048 * 1024; for (int it = gw; it < 32 * 32; it += NGW)  wconv_item<1>(w, 2048, 1024, (bf16_t*)(wb + W_ODOUT), 32, nullptr, scr, it, lane); }
        }
        __syncthreads();
        {
            const float* cvec = inp(lds, 1); const float* cctx = inp(lds, 3); const float* mod_w = inp(lds, 4); const float* mod_b = inp(lds, 5);
            LAS float* Ssil = (LAS float*)lds;
            LAS float* red = (LAS float*)(lds + 33 * 128 * 4);
            const int cl = tid & 127, kq = tid >> 7;
            for (int it = bx; it < 4 * 24; it += G) {
                const int L = it / 24, n0 = (it % 24) * 128;
                float a[33];
#pragma unroll
                for (int r = 0; r < 33; ++r) a[r] = 0.f;
                for (int kc = 0; kc < 8; ++kc) {
                    __syncthreads();
                    for (int e = tid; e < 33 * 128; e += 512) { const int r = e >> 7, k = kc * 128 + (e & 127); const float v = (r < 32) ? ((const GAS float*)cvec)[r * 1024 + k] : ((const GAS float*)cctx)[k]; Ssil[e] = fsilu(v); }
                    __syncthreads();
                    float wv[32];
#pragma unroll
                    for (int k2 = 0; k2 < 32; ++k2) wv[k2] = ((const GAS float*)mod_w)[((size_t)L * 1024 + kc * 128 + kq * 32 + k2) * 3072 + n0 + cl];
#pragma unroll
                    for (int k2 = 0; k2 < 32; ++k2) { const int kl = kq * 32 + k2;
#pragma unroll
                        for (int r = 0; r < 33; ++r) a[r] += Ssil[r * 128 + kl] * wv[k2]; }
                }
                __syncthreads();
#pragma unroll
                for (int r = 0; r < 33; ++r) red[(kq * 33 + r) * 128 + cl] = a[r];
                __syncthreads();
                for (int e = tid; e < 33 * 128; e += 512) { const int r = e >> 7, c = e & 127;
                    ((GAS float*)modv)[((size_t)L * 33 + r) * 3072 + n0 + c] = red[(0 * 33 + r) * 128 + c] + red[(1 * 33 + r) * 128 + c] + red[(2 * 33 + r) * 128 + c] + red[(3 * 33 + r) * 128 + c] + ((const GAS float*)mod_b)[L * 3072 + n0 + c]; }
                __syncthreads();
            }
        }
        { float* cosT = (float*)(dob + DO_ROPE); float* sinT = cosT + 2048 * 32;
          for (int e = (vcu * 512 + tid); e < 2048 * 32; e += G * 512) {
            const int pos = e >> 5, i = e & 31; const float invf = __builtin_amdgcn_exp2f(-(float)(i & 15) * (13.287712379549449f / 16.0f));
            const float ang = (float)((i < 16) ? (pos >> 6) : (pos & 63)) * invf;
            ((GAS float*)cosT)[e] = __cosf(ang); ((GAS float*)sinT)[e] = __sinf(ang); } }
    }
    GRID_BAR();
    {
        PH_BEGIN
        const float* x = inp(lds, 0); const float* ctxin = inp(lds, 2);
        for (int rg = gw; rg < TOK / 4; rg += NGW) {
            const int r0 = rg * 4, b = r0 / SB, s = r0 % SB, midx = (s < CTXL) ? 32 : b;
            const float* src = (s < CTXL) ? ctxin + ((size_t)b * CTXL + s) * DM : x + ((size_t)b * SEQ + (s - CTXL)) * DM;
            const float* mv = modv + (size_t)midx * 3072;
            f32x4 v[4][4];
#pragma unroll
            for (int i = 0; i < 4; ++i)
#pragma unroll
                for (int jq = 0; jq < 4; ++jq) v[i][jq] = *(const GAS f32x4*)(src + (size_t)i * DM + jq * 256 + lane * 4);
#pragma unroll
            for (int jq = 0; jq < 4; ++jq) { const int c = jq * 256 + lane * 4; const f32x4 sh = *(const GAS f32x4*)(mv + c), sc = *(const GAS f32x4*)(mv + 1024 + c) + 1.0f;
#pragma unroll
                for (int i = 0; i < 4; ++i) { const f32x4 u = v[i][jq] * sc + sh;
                    u32x2 hw, uw; hw.x = cvt_pk_bf16(v[i][jq][0], v[i][jq][1]); hw.y = cvt_pk_bf16(v[i][jq][2], v[i][jq][3]); uw.x = cvt_pk_bf16(u[0], u[1]); uw.y = cvt_pk_bf16(u[2], u[3]);
                    *(GAS u32x2*)(H + (size_t)(r0 + i) * DM + c) = hw; *(GAS u32x2*)(U + (size_t)(r0 + i) * DM + c) = uw; } }
        }
    }
    GRID_BAR();

    for (int j = 0; j < 2; ++j) {
        { PH_BEGIN
          pg8::Gemm g{U, (const bf16_t*)(dob + DO_W + (size_t)j * W_PAIR + W_EVIN), DM, DM, NTILE, 37, 0, 1, 1, 0}; pg8::StaticOrder S; S.init(NTILE, 37, G, bx);
          EpiEvIn E{BIG, (float*)(dob + DO_SMALL), inp(lds, 10) + j * 16}; pg8::gemm_phase(lds, tid, g, S, E); }
        GRID_BAR();
        {   PH_BEGIN
            {
                const float* cw = inp(lds, 9) + (size_t)j * 3 * 1024;
                for (int rg = gw; rg < TOK / 4; rg += NGW) {
                    const int r0 = rg * 4, s0 = r0 % SB; const bool hp = (s0 != 0 && s0 != CTXL), hn = (s0 + 3 != CTXL - 1 && s0 + 3 != SB - 1);
                    bf16_t* er = BIG + (size_t)r0 * EV_LD;
#pragma unroll
                    for (int jj = 0; jj < 2; ++jj) { const int c = jj * 512 + lane * 8; const u32x4 z4 = (u32x4){0u, 0u, 0u, 0u};
                        u32x4 pw_[6], gw_[4];
                        pw_[0] = hp ? *(const GAS u32x4*)(er - EV_LD + 2048 + c) : z4;
#pragma unroll
                        for (int i = 0; i < 4; ++i) { pw_[1 + i] = *(const GAS u32x4*)(er + (size_t)i * EV_LD + 2048 + c); gw_[i] = *(const GAS u32x4*)(er + (size_t)i * EV_LD + c); }
                        pw_[5] = hn ? *(const GAS u32x4*)(er + (size_t)4 * EV_LD + 2048 + c) : z4;
                        const f32x4 w00 = *(const GAS f32x4*)(cw + c), w01 = *(const GAS f32x4*)(cw + c + 4), w10 = *(const GAS f32x4*)(cw + 1024 + c), w11 = *(const GAS f32x4*)(cw + 1024 + c + 4),
                                    w20 = *(const GAS f32x4*)(cw + 2048 + c), w21 = *(const GAS f32x4*)(cw + 2048 + c + 4);
                        f32x4 p[6][2];
#pragma unroll
                        for (int i = 0; i < 6; ++i) unpack8(pw_[i], p[i][0], p[i][1]);
#pragma unroll
                        for (int i = 0; i < 4; ++i) { f32x4 g0, g1; unpack8(gw_[i], g0, g1);
                            *(GAS u32x4*)(er + (size_t)i * EV_LD + c) = pack8(g0 * (p[i][0] * w00 + p[i + 1][0] * w10 + p[i + 2][0] * w20), g1 * (p[i][1] * w01 + p[i + 1][1] * w11 + p[i + 2][1] * w21)); } }
                }
            }
            {
                for (int it = vcu; it < NB * 8; it += G) {
                    unsigned char* w2 = ws; unsigned char* d2 = dob; asm volatile("" : "+s"(w2), "+s"(d2));
                    const int b = it >> 3, head = (it >> 1) & 3, dh = it & 1;
                    msc::scan_item((const bf16_t*)(w2 + WS_BIG) + (size_t)b * SB * EV_LD, (const float*)(d2 + DO_SMALL) + (size_t)b * SB * 16, (bf16_t*)(d2 + DO_U) + (size_t)b * SB * DM, head, dh, lds, wave0);
                }
            }
        }
        GRID_BAR();
        { PH_BEGIN
          pg8::Gemm g{BIG, (const bf16_t*)(dob + DO_W + (size_t)j * W_PAIR + W_EVOUT), EV_LD, 2048, NTILE, 4, 0, 1, 1, 0}; pg8::StaticOrder S; S.init(NTILE, 4, G, bx);
          EpiOut E{H, modv + (size_t)(2 * j) * 33 * 3072}; pg8::gemm_phase(lds, tid, g, S, E); }
        GRID_BAR();
        {   PH_BEGIN
            const int L = 2 * j;
            ln_phase<false>(H, U, nullptr, inp(lds, 6) + L * DM, inp(lds, 7) + L * DM, modv + (size_t)(L + 1) * 33 * 3072, gw, NGW, lane, 0u);
        }
        GRID_BAR();
        const bool need_ctx = (j == 0);
        { PH_BEGIN
          pg8::Gemm g{U, (const bf16_t*)(dob + DO_W + (size_t)j * W_PAIR + W_ODIN), DM, DM, NTILE, 11, 0, 1, 1, 0}; pg8::StaticOrder S; S.init(NTILE, 11, G, bx);
          EpiOdIn E{BIG}; pg8::gemm_phase(lds, tid, g, S, E); }
        GRID_BAR();
        {   PH_BEGIN
            float* rowsc = (float*)(dob + DO_ROWSC); bf16_t* KR = (bf16_t*)(dob + DO_SMALL); const float* cosT = (const float*)(dob + DO_ROPE); const float* sinT = cosT + 2048 * 32;
            for (int rg = gw; rg < TOK / 4; rg += NGW) {
                const int r0 = rg * 4, s0 = r0 % SB; const bool lat = s0 >= CTXL;
                unsigned wq[4][3], wk[4][2]; bf16_t x1[4], x2[4]; float cc[4], sn[4];
#pragma unroll
                for (int i = 0; i < 4; ++i) { const GAS bf16_t* orow = (const GAS bf16_t*)BIG + (size_t)(r0 + i) * OD_LD + 2048;
#pragma unroll
                    for (int q = 0; q < 3; ++q) wq[i][q] = *(const GAS unsigned*)(orow + (q * 64 + lane) * 2);
#pragma unroll
                    for (int q = 0; q < 2; ++q) wk[i][q] = *(const GAS unsigned*)(orow + 384 + (q * 64 + lane) * 2);
                    x1[i] = orow[640 + (lane & 31)]; x2[i] = orow[672 + (lane & 31)];
                    cc[i] = 1.f; sn[i] = 0.f;
                    if (lat) { cc[i] = ((const GAS float*)cosT)[(s0 + i - CTXL) * 32 + (lane & 31)]; sn[i] = ((const GAS float*)sinT)[(s0 + i - CTXL) * 32 + (lane & 31)]; } }
                float sq[4], sk[4];
#pragma unroll
                for (int i = 0; i < 4; ++i) { sq[i] = 0.f; sk[i] = 0.f;
#pragma unroll
                    for (int q = 0; q < 3; ++q) { const float a = bflo(wq[i][q]), c = bfhi(wq[i][q]); sq[i] += a * a + c * c; }
#pragma unroll
                    for (int q = 0; q < 2; ++q) { const float a = bflo(wk[i][q]), c = bfhi(wk[i][q]); sk[i] += a * a + c * c; } }
#pragma unroll
                for (int o = 1; o < 64; o <<= 1)
#pragma unroll
                    for (int i = 0; i < 4; ++i) { sq[i] += __shfl_xor(sq[i], o); sk[i] += __shfl_xor(sk[i], o); }
#pragma unroll
                for (int i = 0; i < 4; ++i) { const size_t r = (size_t)(r0 + i);
                    if (lane == 0) { ((GAS float*)rowsc)[r * 2] = 1.0f / sqrtf(sq[i] * (1.0f / 384.0f) + RMS_EPS); ((GAS float*)rowsc)[r * 2 + 1] = 1.0f / sqrtf(sk[i] * (1.0f / 256.0f) + RMS_EPS); }
                    if (lane < 32) { const float a = bf1(x1[i]), c = bf1(x2[i]);
                        ((GAS bf16_t*)KR)[r * 64 + lane] = f2bf(a * cc[i] - c * sn[i]); ((GAS bf16_t*)KR)[r * 64 + 32 + lane] = f2bf(a * sn[i] + c * cc[i]); } }
            }
        }
        GRID_BAR();
        for (int grp = 0; grp < NGRP; ++grp) {
            { PH_BEGIN
              const float* rowsc = (const float*)(dob + DO_ROWSC); const float* cosT = (const float*)(dob + DO_ROPE);
              pg8::Gemm g{BIG + 2048, (const bf16_t*)(dob + DO_W + (size_t)j * W_PAIR + W_UQ), OD_LD, 384, need_ctx ? GT : GB * 8, 12, grp * GT, need_ctx ? 1 : 8, need_ctx ? 1 : 9, need_ctx ? 0 : 1};
              pg8::StaticOrder S; S.init(g.nM, 12, G, bx); EpiUq E{(bf16_t*)(ws + WS_BIG + BIG_Q), rowsc, cosT, cosT + 2048 * 32, grp}; pg8::gemm_phase(lds, tid, g, S, E); }
            { PH_BEGIN
              const float* rowsc = (const float*)(dob + DO_ROWSC);
              pg8::Gemm g{BIG + 2432, (const bf16_t*)(dob + DO_W + (size_t)j * W_PAIR + W_UKV), OD_LD, 256, GT, 16, grp * GT, 1, 1, 0};
              pg8::StaticOrder S; S.init(GT, 16, G, bx); EpiUkv E{(bf16_t*)(ws + WS_BIG + BIG_K), (bf16_t*)(ws + WS_BIG + BIG_V), rowsc, (const bf16_t*)(dob + DO_SMALL), grp}; pg8::gemm_phase(lds, tid, g, S, E); }
            GRID_BAR();
            {   PH_BEGIN
                const int nunits = GB * 16 * 8 + (need_ctx ? GB * 16 : 0);
                for (int un = vcu; un < nunits; un += G) {
                    unsigned char* w2 = ws; asm volatile("" : "+s"(w2));
                    const bf16_t* Qb = (const bf16_t*)(w2 + WS_BIG + BIG_Q); const bf16_t* Kb = (const bf16_t*)(w2 + WS_BIG + BIG_K); const bf16_t* Vb = (const bf16_t*)(w2 + WS_BIG + BIG_V);
                    bf16_t* BIG2 = (bf16_t*)(w2 + WS_BIG);
                    int bl, head, qb, nkeys;
                    if (un < GB * 128) { bl = un >> 7; head = (un >> 3) & 15; qb = 1 + (un & 7); nkeys = SB; }
                    else { const int u2 = un - GB * 128; bl = u2 >> 4; head = u2 & 15; qb = 0; nkeys = CTXL; }
                    const size_t bh = (size_t)(bl * 16 + head) * SB;
                    att::attn_unit(Qb + (bh + qb * 256) * 192, Kb + bh * 192, Vb + bh * 128, BIG2 + (size_t)((grp * GB + bl) * SB + qb * 256) * OD_LD + head * 128, nkeys, lds, tid);
                }
            }
            GRID_BAR();
        }
        { PH_BEGIN
          pg8::Gemm g{BIG, (const bf16_t*)(dob + DO_W + (size_t)j * W_PAIR + W_ODOUT), OD_LD, 2048, need_ctx ? NTILE : NB * 8, 4, 0, need_ctx ? 1 : 8, need_ctx ? 1 : 9, need_ctx ? 0 : 1}; pg8::StaticOrder S; S.init(g.nM, 4, G, bx);
          EpiOut E{H, modv + (size_t)(2 * j + 1) * 33 * 3072}; pg8::gemm_phase(lds, tid, g, S, E); }
        GRID_BAR();
        {   PH_BEGIN
            const int L = 2 * j + 1;
            if (need_ctx) ln_phase<false>(H, U, nullptr, inp(lds, 6) + L * DM, inp(lds, 7) + L * DM, modv + (size_t)(L + 1) * 33 * 3072, gw, NGW, lane, 0u);
            else { const unsigned tmo = __hip_atomic_load((GAS unsigned*)(ws + WS_CTL) + 4096 + XB_TMO, __ATOMIC_RELAXED, __HIP_MEMORY_SCOPE_AGENT);
                   ln_phase<true>(H, nullptr, (float*)dob, inp(lds, 6) + L * DM, inp(lds, 7) + L * DM, nullptr, gw, NGW, lane, tmo); }
        }
        if (need_ctx) GRID_BAR();
    }
}

extern "C" void kernel_launch(void* const* d_in, const int* in_sizes, int n_in, void* d_out, int out_size, void* d_ws, size_t ws_size, hipStream_t stream) {
    static int grid = 0;
    if (grid == 0) {
        if (n_in != 18 || out_size != NB * SEQ * DM || ws_size < WS_END) { fprintf(stderr, "kernel_launch: unexpected shapes (n_in %d out %d ws %zu)\n", n_in, out_size, ws_size); grid = -1; return; }
        int dev = 0, cus = 0;
        if (hipGetDevice(&dev) != hipSuccess || hipDeviceGetAttribute(&cus, hipDeviceAttributeMultiprocessorCount, dev) != hipSuccess) { grid = -1; return; }
        if (hipFuncSetAttribute((const void*)fwd_kernel, hipFuncAttributeMaxDynamicSharedMemorySize, LDS_BYTES) != hipSuccess) { fprintf(stderr, "kernel_launch: hipFuncSetAttribute failed\n"); grid = -1; return; }
        int per_cu = 0;
        if (hipOccupancyMaxActiveBlocksPerMultiprocessor(&per_cu, (const void*)fwd_kernel, 512, LDS_BYTES) != hipSuccess || per_cu < 1) fprintf(stderr, "kernel_launch: occupancy query says %d\n", per_cu);
        (void)hipGetLastError();
        grid = cus;
    }
    if (grid < 0) return;
    if (hipMemsetAsync((char*)d_ws + WS_CTL, 0, CTL_BYTES, stream) != hipSuccess) return;
    Params p{};
    for (int i = 0; i < 18; ++i) p.in[i] = (const float*)d_in[i];
    p.out = (float*)d_out; p.ws = (unsigned char*)d_ws;
    hipLaunchKernelGGL(fwd_kernel, dim3(grid), dim3(512), LDS_BYTES, stream, p);
}
```

```cpp
#include <hip/hip_runtime.h>
#include <cstdio>
#include <cstdint>

#define LAS __attribute__((address_space(3)))
#define GAS __attribute__((address_space(1)))
typedef unsigned short bf16_t;
typedef short bf16x8 __attribute__((ext_vector_type(8)));
typedef float f32x4 __attribute__((ext_vector_type(4)));
typedef unsigned u32x4 __attribute__((ext_vector_type(4)));
typedef unsigned u32x2 __attribute__((ext_vector_type(2)));

constexpr int DM = 1024, NB = 32, SEQ = 2048, CTXL = 256, SB = SEQ + CTXL  , TOK = NB * SB  ;
constexpr int NTILE = TOK / 256;
constexpr int EV_LD = 6144;
constexpr int EV_NP = 9472;
constexpr int OD_LD = 2816;
constexpr int NGRP = 4, GB = NB / NGRP  , GT = GB * 9  , GROWS = GB * SB  ;
constexpr float ALPHA = 1.681792830507429f;
constexpr float QSCALE = 0.07216878364870322f * 1.4426950408889634f;
constexpr float LN_EPS = 1e-5f, RMS_EPS = 1e-6f;

constexpr size_t DO_U = 0;
constexpr size_t DO_W = 150994944;
constexpr size_t W_PAIR = 38010880, W_EVIN = 0, W_EVOUT = 19398656, W_ODIN = 23592960, W_UQ = 29360128, W_UKV = 31719424, W_ODOUT = 33816576;
constexpr size_t DO_MODV = DO_W + 2 * W_PAIR;
constexpr size_t DO_ROPE = DO_MODV + 1622016;
constexpr size_t DO_ROWSC = DO_ROPE + 524288;
constexpr size_t DO_SMALL = DO_ROWSC + 589824;
constexpr size_t DO_END = DO_SMALL + 9437184;
static_assert(DO_END <= 268435456, "d_out map");
constexpr size_t WS_CTL = 0, CTL_BYTES = 1 << 20;
constexpr size_t WS_H = 1 << 20;
constexpr size_t WS_BIG = WS_H + 150994944;
constexpr size_t BIG_Q = 415236096, BIG_K = BIG_Q + 113246208, BIG_V = BIG_K + 113246208;
constexpr size_t WS_END = WS_BIG + 905969664;
static_assert(WS_END <= 1073741824, "ws map");
static_assert(BIG_V + 75497472 <= 905969664, "odd map");

__device__ __forceinline__ unsigned cvt_pk_bf16(float lo, float hi) { unsigned r; asm volatile("v_cvt_pk_bf16_f32 %0, %1, %2" : "=v"(r) : "v"(lo), "v"(hi)); return r; }
__device__ __forceinline__ float bflo(unsigned w) { return __uint_as_float(w << 16); }
__device__ __forceinline__ float bfhi(unsigned w) { return __uint_as_float(w & 0xffff0000u); }
__device__ __forceinline__ float bf1(bf16_t h) { return __uint_as_float(((unsigned)h) << 16); }
__device__ __forceinline__ bf16_t f2bf(float f) { return (bf16_t)(cvt_pk_bf16(f, 0.f) & 0xffffu); }
__device__ __forceinline__ float fsigmoid(float x) { return __builtin_amdgcn_rcpf(1.0f + __builtin_amdgcn_exp2f(-1.4426950408889634f * x)); }
__device__ __forceinline__ float fsilu(float x) { return x * fsigmoid(x); }
__device__ __forceinline__ float wave_sum(float v) {
#pragma unroll
    for (int o = 1; o < 64; o <<= 1) v += __shfl_xor(v, o);
    return v;
}
#define LDS_WAIT() asm volatile("s_waitcnt lgkmcnt(0)" ::: "memory")

#define XB_TMO      128
#define XB_XCNT(j)  (256  + 64 * (j))
#define XB_XSUB(j)  (1280 + 64 * (j))
#define XB_XGEN(j)  (2304 + 64 * (j))
#define XB_TOP      3328
#define XB_TOPGEN   3392
#define XCD_BAR_WORDS 3456
#define XB_SPIN_CAP (1u << 24)
__device__ __forceinline__ unsigned xb_ld(unsigned* p)              { return __hip_atomic_load((GAS unsigned*)p, __ATOMIC_RELAXED, __HIP_MEMORY_SCOPE_AGENT); }
__device__ __forceinline__ unsigned xb_add(unsigned* p, unsigned v) { return __hip_atomic_fetch_add((GAS unsigned*)p, v, __ATOMIC_RELAXED, __HIP_MEMORY_SCOPE_AGENT); }
__device__ __forceinline__ unsigned xb_xcc_id() { return (unsigned)__builtin_amdgcn_s_getreg((3 << 11) | 20) & 0xFu; }
#define XB_SPIN(cond, bar) do { unsigned _sp = 0; while (cond) { __builtin_amdgcn_s_sleep(1); \
    if ((++_sp & 255u) == 0u) { if (xb_ld(&(bar)[XB_TMO])) break; if (_sp > XB_SPIN_CAP) { __hip_atomic_fetch_add((GAS unsigned*)&(bar)[XB_TMO], 1u, __ATOMIC_RELAXED, __HIP_MEMORY_SCOPE_AGENT); break; } } } } while (0)
struct XcdBarrier { unsigned* bar; unsigned x; volatile LAS unsigned* st; };
__device__ __forceinline__ XcdBarrier xcd_barrier_post(unsigned* bar, volatile LAS unsigned* st) {
    XcdBarrier b; b.bar = bar; b.x = xb_xcc_id(); b.st = st;
    if (threadIdx.x == 0) (void)xb_add(&bar[XB_XCNT(b.x)], 1u);
    return b;
}
__device__ __forceinline__ void xcd_barrier_complete(unsigned* bar, unsigned x, unsigned& nloc, unsigned& nx) {
    const unsigned G = gridDim.x * gridDim.y * gridDim.z;
    unsigned sum, cnt, mine, sp = 0u;
    for (;;) {
        sum = 0u; cnt = 0u; mine = 0u;
#pragma unroll
        for (unsigned j = 0; j < 16; ++j) { const unsigned c = xb_ld(&bar[XB_XCNT(j)]); sum += c; cnt += (c > 0u) ? 1u : 0u; mine = (j == x) ? c : mine; }
        if (sum == G) break;
        __builtin_amdgcn_s_sleep(1);
        if ((++sp & 255u) == 0u) { if (xb_ld(&bar[XB_TMO])) break; if (sp > XB_SPIN_CAP) { __hip_atomic_fetch_add((GAS unsigned*)&bar[XB_TMO], 1u, __ATOMIC_RELAXED, __HIP_MEMORY_SCOPE_AGENT); break; } }
    }
    nloc = mine > 0u ? mine : 1u; nx = cnt > 0u ? cnt : 1u;
}
__device__ __forceinline__ void xcd_barrier(const XcdBarrier& b) {
    asm volatile("s_waitcnt vmcnt(0)" ::: "memory");
    __syncthreads();
    if (threadIdx.x == 0) {
        unsigned* bar = b.bar;
        __builtin_amdgcn_s_waitcnt(0);
        unsigned nloc = b.st[0], nx = b.st[1];
        if (nloc == 0u) { xcd_barrier_complete(bar, b.x, nloc, nx); b.st[0] = nloc; b.st[1] = nx; }
        const unsigned old = xb_add(&bar[XB_XSUB(b.x)], 1u);
        const unsigned gen = old / nloc;
        if (old + 1u == (gen + 1u) * nloc) {
            __builtin_amdgcn_fence(__ATOMIC_RELEASE, "agent");
            asm volatile("s_waitcnt vmcnt(0)" ::: "memory");
            const unsigned og = xb_add(&bar[XB_TOP], 1u);
            const unsigned tg = og / nx;
            if (og + 1u == (tg + 1u) * nx) xb_add(&bar[XB_TOPGEN], 1u);
            else XB_SPIN(xb_ld(&bar[XB_TOPGEN]) == tg, bar);
            __builtin_amdgcn_fence(__ATOMIC_ACQUIRE, "agent");
            xb_add(&bar[XB_XGEN(b.x)], 1u);
            asm volatile("s_waitcnt vmcnt(0)" ::: "memory");
        } else {
            XB_SPIN(xb_ld(&bar[XB_XGEN(b.x)]) == gen, bar);
            __builtin_amdgcn_fence(__ATOMIC_ACQUIRE, "agent");
            asm volatile("s_waitcnt vmcnt(0)" ::: "memory");
        }
    }
    __syncthreads();
}

namespace pg8 {
constexpr int BM = 256, BK = 64, HALF = 128, HTB = HALF * BK * 2, STAGE_BYTES = 8 * HTB, NXCD = 8, WGM = 8;
__host__ __device__ __forceinline__ int lds_byte(int r, int c) { const int st = (r >> 4) * 2 + (c >> 5), rr = r & 15, cc = c & 31, ob = rr * 64 + cc * 2; return st * 1024 + (ob ^ (((ob >> 9) & 1) << 5)); }
__host__ __device__ __forceinline__ void stage_rc(int b, int& R, int& C) { const int st = b / 1024, sb = b % 1024, swz = sb ^ (((sb >> 9) & 1) << 5); R = (st >> 1) * 16 + swz / 64; C = (st & 1) * 32 + (swz % 64) / 2; }
__host__ __device__ __forceinline__ int perm32(int rho) { const int n = rho >> 4, i = rho & 15; return 8 * (i >> 2) + 4 * n + (i & 3); }
struct Unit { int pm, pn; };
struct Gemm { const bf16_t* A; const bf16_t* Bt; int lda, K, nM, nN, tbase, gsz, gstride, goff;
    __device__ __forceinline__ int ptile(int pm) const { return tbase + (pm / gsz) * gstride + goff + (pm % gsz); } };
struct StaticOrder {
    int nM, nN, nwg, G, c;
    __device__ void init(int nM_, int nN_, int G_, int c_) { nM = nM_; nN = nN_; nwg = nM * nN; G = G_; c = c_; }
    __device__ bool next(int i, Unit& u) const {
        const long L = (long)i * G + c; if (L >= nwg) return false;
        int wgid = (int)L; { const int q = nwg / NXCD, r = nwg % NXCD, xcd = wgid % NXCD, off = wgid / NXCD; wgid = (xcd < r ? xcd * (q + 1) : r * (q + 1) + (xcd - r) * q) + off; }
        const int nig = WGM * nN, gid = wgid / nig, fm = gid * WGM, gsz = (nM - fm) < WGM ? (nM - fm) : WGM;
        u.pm = fm + ((wgid % nig) % gsz); u.pn = (wgid % nig) / gsz; return true;
    }
};
template <class Epi>
__device__ __forceinline__ void gemm_phase(LAS unsigned char* lds, const int tid, const Gemm g, const StaticOrder& S, const Epi& E) {
    const int wid = __builtin_amdgcn_readfirstlane(tid >> 6), lane = tid & 63, wr = wid >> 2, wc = wid & 3, fr = lane & 15, fq = lane >> 4;
    const int K = g.K, nt = K / BK, lda = g.lda;
    unsigned voffA[2], voffB[2];
#pragma unroll
    for (int i = 0; i < 2; ++i) { int R, C; stage_rc(tid * 16 + i * 8192, R, C); const int Rb = (R & ~31) + perm32(R & 31);
        voffA[i] = (unsigned)(R * lda + C) * 2u; voffB[i] = (unsigned)(Rb * K + C) * 2u; }
    const size_t kstep = (size_t)(BK * 2);
    const size_t hstepA = (size_t)HALF * lda * 2, hstepB = (size_t)HALF * K * 2;
    const size_t tstepA = 2 * hstepA, tstepB = 2 * hstepB;
    const unsigned ldsw = (unsigned)wid * 1024u;
    const int aoff = lds_byte(wr * 64 + fr, fq * 8), boff = lds_byte(wc * 32 + fr, fq * 8);
#define PG8_SA(b, h) (((b) * 2 + (h)) * HTB)
#define PG8_SB(b, h) ((4 + (b) * 2 + (h)) * HTB)
#define PG8_STAGE(bufoff, gbase, voff) do { _Pragma("unroll") for (int _i = 0; _i < 2; ++_i) \
        __builtin_amdgcn_global_load_lds((const unsigned*)((const char*)(gbase) + (voff)[_i]), (LAS unsigned*)(lds + (bufoff) + ldsw + _i * 8192), 16, 0, 0); } while (0)
#define PG8_LDA(dst, b, h) do { _Pragma("unroll") for (int m = 0; m < 4; ++m) _Pragma("unroll") for (int k = 0; k < 2; ++k) dst[m][k] = *(const LAS bf16x8*)(lds + PG8_SA(b, h) + aoff + m * 2048 + k * 1024); } while (0)
#define PG8_LDB(dst, b, h) do { _Pragma("unroll") for (int n = 0; n < 2; ++n) _Pragma("unroll") for (int k = 0; k < 2; ++k) dst[n][k] = *(const LAS bf16x8*)(lds + PG8_SB(b, h) + boff + n * 2048 + k * 1024); } while (0)
#define PG8_MMA(ai, bj, At, Bt) do { __builtin_amdgcn_s_setprio(1); _Pragma("unroll") for (int m = 0; m < 4; ++m) _Pragma("unroll") for (int n = 0; n < 2; ++n) _Pragma("unroll") for (int k = 0; k < 2; ++k) \
        acc[ai][bj][m][n] = __builtin_amdgcn_mfma_f32_16x16x32_bf16(Bt[n][k], At[m][k], acc[ai][bj][m][n], 0, 0, 0); __builtin_amdgcn_s_setprio(0); } while (0)
#define PG8_WAIT_V(n) asm volatile("s_waitcnt vmcnt(" #n ")" ::: "memory")
#define PG8_WAIT_L(n) asm volatile("s_waitcnt lgkmcnt(" #n ")" ::: "memory")
#define PG8_BAR __builtin_amdgcn_s_barrier()
#define PG8_SCHED __builtin_amdgcn_sched_barrier(0)
    Unit cur, nxt; int ui = 0;
    if (!S.next(0, cur)) return;
    f32x4 acc[2][2][4][2];
#pragma unroll
    for (int a = 0; a < 2; ++a)
#pragma unroll
        for (int b = 0; b < 2; ++b)
#pragma unroll
            for (int m = 0; m < 4; ++m)
#pragma unroll
                for (int n = 0; n < 2; ++n) acc[a][b][m][n] = (f32x4){0.f, 0.f, 0.f, 0.f};
    bf16x8 At[4][2], B0[2][2], B1[2][2];
    int curpt = g.ptile(cur.pm);
    const char* cA = (const char*)g.A + (size_t)curpt * tstepA; const char* cB = (const char*)g.Bt + (size_t)cur.pn * tstepB;
    PG8_STAGE(PG8_SB(0, 0), cB, voffB); PG8_STAGE(PG8_SA(0, 0), cA, voffA); PG8_STAGE(PG8_SB(0, 1), cB + hstepB, voffB); PG8_STAGE(PG8_SA(0, 1), cA + hstepA, voffA);
    if (wr == 1) PG8_BAR;
    PG8_WAIT_V(4); PG8_BAR;
    PG8_STAGE(PG8_SB(1, 0), cB + kstep, voffB); PG8_STAGE(PG8_SA(1, 0), cA + kstep, voffA); PG8_STAGE(PG8_SB(1, 1), cB + hstepB + kstep, voffB);
    PG8_WAIT_V(6); PG8_BAR;
    for (;;) {
        const bool has_next = S.next(ui + 1, nxt);
        const int nxtpt = has_next ? g.ptile(nxt.pm) : curpt;
        const char* nA = has_next ? (const char*)g.A + (size_t)nxtpt * tstepA : cA; const char* nB = has_next ? (const char*)g.Bt + (size_t)nxt.pn * tstepB : cB;
#pragma unroll 1
        for (int t = 0; t < nt; t += 2) {
            const bool last = (t == nt - 2);
            const char* a1 = cA + (size_t)(t + 1) * kstep;
            const char* a2 = last ? nA : cA + (size_t)(t + 2) * kstep; const char* b2 = last ? nB : cB + (size_t)(t + 2) * kstep;
            const char* a3 = a2 + kstep; const char* b3 = b2 + kstep;
            PG8_LDB(B0, 0, 0); PG8_SCHED; PG8_LDA(At, 0, 0); PG8_STAGE(PG8_SA(1, 1), a1 + hstepA, voffA);
            PG8_WAIT_L(8); PG8_BAR; PG8_WAIT_L(0); PG8_MMA(0, 0, At, B0); PG8_BAR; PG8_SCHED;
            PG8_LDB(B1, 0, 1); PG8_STAGE(PG8_SB(0, 0), b2, voffB);
            PG8_BAR; PG8_WAIT_L(0); PG8_MMA(0, 1, At, B1); PG8_BAR;
            PG8_LDA(At, 0, 1); PG8_STAGE(PG8_SA(0, 0), a2, voffA);
            PG8_BAR; PG8_WAIT_L(0); PG8_MMA(1, 0, At, B0); PG8_BAR; PG8_SCHED;
            PG8_STAGE(PG8_SB(0, 1), b2 + hstepB, voffB);
            PG8_WAIT_V(6); PG8_BAR; PG8_MMA(1, 1, At, B1); PG8_BAR;
            PG8_LDB(B0, 1, 0); PG8_SCHED; PG8_LDA(At, 1, 0); PG8_STAGE(PG8_SA(0, 1), a2 + hstepA, voffA);
            PG8_WAIT_L(8); PG8_BAR; PG8_WAIT_L(0); PG8_MMA(0, 0, At, B0); PG8_BAR; PG8_SCHED;
            PG8_LDB(B1, 1, 1); PG8_STAGE(PG8_SB(1, 0), b3, voffB);
            PG8_BAR; PG8_WAIT_L(0); PG8_MMA(0, 1, At, B1); PG8_BAR;
            PG8_LDA(At, 1, 1); PG8_STAGE(PG8_SA(1, 0), a3, voffA);
            PG8_BAR; PG8_WAIT_L(0); PG8_MMA(1, 0, At, B0); PG8_BAR; PG8_SCHED;
            PG8_STAGE(PG8_SB(1, 1), b3 + hstepB, voffB);
            PG8_WAIT_V(6); PG8_BAR; PG8_MMA(1, 1, At, B1); PG8_BAR;
        }
        E(acc, cur.pn, curpt, wr, wc, fr, fq);
        if (!has_next) break;
#pragma unroll
        for (int a = 0; a < 2; ++a)
#pragma unroll
            for (int b = 0; b < 2; ++b)
#pragma unroll
                for (int m = 0; m < 4; ++m)
#pragma unroll
                    for (int n = 0; n < 2; ++n) acc[a][b][m][n] = (f32x4){0.f, 0.f, 0.f, 0.f};
        cur = nxt; cA = nA; cB = nB; curpt = nxtpt; ++ui;
    }
    PG8_WAIT_V(0);
    if (wr == 0) PG8_BAR;
    PG8_BAR;
#undef PG8_SA
#undef PG8_SB
#undef PG8_STAGE
#undef PG8_LDA
#undef PG8_LDB
#undef PG8_MMA
#undef PG8_WAIT_V
#undef PG8_WAIT_L
#undef PG8_BAR
#undef PG8_SCHED
}
}

typedef const f32x4 (&AccRef)[2][2][4][2];
__device__ __forceinline__ u32x4 pack8(const f32x4 a, const f32x4 b) { u32x4 w; w.x = cvt_pk_bf16(a[0], a[1]); w.y = cvt_pk_bf16(a[2], a[3]); w.z = cvt_pk_bf16(b[0], b[1]); w.w = cvt_pk_bf16(b[2], b[3]); return w; }
__device__ __forceinline__ void unpack8(const u32x4 w, f32x4& a, f32x4& b) { a = (f32x4){bflo(w.x), bfhi(w.x), bflo(w.y), bfhi(w.y)}; b = (f32x4){bflo(w.z), bfhi(w.z), bflo(w.w), bfhi(w.w)}; }
__device__ __forceinline__ f32x4 silu4(f32x4 v) { return (f32x4){fsilu(v[0]), fsilu(v[1]), fsilu(v[2]), fsilu(v[3])}; }
__device__ __forceinline__ f32x4 sigm4(f32x4 v) { return (f32x4){fsigmoid(v[0]), fsigmoid(v[1]), fsigmoid(v[2]), fsigmoid(v[3])}; }

struct EpiEvIn {
    bf16_t* EV; float* gates; const float* gate_b;
    __device__ __forceinline__ void operator()(AccRef acc, int pn, int pt, int wr, int wc, int fr, int fq) const {
        const int row0 = pt * 256 + wr * 64 + fr, cl = wc * 32 + 8 * fq;
        if (pn < 24) {
            const int kind = pn >> 3, col = kind * 1024 + (pn & 7) * 128 + cl;
#pragma unroll
            for (int ai = 0; ai < 2; ++ai)
#pragma unroll
                for (int m = 0; m < 4; ++m) {
                    const f32x4 x0 = acc[ai][0][m][0], x1 = acc[ai][0][m][1], y0 = acc[ai][1][m][0], y1 = acc[ai][1][m][1];
                    f32x4 r0, r1;
                    if (kind == 0) { r0 = x0 * silu4(y0); r1 = x1 * silu4(y1); }
                    else if (kind == 1) { r0 = sigm4(x0) * silu4(y0); r1 = sigm4(x1) * silu4(y1); }
                    else { r0 = x0 * y0; r1 = x1 * y1; }
                    *(GAS u32x4*)(EV + (size_t)(row0 + ai * 128 + m * 16) * EV_LD + col) = pack8(r0, r1);
                    asm volatile("" ::: "memory");
                }
        } else if (pn < 36) {
            const int col = 3072 + (pn - 24) * 256 + cl;
#pragma unroll
            for (int ai = 0; ai < 2; ++ai)
#pragma unroll
                for (int m = 0; m < 4; ++m)
#pragma unroll
                    for (int bj = 0; bj < 2; ++bj)
                        *(GAS u32x4*)(EV + (size_t)(row0 + ai * 128 + m * 16) * EV_LD + col + bj * 128) = pack8(acc[ai][bj][m][0], acc[ai][bj][m][1]);
        } else {
            if (wc == 0 && fq < 2) {
                const f32x4 b0 = *(const GAS f32x4*)(gate_b + 8 * fq), b1 = *(const GAS f32x4*)(gate_b + 8 * fq + 4);
#pragma unroll
                for (int ai = 0; ai < 2; ++ai)
#pragma unroll
                    for (int m = 0; m < 4; ++m) {
                        GAS float* gp = (GAS float*)gates + (size_t)(row0 + ai * 128 + m * 16) * 16 + 8 * fq;
                        *(GAS f32x4*)gp = acc[ai][0][m][0] + b0; *(GAS f32x4*)(gp + 4) = acc[ai][0][m][1] + b1;
                    }
            }
        }
    }
};
struct EpiOdIn {
    bf16_t* OD;
    __device__ __forceinline__ void operator()(AccRef acc, int pn, int pt, int wr, int wc, int fr, int fq) const {
        const int row0 = pt * 256 + wr * 64 + fr, col = pn * 256 + wc * 32 + 8 * fq;
#pragma unroll
        for (int ai = 0; ai < 2; ++ai)
#pragma unroll
            for (int m = 0; m < 4; ++m)
#pragma unroll
                for (int bj = 0; bj < 2; ++bj) {
                    f32x4 v0 = acc[ai][bj][m][0], v1 = acc[ai][bj][m][1];
                    if (pn < 8) { v0 = silu4(v0); v1 = silu4(v1); }
                    *(GAS u32x4*)(OD + (size_t)(row0 + ai * 128 + m * 16) * OD_LD + col + bj * 128) = pack8(v0, v1);
                }
    }
};
struct EpiUq {
    bf16_t* Q; const float* rowsc; const float* cosT; const float* sinT; int grp;
    __device__ __forceinline__ void operator()(AccRef acc, int pn, int pt, int wr, int wc, int fr, int fq) const {
        const int lt = pt - grp * GT, bl = lt / 9, s0 = (lt % 9) * 256 + wr * 64 + fr, row0 = pt * 256 + wr * 64 + fr;
        float sc[8];
#pragma unroll
        for (int i = 0; i < 8; ++i) sc[i] = ((const GAS float*)rowsc)[(size_t)(row0 + (i >> 2) * 128 + (i & 3) * 16) * 2];
        if (pn < 8) {
#pragma unroll
            for (int ai = 0; ai < 2; ++ai)
#pragma unroll
                for (int m = 0; m < 4; ++m) {
                    const int ro = ai * 128 + m * 16; const float scq = sc[ai * 4 + m] * QSCALE;
#pragma unroll
                    for (int bj = 0; bj < 2; ++bj) {
                        const int head = 2 * pn + bj;
                        *(GAS u32x4*)(Q + ((size_t)(bl * 16 + head) * SB + s0 + ro) * 192 + wc * 32 + 8 * fq) = pack8(acc[ai][bj][m][0] * scq, acc[ai][bj][m][1] * scq);
                    }
                }
        } else {
            const int head = 4 * (pn - 8) + wc, i0 = 8 * fq; const bool lat = (lt % 9) != 0;
#pragma unroll
            for (int ai = 0; ai < 2; ++ai) {
                f32x4 c0[4], c1[4], n0[4], n1[4];
#pragma unroll
                for (int m = 0; m < 4; ++m) {
                    c0[m] = (f32x4){1.f, 1.f, 1.f, 1.f}; c1[m] = c0[m]; n0[m] = (f32x4){0.f, 0.f, 0.f, 0.f}; n1[m] = n0[m];
                    if (lat) { const int pos = s0 + ai * 128 + m * 16 - CTXL; c0[m] = *(const GAS f32x4*)(cosT + pos * 32 + i0); c1[m] = *(const GAS f32x4*)(cosT + pos * 32 + i0 + 4);
                        n0[m] = *(const GAS f32x4*)(sinT + pos * 32 + i0); n1[m] = *(const GAS f32x4*)(sinT + pos * 32 + i0 + 4); }
                }
#pragma unroll
                for (int m = 0; m < 4; ++m) {
                    const int s = s0 + ai * 128 + m * 16; const float scq = sc[ai * 4 + m] * QSCALE;
                    const f32x4 xa0 = acc[ai][0][m][0], xa1 = acc[ai][0][m][1], xb0 = acc[ai][1][m][0], xb1 = acc[ai][1][m][1];
                    bf16_t* qp = Q + ((size_t)(bl * 16 + head) * SB + s) * 192 + 128 + i0;
                    *(GAS u32x4*)qp = pack8((xa0 * c0[m] - xb0 * n0[m]) * scq, (xa1 * c1[m] - xb1 * n1[m]) * scq);
                    *(GAS u32x4*)(qp + 32) = pack8((xa0 * n0[m] + xb0 * c0[m]) * scq, (xa1 * n1[m] + xb1 * c1[m]) * scq);
                }
                asm volatile("" ::: "memory");
            }
        }
    }
};
struct EpiUkv {
    bf16_t* Kb; bf16_t* Vb; const float* rowsc; const bf16_t* KR; int grp;
    __device__ __forceinline__ void operator()(AccRef acc, int pn, int pt, int wr, int wc, int fr, int fq) const {
        const int lt = pt - grp * GT, bl = lt / 9, s0 = (lt % 9) * 256 + wr * 64 + fr, row0 = pt * 256 + wr * 64 + fr, head = pn;
        const int c8 = ((wc & 1) * 4 + fq) * 8;
        float sc[8]; u32x4 kr[8];
#pragma unroll
        for (int i = 0; i < 8; ++i) { const int ro = (i >> 2) * 128 + (i & 3) * 16; sc[i] = ((const GAS float*)rowsc)[(size_t)(row0 + ro) * 2 + 1];
            kr[i] = (wc < 2) ? *(const GAS u32x4*)(KR + (size_t)(row0 + ro) * 64 + c8) : (u32x4){0u, 0u, 0u, 0u}; }
#pragma unroll
        for (int ai = 0; ai < 2; ++ai)
#pragma unroll
            for (int m = 0; m < 4; ++m) {
                const int ro = ai * 128 + m * 16; const float scv = sc[ai * 4 + m];
                const size_t kv = (size_t)(bl * 16 + head) * SB + s0 + ro;
                *(GAS u32x4*)(Kb + kv * 192 + wc * 32 + 8 * fq) = pack8(acc[ai][0][m][0] * scv, acc[ai][0][m][1] * scv);
                *(GAS u32x4*)(Vb + kv * 128 + wc * 32 + 8 * fq) = pack8(acc[ai][1][m][0] * scv, acc[ai][1][m][1] * scv);
                if (wc < 2) *(GAS u32x4*)(Kb + kv * 192 + 128 + c8) = kr[ai * 4 + m];
            }
    }
};
struct EpiOut {
    bf16_t* H; const float* modv  ;
    __device__ __forceinline__ void operator()(AccRef acc, int pn, int pt, int wr, int wc, int fr, int fq) const {
        const int row0 = pt * 256 + wr * 64 + fr, midx = (pt % 9 == 0) ? 32 : pt / 9;
        const float* gv = modv + (size_t)midx * 3072 + 2048;
#pragma unroll
        for (int bj = 0; bj < 2; ++bj) {
            const int col = pn * 256 + bj * 128 + wc * 32 + 8 * fq;
            const f32x4 g0 = *(const GAS f32x4*)(gv + col), g1 = *(const GAS f32x4*)(gv + col + 4);
            u32x4 hw[8];
#pragma unroll
            for (int i = 0; i < 8; ++i) hw[i] = *(const GAS u32x4*)(H + (size_t)(row0 + (i >> 2) * 128 + (i & 3) * 16) * DM + col);
#pragma unroll
            for (int i = 0; i < 8; ++i) { const int ai = i >> 2, m = i & 3;
                f32x4 h0, h1; unpack8(hw[i], h0, h1);
                *(GAS u32x4*)(H + (size_t)(row0 + ai * 128 + m * 16) * DM + col) = pack8(h0 * ALPHA + g0 * acc[ai][bj][m][0], h1 * ALPHA + g1 * acc[ai][bj][m][1]); }
            asm volatile("" ::: "memory");
        }
    }
};

namespace att {
typedef short s16x4 __attribute__((ext_vector_type(4)));
typedef float f32x16 __attribute__((ext_vector_type(16)));
constexpr int SHM_V = 16384, SHM_KN = 16384, SHM_KR = 8192, OFF_V = 0, OFF_KN = 32768, OFF_KR = 65536, OFF_WS = 81920;
constexpr float THR2 = 11.5f;
#define KSWZ(row, colB) ((row) * 256 + ((colB) ^ (((row) & 7) << 4)))
#define KSWZ2(row, colB) ((row) * 128 + ((colB) ^ ((((row) >> 1) & 7) << 4)))
#define SBAR() __builtin_amdgcn_sched_barrier(0)
__device__ __forceinline__ int crow(int r, int hi) { return (r & 3) + 8 * (r >> 2) + 4 * hi; }
__device__ __forceinline__ void partialSM(f32x16& p0, f32x16& p1, float& m_reg, float& mn, float& alpha) {
  float pmax = p0[0];
#pragma unroll
  for (int r = 1; r < 16; ++r) pmax = fmaxf(pmax, p0[r]);
#pragma unroll
  for (int r = 0; r < 16; ++r) pmax = fmaxf(pmax, p1[r]);
  { auto rr = __builtin_amdgcn_permlane32_swap(__float_as_uint(pmax), __float_as_uint(pmax), false, false);
    pmax = fmaxf(__uint_as_float(rr[0]), __uint_as_float(rr[1])); }
  if (__builtin_expect(__all(pmax - m_reg <= THR2), 1)) { mn = m_reg; alpha = 1.f; }
  else { mn = fmaxf(m_reg, pmax); alpha = __builtin_amdgcn_exp2f(m_reg - mn); m_reg = mn; }
#pragma unroll
  for (int r = 0; r < 16; ++r) p0[r] = p0[r] - mn;
#pragma unroll
  for (int r = 0; r < 16; ++r) p1[r] = p1[r] - mn;
#pragma unroll
  for (int r = 0; r < 16; ++r) p0[r] = __builtin_amdgcn_exp2f(p0[r]);
}
__device__ __forceinline__ void finishSM(f32x16& p0, f32x16& p1, float alpha, float& l_reg, bf16x8& pa0, bf16x8& pa1, bf16x8& pa2, bf16x8& pa3) {
#pragma unroll
  for (int r = 0; r < 16; ++r) p1[r] = __builtin_amdgcn_exp2f(p1[r]);
  float ps = 0;
#pragma unroll
  for (int r = 0; r < 16; ++r) ps += p0[r];
#pragma unroll
  for (int r = 0; r < 16; ++r) ps += p1[r];
  { auto rr = __builtin_amdgcn_permlane32_swap(__float_as_uint(ps), __float_as_uint(ps), false, false);
    ps = __uint_as_float(rr[0]) + __uint_as_float(rr[1]); }
  l_reg = l_reg * alpha + ps;
#define PK4(P, BASE, OUT) do { unsigned a0 = cvt_pk_bf16(P[BASE + 0], P[BASE + 1]), a1 = cvt_pk_bf16(P[BASE + 2], P[BASE + 3]);   \
    unsigned b0 = cvt_pk_bf16(P[BASE + 4], P[BASE + 5]), b1 = cvt_pk_bf16(P[BASE + 6], P[BASE + 7]);                              \
    auto r0 = __builtin_amdgcn_permlane32_swap(a0, b0, false, false); auto r1 = __builtin_amdgcn_permlane32_swap(a1, b1, false, false); \
    u32x4 w = {r0[0], r1[0], r0[1], r1[1]}; OUT = *reinterpret_cast<bf16x8*>(&w); } while (0)
  PK4(p0, 0, pa0); PK4(p0, 8, pa1); PK4(p1, 0, pa2); PK4(p1, 8, pa3);
#undef PK4
}
__device__ __forceinline__ void qkt(f32x16& p0, f32x16& p1, unsigned kn, unsigned kr, unsigned qrp, const bf16x8 (&qr)[12], int r32, int hi) {
  p0 = f32x16{}; p1 = f32x16{};
  unsigned hb = (unsigned)hi * 16u; asm volatile("" : "+v"(hb));
  const unsigned swn = ((unsigned)r32 & 7u) << 4, swr = (((unsigned)r32 >> 1) & 7u) << 4, an = kn + (unsigned)r32 * 256u, ar = kr + (unsigned)r32 * 128u;
#pragma unroll
  for (int d0 = 0; d0 < 8; ++d0) { const unsigned ad = an + (((unsigned)d0 * 32u + hb) ^ swn);
    const bf16x8 b0 = *(const LAS bf16x8*)(uintptr_t)ad;
    const bf16x8 b1 = *(const LAS bf16x8*)(uintptr_t)(ad + 8192u);
    p0 = __builtin_amdgcn_mfma_f32_32x32x16_bf16(b0, qr[d0], p0, 0, 0, 0);
    p1 = __builtin_amdgcn_mfma_f32_32x32x16_bf16(b1, qr[d0], p1, 0, 0, 0); }
#pragma unroll
  for (int d0 = 0; d0 < 4; ++d0) { const unsigned ad = ar + (((unsigned)d0 * 32u + hb) ^ swr);
    const bf16x8 b0 = *(const LAS bf16x8*)(uintptr_t)ad;
    const bf16x8 b1 = *(const LAS bf16x8*)(uintptr_t)(ad + 4096u);
    p0 = __builtin_amdgcn_mfma_f32_32x32x16_bf16(b0, qr[8 + d0], p0, 0, 0, 0);
    p1 = __builtin_amdgcn_mfma_f32_32x32x16_bf16(b1, qr[8 + d0], p1, 0, 0, 0); }
  (void)qrp;
}
__device__ __forceinline__ int v_st(int k, int c) { const int kk = (k & ~0xC) | ((k & 4) << 1) | ((k & 8) >> 1); return ((kk >> 3) * 4 + (c >> 5)) * 512 + ((kk & 7) * 32 + (c & 31)) * 2; }
__device__ __forceinline__ int v_rd_base(int lane) { return ((lane & 3) << 3) | (((lane >> 2) & 3) << 6) | (((lane >> 4) & 1) << 5) | (((lane >> 5) & 1) << 8); }
constexpr int v_rd_off(int d0, int ks, int half) { return d0 * 512 + ks * 4096 + half * 2048; }
template <int OFF> __device__ __forceinline__ s16x4 tr_read(int vb) {
  s16x4 r; asm volatile("ds_read_b64_tr_b16 %0, %1 offset:%2" : "=&v"(r) : "v"(vb), "i"(OFF) : "memory"); return r;
}
template <int D0> __device__ __forceinline__ void pv_one(f32x16& od, int vb, bf16x8 pa0, bf16x8 pa1, bf16x8 pa2, bf16x8 pa3) {
  const s16x4 l0 = tr_read<v_rd_off(D0, 0, 0)>(vb), h0 = tr_read<v_rd_off(D0, 0, 1)>(vb), l1 = tr_read<v_rd_off(D0, 1, 0)>(vb), h1 = tr_read<v_rd_off(D0, 1, 1)>(vb);
  const s16x4 l2 = tr_read<v_rd_off(D0, 2, 0)>(vb), h2 = tr_read<v_rd_off(D0, 2, 1)>(vb), l3 = tr_read<v_rd_off(D0, 3, 0)>(vb), h3 = tr_read<v_rd_off(D0, 3, 1)>(vb);
  asm volatile("s_waitcnt lgkmcnt(0)" ::: "memory"); SBAR();
#define PK(L, H) (bf16x8){L[0], L[1], L[2], L[3], H[0], H[1], H[2], H[3]}
  od = __builtin_amdgcn_mfma_f32_32x32x16_bf16(pa0, PK(l0, h0), od, 0, 0, 0);
  od = __builtin_amdgcn_mfma_f32_32x32x16_bf16(pa1, PK(l1, h1), od, 0, 0, 0);
  od = __builtin_amdgcn_mfma_f32_32x32x16_bf16(pa2, PK(l2, h2), od, 0, 0, 0);
  od = __builtin_amdgcn_mfma_f32_32x32x16_bf16(pa3, PK(l3, h3), od, 0, 0, 0);
#undef PK
}
__device__ __forceinline__ void pv_d0(f32x16* o, int vb, bf16x8 pa0, bf16x8 pa1, bf16x8 pa2, bf16x8 pa3) {
  pv_one<0>(o[0], vb, pa0, pa1, pa2, pa3); pv_one<1>(o[1], vb, pa0, pa1, pa2, pa3); pv_one<2>(o[2], vb, pa0, pa1, pa2, pa3); pv_one<3>(o[3], vb, pa0, pa1, pa2, pa3);
}
constexpr int BUFB = 40960, OFF_RV = 0, OFF_RKN = 16384, OFF_RKR = 32768, OFF_RWS = 3 * BUFB, OFF_QR = OFF_RWS + 2048  ;
__device__ __forceinline__ void attn_unit(const bf16_t* __restrict__ Qb, const bf16_t* __restrict__ Kh, const bf16_t* __restrict__ Vh, bf16_t* Zp, int seq, LAS unsigned char* lds, int tid_in) {
  int tid = tid_in; asm volatile("" : "+v"(tid));
  const int wid = __builtin_amdgcn_readfirstlane(tid >> 6), lane = tid & 63, r32 = lane & 31, hi = lane >> 5;
  LAS float* wsl = (LAS float*)(lds + OFF_RWS) + wid * 64; LAS float* li_l = wsl; LAS float* al_l = wsl + 32;
  float m_reg = -1e30f, l_reg = 0; f32x16 o[4] = {}; bf16x8 qr[12];
  const bf16_t* Qw = Qb + (size_t)(wid * 32 + r32) * 192 + hi * 8;
#pragma unroll
  for (int d0 = 0; d0 < 12; ++d0) qr[d0] = *(const GAS bf16x8*)(Qw + d0 * 16);
  const unsigned ldsb = (unsigned)(uintptr_t)lds, qrp = ldsb + (unsigned)(OFF_QR + wid * 4096);
  unsigned sov[2], sok[2], sor;
#pragma unroll
  for (int i = 0; i < 2; ++i) {
    { const int c = 2 * wid + i, sub = 2 * c + (lane >> 5), kk = (sub >> 2) * 8 + ((lane & 31) >> 2), k = (kk & ~0xC) | ((kk & 4) << 1) | ((kk & 8) >> 1), col = (sub & 3) * 32 + (lane & 3) * 8;
      sov[i] = (unsigned)(k * 128 + col) * 2u; }
    { const int c = 2 * wid + i, row = 4 * c + (lane >> 4), u = (lane & 15) ^ (row & 7); sok[i] = (unsigned)(row * 384 + u * 16); }
  }
  { const int row = 8 * wid + (lane >> 3), u = (lane & 7) ^ ((row >> 1) & 7); sor = (unsigned)(row * 384 + 256 + u * 16); }
#define DMA(j) do { const int b_ = (j) % 3; const char* vt_ = (const char*)Vh + (size_t)(j) * (64 * 128 * 2); const char* kt_ = (const char*)Kh + (size_t)(j) * (64 * 192 * 2); \
    __builtin_amdgcn_global_load_lds((const unsigned*)(vt_ + sov[0]), (LAS unsigned*)(lds + b_ * BUFB + OFF_RV + (2 * wid) * 1024), 16, 0, 0); \
    __builtin_amdgcn_global_load_lds((const unsigned*)(vt_ + sov[1]), (LAS unsigned*)(lds + b_ * BUFB + OFF_RV + (2 * wid + 1) * 1024), 16, 0, 0); \
    __builtin_amdgcn_global_load_lds((const unsigned*)(kt_ + sok[0]), (LAS unsigned*)(lds + b_ * BUFB + OFF_RKN + (2 * wid) * 1024), 16, 0, 0); \
    __builtin_amdgcn_global_load_lds((const unsigned*)(kt_ + sok[1]), (LAS unsigned*)(lds + b_ * BUFB + OFF_RKN + (2 * wid + 1) * 1024), 16, 0, 0); \
    __builtin_amdgcn_global_load_lds((const unsigned*)(kt_ + sor), (LAS unsigned*)(lds + b_ * BUFB + OFF_RKR + wid * 1024), 16, 0, 0); } while (0)
#define VMW(n) asm volatile("s_waitcnt vmcnt(" #n ")" ::: "memory")
#define BAR() do { asm volatile("" ::: "memory"); __builtin_amdgcn_s_barrier(); asm volatile("" ::: "memory"); } while (0)
#define RESC(a) do { if (__any((a) < 1.f)) { if (hi == 0) al_l[r32] = (a); asm volatile("s_waitcnt lgkmcnt(0)" ::: "memory"); \
    _Pragma("unroll") for (int d = 0; d < 4; ++d) _Pragma("unroll") for (int r = 0; r < 16; ++r) o[d][r] *= al_l[crow(r, hi)]; } } while (0)
#define KN(j) (ldsb + (unsigned)(((j) % 3) * BUFB + OFF_RKN))
#define KRP(j) (ldsb + (unsigned)(((j) % 3) * BUFB + OFF_RKR))
#define VB(j) (vb0 + ((j) % 3) * BUFB)
  const int vb0 = (int)ldsb + OFF_RV + v_rd_base(lane);
  f32x16 pA0, pA1, pB0, pB1; float mnA, mnB, alA, alB; bf16x8 pa0, pa1, pa2, pa3; const int NT = seq / 64;
  DMA(0); DMA(1);
  VMW(5); BAR();
  qkt(pA0, pA1, KN(0), KRP(0), qrp, qr, r32, hi); partialSM(pA0, pA1, m_reg, mnA, alA);
  VMW(0); BAR();
  DMA(2);
  if (wid < 4) {
    for (int j = 1; j + 1 < NT; j += 2) {
      SBAR(); qkt(pB0, pB1, KN(j), KRP(j), qrp, qr, r32, hi);
      finishSM(pA0, pA1, alA, l_reg, pa0, pa1, pa2, pa3); SBAR();
      pv_d0(o, VB(j - 1), pa0, pa1, pa2, pa3); partialSM(pB0, pB1, m_reg, mnB, alB);
      VMW(0); BAR();
      DMA(j + 2);
      RESC(alB);
      SBAR(); qkt(pA0, pA1, KN(j + 1), KRP(j + 1), qrp, qr, r32, hi);
      finishSM(pB0, pB1, alB, l_reg, pa0, pa1, pa2, pa3); SBAR();
      pv_d0(o, VB(j), pa0, pa1, pa2, pa3); partialSM(pA0, pA1, m_reg, mnA, alA);
      VMW(0); BAR();
      if (j + 3 < NT) DMA(j + 3);
      RESC(alA);
    }
  } else {
    for (int j = 1; j + 1 < NT; j += 2) {
      SBAR(); finishSM(pA0, pA1, alA, l_reg, pa0, pa1, pa2, pa3); SBAR();
      pv_d0(o, VB(j - 1), pa0, pa1, pa2, pa3); SBAR();
      qkt(pB0, pB1, KN(j), KRP(j), qrp, qr, r32, hi); partialSM(pB0, pB1, m_reg, mnB, alB);
      VMW(0); BAR();
      DMA(j + 2);
      RESC(alB);
      SBAR(); finishSM(pB0, pB1, alB, l_reg, pa0, pa1, pa2, pa3); SBAR();
      pv_d0(o, VB(j), pa0, pa1, pa2, pa3); SBAR();
      qkt(pA0, pA1, KN(j + 1), KRP(j + 1), qrp, qr, r32, hi); partialSM(pA0, pA1, m_reg, mnA, alA);
      VMW(0); BAR();
      if (j + 3 < NT) DMA(j + 3);
      RESC(alA);
    }
  }
  SBAR(); qkt(pB0, pB1, KN(NT - 1), KRP(NT - 1), qrp, qr, r32, hi);
  finishSM(pA0, pA1, alA, l_reg, pa0, pa1, pa2, pa3); SBAR();
  pv_d0(o, VB(NT - 2), pa0, pa1, pa2, pa3); partialSM(pB0, pB1, m_reg, mnB, alB);
  RESC(alB);
  int r32e = r32, hie = hi; asm volatile("" : "+v"(r32e), "+v"(hie));
  GAS bf16_t* Zw = (GAS bf16_t*)Zp + (size_t)(wid * 32 + 4 * hie) * OD_LD + r32e;
  bf16_t zv[16][4];
#pragma unroll
  for (int r = 0; r < 16; ++r) { const int orow = (r & 3) + 8 * (r >> 2);
#pragma unroll
    for (int d0 = 0; d0 < 4; ++d0) zv[r][d0] = Zw[(size_t)orow * OD_LD + d0 * 32]; }
  SBAR();
  finishSM(pB0, pB1, alB, l_reg, pa0, pa1, pa2, pa3); SBAR();
  pv_d0(o, VB(NT - 1), pa0, pa1, pa2, pa3);
  if (hi == 0) li_l[r32] = l_reg; asm volatile("s_waitcnt lgkmcnt(0)" ::: "memory");
  float rli[16];
#pragma unroll
  for (int r = 0; r < 16; ++r) rli[r] = __builtin_amdgcn_rcpf(li_l[crow(r, hi)]);
#pragma unroll
  for (int r = 0; r < 16; ++r) { const int orow = (r & 3) + 8 * (r >> 2);
#pragma unroll
    for (int d0 = 0; d0 < 4; ++d0) Zw[(size_t)orow * OD_LD + d0 * 32] = f2bf(o[d0][r] * rli[r] * bf1(zv[r][d0])); }
  VMW(0); BAR();
#undef DMA
#undef VMW
#undef BAR
#undef RESC
#undef KN
#undef KRP
#undef VB
}
}

__device__ __forceinline__ void conv_rowgroup(bf16_t* EV, const float* cw, int rg, int lane) {
    const int r0 = rg * 4, s0 = r0 % SB; const bool hp = (s0 != 0 && s0 != CTXL), hn = (s0 + 3 != CTXL - 1 && s0 + 3 != SB - 1);
    bf16_t* er = EV + (size_t)r0 * EV_LD;
#pragma unroll
    for (int jj = 0; jj < 2; ++jj) { const int c = jj * 512 + lane * 8; const u32x4 z4 = (u32x4){0u, 0u, 0u, 0u};
        u32x4 pw_[6], gw_[4];
        pw_[0] = hp ? *(const GAS u32x4*)(er - EV_LD + 2048 + c) : z4;
#pragma unroll
        for (int i = 0; i < 4; ++i) { pw_[1 + i] = *(const GAS u32x4*)(er + (size_t)i * EV_LD + 2048 + c); gw_[i] = *(const GAS u32x4*)(er + (size_t)i * EV_LD + c); }
        pw_[5] = hn ? *(const GAS u32x4*)(er + (size_t)4 * EV_LD + 2048 + c) : z4;
        const f32x4 w00 = *(const GAS f32x4*)(cw + c), w01 = *(const GAS f32x4*)(cw + c + 4), w10 = *(const GAS f32x4*)(cw + 1024 + c), w11 = *(const GAS f32x4*)(cw + 1024 + c + 4),
                    w20 = *(const GAS f32x4*)(cw + 2048 + c), w21 = *(const GAS f32x4*)(cw + 2048 + c + 4);
        f32x4 p[6][2];
#pragma unroll
        for (int i = 0; i < 6; ++i) unpack8(pw_[i], p[i][0], p[i][1]);
#pragma unroll
        for (int i = 0; i < 4; ++i) { f32x4 g0, g1; unpack8(gw_[i], g0, g1);
            *(GAS u32x4*)(er + (size_t)i * EV_LD + c) = pack8(g0 * (p[i][0] * w00 + p[i + 1][0] * w10 + p[i + 2][0] * w20), g1 * (p[i][1] * w01 + p[i + 1][1] * w11 + p[i + 2][1] * w21)); } }
}

namespace msc {
using att::f32x16; using att::s16x4; using att::crow; using att::v_st; using att::v_rd_base; using att::v_rd_off; using att::tr_read;
constexpr int CL = 32, NCH = SB / CL;
constexpr int BUF = 40960, O_Q = 0, O_K = 16384, O_V = 32768, O_KW = 81920, O_X = 98304, O_A = 114688, O_G = O_A + 9216, O_M = O_G + 9216, O_MP = O_M + 9216, O_N = 142848, O_QN = 144896, O_PW = 145408, O_PST = 148480, O_RS = 156672;
#define PK4(P, BASE, OUT) do { unsigned a0 = cvt_pk_bf16(P[BASE + 0], P[BASE + 1]), a1 = cvt_pk_bf16(P[BASE + 2], P[BASE + 3]);   \
    unsigned b0 = cvt_pk_bf16(P[BASE + 4], P[BASE + 5]), b1 = cvt_pk_bf16(P[BASE + 6], P[BASE + 7]);                              \
    auto r0 = __builtin_amdgcn_permlane32_swap(a0, b0, false, false); auto r1 = __builtin_amdgcn_permlane32_swap(a1, b1, false, false); \
    u32x4 w = {r0[0], r1[0], r0[1], r1[1]}; OUT = *reinterpret_cast<bf16x8*>(&w); } while (0)
#define PKLH(L, H) (bf16x8){L[0], L[1], L[2], L[3], H[0], H[1], H[2], H[3]}
__device__ __forceinline__ void scan_item(const bf16_t* evb  , const float* gb  , bf16_t* hfb  ,
                                          int head, int dh, LAS unsigned char* lds, int wave0, bf16_t* EVall, const float* cw, int cgw, int cngw) {
  int tid; asm volatile("v_mbcnt_lo_u32_b32 %0, -1, 0\n\tv_mbcnt_hi_u32_b32 %0, -1, %0" : "=v"(tid)); tid += wave0 * 64;
  const int tid_o = tid; const int wid = wave0, lane = tid & 63, r32 = lane & 31, hi = lane >> 5, kh = wid >> 2, dq = wid & 3; (void)r32; (void)hi;
  const unsigned ldsb = (unsigned)(uintptr_t)lds;
  LAS float* aS = (LAS float*)(lds + O_A); LAS float* gT = (LAS float*)(lds + O_G); LAS float* mT = (LAS float*)(lds + O_M); LAS float* mP = (LAS float*)(lds + O_MP);
  LAS float* nbuf = (LAS float*)(lds + O_N); LAS float* qnS = (LAS float*)(lds + O_QN); LAS float* pw = (LAS float*)(lds + O_PW) + wid * 96;
  LAS float* xch = (LAS float*)(lds + O_X) + dq * 1024; LAS float* rsS = (LAS float*)(lds + O_RS);
#define BARX() do { asm volatile("" ::: "memory"); __builtin_amdgcn_s_barrier(); asm volatile("" ::: "memory"); } while (0)
#define LGK0() do { asm volatile("s_waitcnt lgkmcnt(0)" ::: "memory"); __builtin_amdgcn_sched_barrier(0); } while (0)
  for (int dir = 0; dir < 2; ++dir) {
    asm volatile("s_waitcnt vmcnt(0) lgkmcnt(0)" ::: "memory"); BARX();
    {
      LAS float* rawI = (LAS float*)lds; LAS float* rawF = rawI + SB; LAS float* Bc = rawF + SB; LAS float* CMc = Bc + 128;
      {
        float ipv[5], fpv[5];
#pragma unroll
        for (int i = 0; i < 5; ++i) { const int jx = tid + 512 * i; ipv[i] = 0.f; fpv[i] = 0.f;
          if (jx < SB) { const int srow = dir == 0 ? jx : (jx < CTXL ? CTXL - 1 - jx : SB - 1 - (jx - CTXL)); const GAS float* gr = (const GAS float*)gb + (size_t)srow * 16 + dir * 8; ipv[i] = gr[head]; fpv[i] = gr[4 + head]; } }
#pragma unroll
        for (int i = 0; i < 5; ++i) { const int jx = tid + 512 * i; if (jx < SB) { rawI[jx] = ipv[i]; rawF[jx] = fminf(fpv[i], 0.f) - __logf(1.0f + __expf(-fabsf(fpv[i]))); } }
      }
      if (tid < 256) { nbuf[tid] = 0.f; nbuf[256 + tid] = 0.f; }
      LGK0(); BARX();
      for (int c = wid; c < NCH; c += 8) {
        const int l5 = lane & 31; const float ip = rawI[c * CL + l5]; float bsum = rawF[c * CL + l5];
#pragma unroll
        for (int o = 1; o < 32; o <<= 1) { const float t = __shfl_up(bsum, o, 32); if (l5 >= o) bsum += t; }
        const float a = ip - bsum; float cm = a;
#pragma unroll
        for (int o = 1; o < 32; o <<= 1) { const float t = __shfl_up(cm, o, 32); if (l5 >= o) cm = fmaxf(cm, t); }
        if (lane < 32) { aS[c * CL + l5] = a; gT[c * CL + l5] = cm; mT[c * CL + l5] = bsum; }
        if (lane == 31) { Bc[c] = bsum; CMc[c] = cm; }
      }
      LGK0(); BARX();
      if (tid == 0) { float mp = -1e30f; for (int c = 0; c < NCH; ++c) { mP[c] = mp; mp = Bc[c] + fmaxf(mp, CMc[c]); } }
      LGK0(); BARX();
      for (int jx = tid; jx < SB; jx += 512) { const float g = fmaxf(mP[jx >> 5], gT[jx]); gT[jx] = g; mT[jx] = mT[jx] + g; }
      LGK0(); BARX();
    }
    unsigned soq[2], sov;
#pragma unroll
    for (int i = 0; i < 2; ++i) { const int c2 = 2 * wid + i, t = 2 * c2 + (lane >> 5), u = (lane & 31) ^ (t & 15), ro = dir ? 31 - t : t; soq[i] = (unsigned)(ro * EV_LD * 2 + u * 16); }
    { const int sub = 2 * wid + (lane >> 5), kk = (sub >> 2) * 8 + ((lane & 31) >> 2), s_ = (kk & ~0xC) | ((kk & 4) << 1) | ((kk & 8) >> 1), col = (sub & 3) * 32 + (lane & 3) * 8, ro = dir ? 31 - s_ : s_;
      sov = (unsigned)(ro * EV_LD * 2 + col * 2); }
#define SLO(c) (dir == 0 ? (c) * CL : ((c) * CL < CTXL ? CTXL - CL - (c) * CL : SB - CL - ((c) * CL - CTXL)))
#define DMA(c) do { const int b_ = (c) & 1; const char* rb_ = (const char*)(evb + (size_t)SLO(c) * EV_LD); \
    const char* qb_ = rb_ + (3072 + head * 256) * 2; const char* kb_ = rb_ + (4096 + head * 256) * 2; const char* vb_ = rb_ + (5120 + head * 256 + dh * 128) * 2; \
    __builtin_amdgcn_global_load_lds((const unsigned*)(qb_ + soq[0]), (LAS unsigned*)(lds + b_ * BUF + O_Q + (2 * wid) * 1024), 16, 0, 0); \
    __builtin_amdgcn_global_load_lds((const unsigned*)(qb_ + soq[1]), (LAS unsigned*)(lds + b_ * BUF + O_Q + (2 * wid + 1) * 1024), 16, 0, 0); \
    __builtin_amdgcn_global_load_lds((const unsigned*)(kb_ + soq[0]), (LAS unsigned*)(lds + b_ * BUF + O_K + (2 * wid) * 1024), 16, 0, 0); \
    __builtin_amdgcn_global_load_lds((const unsigned*)(kb_ + soq[1]), (LAS unsigned*)(lds + b_ * BUF + O_K + (2 * wid + 1) * 1024), 16, 0, 0); \
    __builtin_amdgcn_global_load_lds((const unsigned*)(vb_ + sov), (LAS unsigned*)(lds + b_ * BUF + O_V + wid * 1024), 16, 0, 0); } while (0)
    f32x16 C[4] = {};
    float nv[4] = {0.f, 0.f, 0.f, 0.f};
    const bf16x8 ones8 = {0x3F80, 0x3F80, 0x3F80, 0x3F80, 0x3F80, 0x3F80, 0x3F80, 0x3F80};
    DMA(0); DMA(1);
    asm volatile("s_waitcnt vmcnt(5)" ::: "memory"); BARX();
    for (int c = 0; c < NCH; ++c) {
      int tid = tid_o; asm volatile("" : "+v"(tid));
      const int lane = tid & 63, r32 = lane & 31, hi = lane >> 5, dcol = head * 256 + dh * 128 + dq * 32 + r32;
      if (cgw >= 0 && (c & 15) == 0) {
        const int rg = cgw + (dir * 5 + (c >> 4)) * cngw; if (rg < TOK / 4) conv_rowgroup(EVall, cw, rg, lane); }
      const unsigned tb = ldsb + (unsigned)((c & 1) * BUF);
      const float mprev = mP[c], glast = gT[c * CL + CL - 1];
      const float decay = __expf(mprev - glast);
      const unsigned rb = (unsigned)r32 * 512u, sw = ((unsigned)r32 & 15u) << 4; unsigned hb = (unsigned)hi * 16u; asm volatile("" : "+v"(hb));
      const int slo = SLO(c);
      unsigned pf_h[16], pf_o[16];
      if (dir == 1 && kh == 0) {
        const char* hb_ = (const char*)(hfb + (size_t)slo * DM); const char* ob_ = (const char*)(evb + (size_t)slo * EV_LD + 1024);
        const unsigned ho = (unsigned)((31 - 4 * hi) * DM + dcol) * 2u, oo = (unsigned)((31 - 4 * hi) * EV_LD + dcol) * 2u;
#pragma unroll
        for (int r = 0; r < 16; ++r) { const int tc = (r & 3) + 8 * (r >> 2);
          pf_h[r] = *(const GAS bf16_t*)(hb_ + (ho - (unsigned)(tc * DM * 2))); pf_o[r] = *(const GAS bf16_t*)(ob_ + (oo - (unsigned)(tc * EV_LD * 2))); }
      }
      if (kh == 1) {
        f32x16 pe = {}, po = {};
#pragma unroll
        for (int kk = 0; kk < 16; kk += 2) { const unsigned ad0 = tb + rb + (((unsigned)kk * 32u + hb) ^ sw), ad1 = tb + rb + (((unsigned)(kk + 1) * 32u + hb) ^ sw);
          const bf16x8 kf0 = *(const LAS bf16x8*)(uintptr_t)(ad0 + O_K), qf0 = *(const LAS bf16x8*)(uintptr_t)(ad0 + O_Q);
          const bf16x8 kf1 = *(const LAS bf16x8*)(uintptr_t)(ad1 + O_K), qf1 = *(const LAS bf16x8*)(uintptr_t)(ad1 + O_Q);
          pe = __builtin_amdgcn_mfma_f32_32x32x16_bf16(kf0, qf0, pe, 0, 0, 0);
          po = __builtin_amdgcn_mfma_f32_32x32x16_bf16(kf1, qf1, po, 0, 0, 0); }
        f32x16 p = pe + po;
        const float gt = gT[c * CL + r32]; float rowsum = 0.f;
#pragma unroll
        for (int r4 = 0; r4 < 4; ++r4) { const f32x4 a4 = *(const LAS f32x4*)(aS + c * CL + 8 * r4 + 4 * hi);
#pragma unroll
          for (int e = 0; e < 4; ++e) { const int sidx = 8 * r4 + 4 * hi + e; const float w = (sidx <= r32) ? __expf(a4[e] - gt) : 0.f; p[4 * r4 + e] *= w; rowsum += p[4 * r4 + e]; } }
        { auto rr = __builtin_amdgcn_permlane32_swap(__float_as_uint(rowsum), __float_as_uint(rowsum), false, false); rowsum = __uint_as_float(rr[0]) + __uint_as_float(rr[1]); }
        bf16x8 pa0, pa1; PK4(p, 0, pa0); PK4(p, 8, pa1);
        *(LAS bf16x8*)(lds + O_PST + (dq * 2 + 0) * 1024 + lane * 16) = pa0; *(LAS bf16x8*)(lds + O_PST + (dq * 2 + 1) * 1024 + lane * 16) = pa1;
        if (hi == 0) rsS[dq * 32 + r32] = rowsum;
      } else {
        { const int s_ = tid >> 3, cb = (tid & 7) * 8; const float wt = __expf(aS[c * CL + s_] - glast);
#pragma unroll
          for (int h4 = 0; h4 < 4; ++h4) { const int c8 = cb + 64 * h4; f32x4 x0, x1;
            unpack8(*(const LAS u32x4*)(uintptr_t)(tb + O_K + (unsigned)s_ * 512u + ((unsigned)(c8 * 2) ^ (((unsigned)s_ & 15u) << 4))), x0, x1);
            *(LAS u32x4*)(lds + O_KW + (c8 >> 7) * 8192 + v_st(s_, c8 & 127)) = pack8(x0 * wt, x1 * wt); } }
        { const int t_ = tid >> 3, part = tid & 7; const LAS float* nb = nbuf + (c & 1) * 256 + part * 32; float acc = 0.f;
#pragma unroll
          for (int e = 0; e < 4; ++e) { f32x4 x0, x1; unpack8(*(const LAS u32x4*)(uintptr_t)(tb + O_Q + (unsigned)t_ * 512u + ((unsigned)(part * 64 + e * 16) ^ (((unsigned)t_ & 15u) << 4))), x0, x1);
            const f32x4 n0 = *(const LAS f32x4*)(nb + e * 8), n1 = *(const LAS f32x4*)(nb + e * 8 + 4);
            acc += x0[0] * n0[0] + x0[1] * n0[1] + x0[2] * n0[2] + x0[3] * n0[3] + x1[0] * n1[0] + x1[1] * n1[1] + x1[2] * n1[2] + x1[3] * n1[3]; }
          acc += __shfl_xor(acc, 1); acc += __shfl_xor(acc, 2); acc += __shfl_xor(acc, 4);
          if (part == 0) qnS[t_] = acc; }
      }
      LGK0(); BARX();
      f32x16 aq0 = {}, aq1 = {};
#pragma unroll
      for (int j = 0; j < 8; ++j) { const unsigned ad = tb + O_Q + rb + (((unsigned)(8 * kh + j) * 32u + hb) ^ sw);
        const bf16x8 qf = *(const LAS bf16x8*)(uintptr_t)ad; bf16x8 cf;
        if ((j & 1) == 0) { PK4(C[j >> 1], 0, cf); aq0 = __builtin_amdgcn_mfma_f32_32x32x16_bf16(qf, cf, aq0, 0, 0, 0); }
        else { PK4(C[j >> 1], 8, cf); aq1 = __builtin_amdgcn_mfma_f32_32x32x16_bf16(qf, cf, aq1, 0, 0, 0); } }
      f32x16 aqc = aq0 + aq1;
      const int vbase = (int)(tb + O_V) + v_rd_base(lane) + dq * 512;
      const int kwb = (int)(ldsb + O_KW + kh * 8192) + v_rd_base(lane);
      const s16x4 vl0 = tr_read<v_rd_off(0, 0, 0)>(vbase), vh0 = tr_read<v_rd_off(0, 0, 1)>(vbase), vl1 = tr_read<v_rd_off(0, 1, 0)>(vbase), vh1 = tr_read<v_rd_off(0, 1, 1)>(vbase);
      const s16x4 a0l0 = tr_read<v_rd_off(0, 0, 0)>(kwb), a0h0 = tr_read<v_rd_off(0, 0, 1)>(kwb), a0l1 = tr_read<v_rd_off(0, 1, 0)>(kwb), a0h1 = tr_read<v_rd_off(0, 1, 1)>(kwb);
      const s16x4 a1l0 = tr_read<v_rd_off(1, 0, 0)>(kwb), a1h0 = tr_read<v_rd_off(1, 0, 1)>(kwb), a1l1 = tr_read<v_rd_off(1, 1, 0)>(kwb), a1h1 = tr_read<v_rd_off(1, 1, 1)>(kwb);
      const s16x4 a2l0 = tr_read<v_rd_off(2, 0, 0)>(kwb), a2h0 = tr_read<v_rd_off(2, 0, 1)>(kwb), a2l1 = tr_read<v_rd_off(2, 1, 0)>(kwb), a2h1 = tr_read<v_rd_off(2, 1, 1)>(kwb);
      const s16x4 a3l0 = tr_read<v_rd_off(3, 0, 0)>(kwb), a3h0 = tr_read<v_rd_off(3, 0, 1)>(kwb), a3l1 = tr_read<v_rd_off(3, 1, 0)>(kwb), a3h1 = tr_read<v_rd_off(3, 1, 1)>(kwb);
      bf16x8 pa0 = {}, pa1 = {};
      if (kh == 0) { pa0 = *(const LAS bf16x8*)(lds + O_PST + (dq * 2 + 0) * 1024 + lane * 16); pa1 = *(const LAS bf16x8*)(lds + O_PST + (dq * 2 + 1) * 1024 + lane * 16); }
      LGK0();
      const bf16x8 vf0 = PKLH(vl0, vh0), vf1 = PKLH(vl1, vh1);
      const bf16x8 kwf[4][2] = {{PKLH(a0l0, a0h0), PKLH(a0l1, a0h1)}, {PKLH(a1l0, a1h0), PKLH(a1l1, a1h1)}, {PKLH(a2l0, a2h0), PKLH(a2l1, a2h1)}, {PKLH(a3l0, a3h0), PKLH(a3l1, a3h1)}};
      f32x16 asv = {};
      if (kh == 0) {
        asv = __builtin_amdgcn_mfma_f32_32x32x16_bf16(pa0, vf0, asv, 0, 0, 0);
        asv = __builtin_amdgcn_mfma_f32_32x32x16_bf16(pa1, vf1, asv, 0, 0, 0);
        const float ai = __expf(mprev - gT[c * CL + r32]);
        pw[r32] = rsS[dq * 32 + r32] + ai * qnS[r32]; pw[32 + r32] = ai; pw[64 + r32] = __expf(-mT[c * CL + r32]);
      } else {
#pragma unroll
        for (int r = 0; r < 16; ++r) xch[r * 64 + lane] = aqc[r];
      }
#pragma unroll
      for (int i = 0; i < 4; ++i) {
#pragma unroll
        for (int r = 0; r < 16; ++r) C[i][r] *= decay;
        C[i] = __builtin_amdgcn_mfma_f32_32x32x16_bf16(kwf[i][0], vf0, C[i], 0, 0, 0);
        C[i] = __builtin_amdgcn_mfma_f32_32x32x16_bf16(kwf[i][1], vf1, C[i], 0, 0, 0);
        if (dq == 0) {
          f32x16 na = {}; na = __builtin_amdgcn_mfma_f32_32x32x16_bf16(ones8, kwf[i][0], na, 0, 0, 0); na = __builtin_amdgcn_mfma_f32_32x32x16_bf16(ones8, kwf[i][1], na, 0, 0, 0);
          nv[i] = decay * nv[i] + na[0];
          if (hi == 0) nbuf[((c + 1) & 1) * 256 + kh * 128 + i * 32 + r32] = nv[i]; }
      }
      asm volatile("s_waitcnt vmcnt(0) lgkmcnt(0)" ::: "memory"); BARX();
      if (dir == 1 && kh == 0) {
#pragma unroll
        for (int r = 0; r < 16; ++r) asm volatile("" : "+v"(pf_h[r]), "+v"(pf_o[r]));
      }
      if (c + 2 < NCH) DMA(c + 2);
      if (kh == 0) {
        float hvs[16];
#pragma unroll
        for (int r4 = 0; r4 < 4; ++r4) {
          const f32x4 dn = *(const LAS f32x4*)(pw + 8 * r4 + 4 * hi), ai4 = *(const LAS f32x4*)(pw + 32 + 8 * r4 + 4 * hi), em4 = *(const LAS f32x4*)(pw + 64 + 8 * r4 + 4 * hi);
#pragma unroll
          for (int e = 0; e < 4; ++e) { const int r = 4 * r4 + e;
            hvs[r] = (asv[r] + ai4[e] * (aqc[r] + xch[r * 64 + lane])) * __builtin_amdgcn_rcpf(fmaxf(fabsf(dn[e]), em4[e])); }
        }
        if (dir == 0) {
          char* hb_ = (char*)(hfb + (size_t)slo * DM); const unsigned ho = (unsigned)((4 * hi) * DM + dcol) * 2u;
#pragma unroll
          for (int r = 0; r < 16; ++r) { const int tc = (r & 3) + 8 * (r >> 2); *(GAS bf16_t*)(hb_ + (ho + (unsigned)(tc * DM * 2))) = f2bf(hvs[r]); }
        } else {
          char* ob_ = (char*)((bf16_t*)evb + (size_t)slo * EV_LD + 1024); const unsigned oo = (unsigned)((31 - 4 * hi) * EV_LD + dcol) * 2u;
#pragma unroll
          for (int r = 0; r < 16; ++r) { const int tc = (r & 3) + 8 * (r >> 2); *(GAS bf16_t*)(ob_ + (oo - (unsigned)(tc * EV_LD * 2))) = f2bf(bflo(pf_o[r]) * (bflo(pf_h[r]) + hvs[r])); }
        }
      }
    }
#undef DMA
#undef SLO
  }
  asm volatile("s_waitcnt vmcnt(0) lgkmcnt(0)" ::: "memory"); BARX();
#undef BARX
#undef LGK0
}
#undef PK4
#undef PKLH
}

struct Params { const float* in[18]; float* out; unsigned char* ws; };
constexpr int LDS_BYTES = 163840, LDS_CTL = 162816, MISC_OFF = LDS_CTL + 320;

template <int MID> __device__ __forceinline__ int wmap(int n) {
    if (MID == 0) {
        const int pn = n >> 8, lc = n & 255, bj = lc >> 7, c = lc & 127;
        if (pn < 8)  return (bj ? 3072 : 0) + 128 * pn + c;
        if (pn < 16) return (bj ? 8192 : 7168) + 128 * (pn - 8) + c;
        if (pn < 24) return (bj ? 2048 : 1024) + 128 * (pn - 16) + c;
        if (pn < 36) return 4096 + 256 * (pn - 24) + lc;
        return lc < 16 ? 9216 + lc : -1;
    } else if (MID == 2) {
        if (n < 2048) return 704 + n;
        return (n - 2048 < 704) ? n - 2048 : -1;
    } else if (MID == 3) {
        const int pn = n >> 8, lc = n & 255;
        if (pn < 8) return (n >> 7) * 192 + (n & 127);
        const int bj = lc >> 7, hh = (lc & 127) >> 5, i = lc & 31;
        return (4 * (pn - 8) + hh) * 192 + 128 + 32 * bj + i;
    }
    return n;
}
template <int MID> __device__ __forceinline__ void wconv_item(const float* W, int K, int NS, bf16_t* WT, int nblk, const float* kscale, LAS float* scr, int item, int lane) {
    const int kb = item / nblk, nb = item % nblk, k0 = 64 * kb, n0 = 32 * nb;
    const int src = wmap<MID>(n0 + (lane & 31));
    const float cs = (MID == 0 && src >= 5120 && src < 6144) ? 0.0625f : 1.0f;
    float wv[32];
#pragma unroll
    for (int i = 0; i < 32; ++i) { const int kk = 2 * i + (lane >> 5); wv[i] = (src >= 0) ? ((const GAS float*)W)[(size_t)(k0 + kk) * NS + src] : 0.f; }
#pragma unroll
    for (int i = 0; i < 32; ++i) { const int kk = 2 * i + (lane >> 5); float v = wv[i] * cs; if (kscale) v *= ((const GAS float*)kscale)[k0 + kk];
        scr[kk * 33 + (lane & 31)] = v; }
    LDS_WAIT(); asm volatile("" ::: "memory");
    const int c = lane & 7;
#pragma unroll
    for (int j = 0; j < 4; ++j) { const int n = (lane >> 3) + 8 * j; const LAS float* s = scr + (8 * c) * 33 + n;
        u32x4 o; o.x = cvt_pk_bf16(s[0 * 33], s[1 * 33]); o.y = cvt_pk_bf16(s[2 * 33], s[3 * 33]); o.z = cvt_pk_bf16(s[4 * 33], s[5 * 33]); o.w = cvt_pk_bf16(s[6 * 33], s[7 * 33]);
        *(GAS u32x4*)(WT + (size_t)(n0 + n) * K + k0 + 8 * c) = o; }
    LDS_WAIT(); asm volatile("" ::: "memory");
}

constexpr int PTR_OFF = LDS_CTL + 512;
__device__ __forceinline__ const float* inp(LAS unsigned char* lds, int i) {
    unsigned off = (unsigned)(PTR_OFF + 8 * i); asm volatile("" : "+s"(off));
    volatile LAS unsigned* t = (volatile LAS unsigned*)(lds + off);
    const unsigned lo = __builtin_amdgcn_readfirstlane(t[0]), hi = __builtin_amdgcn_readfirstlane(t[1]);
    return (const float*)(((unsigned long long)hi << 32) | lo);
}
#define PH_BEGIN int tid; asm volatile("v_mbcnt_lo_u32_b32 %0, -1, 0\n\tv_mbcnt_hi_u32_b32 %0, -1, %0" : "=v"(tid)); tid += wave0 * 64; unsigned char* ws = ws0; unsigned char* dob = dob0; asm volatile("" : "+v"(tid), "+s"(ws), "+s"(dob)); \
    const int lane = tid & 63, wave = __builtin_amdgcn_readfirstlane(tid >> 6), G = gridDim.x, bx = blockIdx.x, vcu = (G % 8 == 0) ? (bx % 8) * (G / 8) + bx / 8 : bx, gw = vcu * 8 + wave, NGW = G * 8; \
    (void)lane; (void)wave; (void)gw; (void)NGW; (void)vcu; \
    bf16_t* U = (bf16_t*)(dob + DO_U); bf16_t* H = (bf16_t*)(ws + WS_H); bf16_t* BIG = (bf16_t*)(ws + WS_BIG); float* modv = (float*)(dob + DO_MODV); \
    (void)U; (void)H; (void)BIG; (void)modv;

template <bool FINAL>
__device__ __forceinline__ void ln_phase(bf16_t* H, bf16_t* U, float* outp, const float* ln_g, const float* ln_b, const float* modn, int gw, int NGW, int lane, unsigned tmo) {
    for (int rg = gw; rg < TOK / 4; rg += NGW) {
        const int r0 = rg * 4, b = r0 / SB, s0 = r0 % SB, midx = (s0 < CTXL) ? 32 : b;
        if (FINAL && s0 < CTXL) continue;
        bf16_t* hr = H + (size_t)r0 * DM;
        f32x4 v[4][2][2]; float sm[4], sq[4];
#pragma unroll
        for (int i = 0; i < 4; ++i)
#pragma unroll
            for (int jj = 0; jj < 2; ++jj) unpack8(*(const GAS u32x4*)(hr + (size_t)i * DM + jj * 512 + lane * 8), v[i][jj][0], v[i][jj][1]);
#pragma unroll
        for (int i = 0; i < 4; ++i) { sm[i] = 0.f;
#pragma unroll
            for (int jj = 0; jj < 2; ++jj)
#pragma unroll
                for (int q = 0; q < 2; ++q) sm[i] += (v[i][jj][q][0] + v[i][jj][q][1]) + (v[i][jj][q][2] + v[i][jj][q][3]); }
#pragma unroll
        for (int o = 1; o < 64; o <<= 1)
#pragma unroll
            for (int i = 0; i < 4; ++i) sm[i] += __shfl_xor(sm[i], o);
#pragma unroll
        for (int i = 0; i < 4; ++i) { const float mean = sm[i] * (1.0f / DM); sq[i] = 0.f;
#pragma unroll
            for (int jj = 0; jj < 2; ++jj)
#pragma unroll
                for (int q = 0; q < 2; ++q) { v[i][jj][q] = v[i][jj][q] - mean; sq[i] += (v[i][jj][q][0] * v[i][jj][q][0] + v[i][jj][q][1] * v[i][jj][q][1]) + (v[i][jj][q][2] * v[i][jj][q][2] + v[i][jj][q][3] * v[i][jj][q][3]); } }
#pragma unroll
        for (int o = 1; o < 64; o <<= 1)
#pragma unroll
            for (int i = 0; i < 4; ++i) sq[i] += __shfl_xor(sq[i], o);
        const float* mv = FINAL ? nullptr : modn + (size_t)midx * 3072;
#pragma unroll
        for (int jj = 0; jj < 2; ++jj) { const int c = jj * 512 + lane * 8;
            f32x4 gg[2], bb[2], sh[2], sc[2];
#pragma unroll
            for (int q = 0; q < 2; ++q) { gg[q] = *(const GAS f32x4*)(ln_g + c + 4 * q); bb[q] = *(const GAS f32x4*)(ln_b + c + 4 * q);
                if (!FINAL) { sh[q] = *(const GAS f32x4*)(mv + c + 4 * q); sc[q] = *(const GAS f32x4*)(mv + 1024 + c + 4 * q) + 1.0f; } }
#pragma unroll
            for (int i = 0; i < 4; ++i) { const float rstd = 1.0f / sqrtf(sq[i] * (1.0f / DM) + LN_EPS);
                f32x4 y0 = v[i][jj][0] * rstd * gg[0] + bb[0], y1 = v[i][jj][1] * rstd * gg[1] + bb[1];
                if (!FINAL) { *(GAS u32x4*)(hr + (size_t)i * DM + c) = pack8(y0, y1); *(GAS u32x4*)(U + (size_t)(r0 + i) * DM + c) = pack8(y0 * sc[0] + sh[0], y1 * sc[1] + sh[1]); }
                else { float* op = outp + ((size_t)b * SEQ + (s0 + i - CTXL)) * DM + c;
                    if (tmo) { const float qn = __builtin_nanf(""); y0 = (f32x4){qn, qn, qn, qn}; y1 = y0; }
                    *(GAS f32x4*)op = y0; *(GAS f32x4*)(op + 4) = y1; } }
        }
    }
}

__global__ void __launch_bounds__(512, 2) fwd_kernel(Params p) {
    extern __shared__ __attribute__((aligned(16))) unsigned char lds_raw[];
    LAS unsigned char* lds = (LAS unsigned char*)lds_raw;
    const int tid0 = threadIdx.x;
    volatile LAS unsigned* MISC = (volatile LAS unsigned*)(lds + MISC_OFF);
    for (int u = tid0; u < (LDS_BYTES - LDS_CTL) / 4; u += 512) ((LAS unsigned*)(lds + LDS_CTL))[u] = 0u;
    __syncthreads();
    if (tid0 < 18) { const unsigned long long a = (unsigned long long)p.in[tid0]; volatile LAS unsigned* t = (volatile LAS unsigned*)(lds + PTR_OFF); t[2 * tid0] = (unsigned)a; t[2 * tid0 + 1] = (unsigned)(a >> 32); }
    __syncthreads();
    unsigned char* const ws0 = p.ws; unsigned char* const dob0 = (unsigned char*)p.out;
    const int wave0 = __builtin_amdgcn_readfirstlane(tid0 >> 6);
    (void)xcd_barrier_post((unsigned*)(ws0 + WS_CTL) + 4096, MISC + 8);
#define GRID_BAR() do { XcdBarrier b2_; b2_.bar = (unsigned*)(ws0 + WS_CTL) + 4096; asm volatile("" : "+s"(b2_.bar)); b2_.x = xb_xcc_id(); b2_.st = (volatile LAS unsigned*)(lds + MISC_OFF) + 8; xcd_barrier(b2_); } while (0)

    {
        PH_BEGIN
        LAS float* scr = (LAS float*)(lds + wave * 16384);
        for (int j = 0; j < 2; ++j) {
            unsigned char* wb = dob + DO_W + (size_t)j * W_PAIR;
            { const float* w = inp(lds, 8) + (size_t)j * 1024 * 9232; for (int it = gw; it < 16 * 296; it += NGW) wconv_item<0>(w, 1024, 9232, (bf16_t*)(wb + W_EVIN), 296, nullptr, scr, it, lane); }
            { const float* w = inp(lds, 11) + (size_t)j * 2048 * 1024; for (int it = gw; it < 32 * 32; it += NGW)  wconv_item<1>(w, 2048, 1024, (bf16_t*)(wb + W_EVOUT), 32, nullptr, scr, it, lane); }
            { const float* w = inp(lds, 12) + (size_t)j * 1024 * 2752; for (int it = gw; it < 16 * 88; it += NGW)  wconv_item<2>(w, 1024, 2752, (bf16_t*)(wb + W_ODIN), 88, nullptr, scr, it, lane); }
            { const float* w = inp(lds, 14) + (size_t)j * 384 * 3072; const float* ks = inp(lds, 13) + j * 384; for (int it = gw; it < 6 * 96; it += NGW)   wconv_item<3>(w, 384, 3072, (bf16_t*)(wb + W_UQ), 96, ks, scr, it, lane); }
            { const float* w = inp(lds, 16) + (size_t)j * 256 * 4096; const float* ks = inp(lds, 15) + j * 256; for (int it = gw; it < 4 * 128; it += NGW)  wconv_item<1>(w, 256, 4096, (bf16_t*)(wb + W_UKV), 128, ks, scr, it, lane); }
            { const float* w = inp(lds, 17) + (size_t)j * 2048 * 1024; for (int it = gw; it < 32 * 32; it += NGW)  wconv_item<1>(w, 2048, 1024, (bf16_t*)(wb + W_ODOUT), 32, nullptr, scr, it, lane); }
        }
        __syncthreads();
        {
            const float* cvec = inp(lds, 1); const float* cctx = inp(lds, 3); const float* mod_w = inp(lds, 4); const float* mod_b = inp(lds, 5);
            LAS float* Ssil = (LAS float*)lds;
            LAS float* red = (LAS float*)(lds + 33 * 128 * 4);
            const int cl = tid & 127, kq = tid >> 7;
            for (int it = bx; it < 4 * 24; it += G) {
                const int L = it / 24, n0 = (it % 24) * 128;
                float a[33];
#pragma unroll
                for (int r = 0; r < 33; ++r) a[r] = 0.f;
                for (int kc = 0; kc < 8; ++kc) {
                    __syncthreads();
                    for (int e = tid; e < 33 * 128; e += 512) { const int r = e >> 7, k = kc * 128 + (e & 127); const float v = (r < 32) ? ((const GAS float*)cvec)[r * 1024 + k] : ((const GAS float*)cctx)[k]; Ssil[e] = fsilu(v); }
                    __syncthreads();
                    float wv[32];
#pragma unroll
                    for (int k2 = 0; k2 < 32; ++k2) wv[k2] = ((const GAS float*)mod_w)[((size_t)L * 1024 + kc * 128 + kq * 32 + k2) * 3072 + n0 + cl];
#pragma unroll
                    for (int k2 = 0; k2 < 32; ++k2) { const int kl = kq * 32 + k2;
#pragma unroll
                        for (int r = 0; r < 33; ++r) a[r] += Ssil[r * 128 + kl] * wv[k2]; }
                }
                __syncthreads();
#pragma unroll
                for (int r = 0; r < 33; ++r) red[(kq * 33 + r) * 128 + cl] = a[r];
                __syncthreads();
                for (int e = tid; e < 33 * 128; e += 512) { const int r = e >> 7, c = e & 127;
                    ((GAS float*)modv)[((size_t)L * 33 + r) * 3072 + n0 + c] = red[(0 * 33 + r) * 128 + c] + red[(1 * 33 + r) * 128 + c] + red[(2 * 33 + r) * 128 + c] + red[(3 * 33 + r) * 128 + c] + ((const GAS float*)mod_b)[L * 3072 + n0 + c]; }
                __syncthreads();
            }
        }
        { float* cosT = (float*)(dob + DO_ROPE); float* sinT = cosT + 2048 * 32;
          for (int e = (vcu * 512 + tid); e < 2048 * 32; e += G * 512) {
            const int pos = e >> 5, i = e & 31; const float invf = __builtin_amdgcn_exp2f(-(float)(i & 15) * (13.287712379549449f / 16.0f));
            const float ang = (float)((i < 16) ? (pos >> 6) : (pos & 63)) * invf;
            ((GAS float*)cosT)[e] = __cosf(ang); ((GAS float*)sinT)[e] = __sinf(ang); } }
    }
    GRID_BAR();
    {
        PH_BEGIN
        const float* x = inp(lds, 0); const float* ctxin = inp(lds, 2);
        for (int rg = gw; rg < TOK / 4; rg += NGW) {
            const int r0 = rg * 4, b = r0 / SB, s = r0 % SB, midx = (s < CTXL) ? 32 : b;
            const float* src = (s < CTXL) ? ctxin + ((size_t)b * CTXL + s) * DM : x + ((size_t)b * SEQ + (s - CTXL)) * DM;
            const float* mv = modv + (size_t)midx * 3072;
            f32x4 v[4][4];
#pragma unroll
            for (int i = 0; i < 4; ++i)
#pragma unroll
                for (int jq = 0; jq < 4; ++jq) v[i][jq] = *(const GAS f32x4*)(src + (size_t)i * DM + jq * 256 + lane * 4);
#pragma unroll
            for (int jq = 0; jq < 4; ++jq) { const int c = jq * 256 + lane * 4; const f32x4 sh = *(const GAS f32x4*)(mv + c), sc = *(const GAS f32x4*)(mv + 1024 + c) + 1.0f;
#pragma unroll
                for (int i = 0; i < 4; ++i) { const f32x4 u = v[i][jq] * sc + sh;
                    u32x2 hw, uw; hw.x = cvt_pk_bf16(v[i][jq][0], v[i][jq][1]); hw.y = cvt_pk_bf16(v[i][jq][2], v[i][jq][3]); uw.x = cvt_pk_bf16(u[0], u[1]); uw.y = cvt_pk_bf16(u[2], u[3]);
                    *(GAS u32x2*)(H + (size_t)(r0 + i) * DM + c) = hw; *(GAS u32x2*)(U + (size_t)(r0 + i) * DM + c) = uw; } }
        }
    }
    GRID_BAR();

    for (int j = 0; j < 2; ++j) {
        { PH_BEGIN
          pg8::Gemm g{U, (const bf16_t*)(dob + DO_W + (size_t)j * W_PAIR + W_EVIN), DM, DM, NTILE, 37, 0, 1, 1, 0}; pg8::StaticOrder S; S.init(NTILE, 37, G, bx);
          EpiEvIn E{BIG, (float*)(dob + DO_SMALL), inp(lds, 10) + j * 16}; pg8::gemm_phase(lds, tid, g, S, E); }
        GRID_BAR();
        {   PH_BEGIN
            const float* cw = inp(lds, 9) + (size_t)j * 3 * 1024;
            const bool conv_in_scan = (G == NB * 8);
            if (!conv_in_scan) for (int rg = gw; rg < TOK / 4; rg += NGW) conv_rowgroup(BIG, cw, rg, lane);
            {
                for (int it = vcu; it < NB * 8; it += G) {
                    unsigned char* w2 = ws; unsigned char* d2 = dob; asm volatile("" : "+s"(w2), "+s"(d2));
                    const int b = it >> 3, head = (it >> 1) & 3, dh = it & 1;
                    msc::scan_item((const bf16_t*)(w2 + WS_BIG) + (size_t)b * SB * EV_LD, (const float*)(d2 + DO_SMALL) + (size_t)b * SB * 16, (bf16_t*)(d2 + DO_U) + (size_t)b * SB * DM, head, dh, lds, wave0, (bf16_t*)(w2 + WS_BIG), cw, conv_in_scan ? gw : -1, NGW);
                }
            }
        }
        GRID_BAR();
        { PH_BEGIN
          pg8::Gemm g{BIG, (const bf16_t*)(dob + DO_W + (size_t)j * W_PAIR + W_EVOUT), EV_LD, 2048, NTILE, 4, 0, 1, 1, 0}; pg8::StaticOrder S; S.init(NTILE, 4, G, bx);
          EpiOut E{H, modv + (size_t)(2 * j) * 33 * 3072}; pg8::gemm_phase(lds, tid, g, S, E); }
        GRID_BAR();
        {   PH_BEGIN
            const int L = 2 * j;
            ln_phase<false>(H, U, nullptr, inp(lds, 6) + L * DM, inp(lds, 7) + L * DM, modv + (size_t)(L + 1) * 33 * 3072, gw, NGW, lane, 0u);
        }
        GRID_BAR();
        const bool need_ctx = (j == 0);
        { PH_BEGIN
          pg8::Gemm g{U, (const bf16_t*)(dob + DO_W + (size_t)j * W_PAIR + W_ODIN), DM, DM, NTILE, 11, 0, 1, 1, 0}; pg8::StaticOrder S; S.init(NTILE, 11, G, bx);
          EpiOdIn E{BIG}; pg8::gemm_phase(lds, tid, g, S, E); }
        GRID_BAR();
        {   PH_BEGIN
            float* rowsc = (float*)(dob + DO_ROWSC); bf16_t* KR = (bf16_t*)(dob + DO_SMALL); const float* cosT = (const float*)(dob + DO_ROPE); const float* sinT = cosT + 2048 * 32;
            for (int rg = gw; rg < TOK / 4; rg += NGW) {
                const int r0 = rg * 4, s0 = r0 % SB; const bool lat = s0 >= CTXL;
                unsigned wq[4][3], wk[4][2]; bf16_t x1[4], x2[4]; float cc[4], sn[4];
#pragma unroll
                for (int i = 0; i < 4; ++i) { const GAS bf16_t* orow = (const GAS bf16_t*)BIG + (size_t)(r0 + i) * OD_LD + 2048;
#pragma unroll
                    for (int q = 0; q < 3; ++q) wq[i][q] = *(const GAS unsigned*)(orow + (q * 64 + lane) * 2);
#pragma unroll
                    for (int q = 0; q < 2; ++q) wk[i][q] = *(const GAS unsigned*)(orow + 384 + (q * 64 + lane) * 2);
                    x1[i] = orow[640 + (lane & 31)]; x2[i] = orow[672 + (lane & 31)];
                    cc[i] = 1.f; sn[i] = 0.f;
                    if (lat) { cc[i] = ((const GAS float*)cosT)[(s0 + i - CTXL) * 32 + (lane & 31)]; sn[i] = ((const GAS float*)sinT)[(s0 + i - CTXL) * 32 + (lane & 31)]; } }
                float sq[4], sk[4];
#pragma unroll
                for (int i = 0; i < 4; ++i) { sq[i] = 0.f; sk[i] = 0.f;
#pragma unroll
                    for (int q = 0; q < 3; ++q) { const float a = bflo(wq[i][q]), c = bfhi(wq[i][q]); sq[i] += a * a + c * c; }
#pragma unroll
                    for (int q = 0; q < 2; ++q) { const float a = bflo(wk[i][q]), c = bfhi(wk[i][q]); sk[i] += a * a + c * c; } }
#pragma unroll
                for (int o = 1; o < 64; o <<= 1)
#pragma unroll
                    for (int i = 0; i < 4; ++i) { sq[i] += __shfl_xor(sq[i], o); sk[i] += __shfl_xor(sk[i], o); }
#pragma unroll
                for (int i = 0; i < 4; ++i) { const size_t r = (size_t)(r0 + i);
                    if (lane == 0) { ((GAS float*)rowsc)[r * 2] = 1.0f / sqrtf(sq[i] * (1.0f / 384.0f) + RMS_EPS); ((GAS float*)rowsc)[r * 2 + 1] = 1.0f / sqrtf(sk[i] * (1.0f / 256.0f) + RMS_EPS); }
                    if (lane < 32) { const float a = bf1(x1[i]), c = bf1(x2[i]);
                        ((GAS bf16_t*)KR)[r * 64 + lane] = f2bf(a * cc[i] - c * sn[i]); ((GAS bf16_t*)KR)[r * 64 + 32 + lane] = f2bf(a * sn[i] + c * cc[i]); } }
            }
        }
        GRID_BAR();
        for (int grp = 0; grp < NGRP; ++grp) {
            { PH_BEGIN
              const float* rowsc = (const float*)(dob + DO_ROWSC); const float* cosT = (const float*)(dob + DO_ROPE);
              pg8::Gemm g{BIG + 2048, (const bf16_t*)(dob + DO_W + (size_t)j * W_PAIR + W_UQ), OD_LD, 384, need_ctx ? GT : GB * 8, 12, grp * GT, need_ctx ? 1 : 8, need_ctx ? 1 : 9, need_ctx ? 0 : 1};
              pg8::StaticOrder S; S.init(g.nM, 12, G, bx); EpiUq E{(bf16_t*)(ws + WS_BIG + BIG_Q), rowsc, cosT, cosT + 2048 * 32, grp}; pg8::gemm_phase(lds, tid, g, S, E); }
            { PH_BEGIN
              const float* rowsc = (const float*)(dob + DO_ROWSC);
              pg8::Gemm g{BIG + 2432, (const bf16_t*)(dob + DO_W + (size_t)j * W_PAIR + W_UKV), OD_LD, 256, GT, 16, grp * GT, 1, 1, 0};
              pg8::StaticOrder S; S.init(GT, 16, G, bx); EpiUkv E{(bf16_t*)(ws + WS_BIG + BIG_K), (bf16_t*)(ws + WS_BIG + BIG_V), rowsc, (const bf16_t*)(dob + DO_SMALL), grp}; pg8::gemm_phase(lds, tid, g, S, E); }
            GRID_BAR();
            {   PH_BEGIN
                const int nunits = GB * 16 * 8 + (need_ctx ? GB * 16 : 0);
                for (int un = vcu; un < nunits; un += G) {
                    unsigned char* w2 = ws; asm volatile("" : "+s"(w2));
                    const bf16_t* Qb = (const bf16_t*)(w2 + WS_BIG + BIG_Q); const bf16_t* Kb = (const bf16_t*)(w2 + WS_BIG + BIG_K); const bf16_t* Vb = (const bf16_t*)(w2 + WS_BIG + BIG_V);
                    bf16_t* BIG2 = (bf16_t*)(w2 + WS_BIG);
                    int bl, head, qb, nkeys;
                    if (un < GB * 128) { bl = un >> 7; head = (un >> 3) & 15; qb = 1 + (un & 7); nkeys = SB; }
                    else { const int u2 = un - GB * 128; bl = u2 >> 4; head = u2 & 15; qb = 0; nkeys = CTXL; }
                    const size_t bh = (size_t)(bl * 16 + head) * SB;
                    att::attn_unit(Qb + (bh + qb * 256) * 192, Kb + bh * 192, Vb + bh * 128, BIG2 + (size_t)((grp * GB + bl) * SB + qb * 256) * OD_LD + head * 128, nkeys, lds, tid);
                }
            }
            GRID_BAR();
        }
        { PH_BEGIN
          pg8::Gemm g{BIG, (const bf16_t*)(dob + DO_W + (size_t)j * W_PAIR + W_ODOUT), OD_LD, 2048, need_ctx ? NTILE : NB * 8, 4, 0, need_ctx ? 1 : 8, need_ctx ? 1 : 9, need_ctx ? 0 : 1}; pg8::StaticOrder S; S.init(g.nM, 4, G, bx);
          EpiOut E{H, modv + (size_t)(2 * j + 1) * 33 * 3072}; pg8::gemm_phase(lds, tid, g, S, E); }
        GRID_BAR();
        {   PH_BEGIN
            const int L = 2 * j + 1;
            if (need_ctx) ln_phase<false>(H, U, nullptr, inp(lds, 6) + L * DM, inp(lds, 7) + L * DM, modv + (size_t)(L + 1) * 33 * 3072, gw, NGW, lane, 0u);
            else { const unsigned tmo = __hip_atomic_load((GAS unsigned*)(ws + WS_CTL) + 4096 + XB_TMO, __ATOMIC_RELAXED, __HIP_MEMORY_SCOPE_AGENT);
                   ln_phase<true>(H, nullptr, (float*)dob, inp(lds, 6) + L * DM, inp(lds, 7) + L * DM, nullptr, gw, NGW, lane, tmo); }
        }
        if (need_ctx) GRID_BAR();
    }
}

extern "C" void kernel_launch(void* const* d_in, const int* in_sizes, int n_in, void* d_out, int out_size, void* d_ws, size_t ws_size, hipStream_t stream) {
    static int grid = 0;
    if (grid == 0) {
        if (n_in != 18 || out_size != NB * SEQ * DM || ws_size < WS_END) { fprintf(stderr, "kernel_launch: unexpected shapes (n_in %d out %d ws %zu)\n", n_in, out_size, ws_size); grid = -1; return; }
        int dev = 0, cus = 0;
        if (hipGetDevice(&dev) != hipSuccess || hipDeviceGetAttribute(&cus, hipDeviceAttributeMultiprocessorCount, dev) != hipSuccess) { grid = -1; return; }
        if (hipFuncSetAttribute((const void*)fwd_kernel, hipFuncAttributeMaxDynamicSharedMemorySize, LDS_BYTES) != hipSuccess) { fprintf(stderr, "kernel_launch: hipFuncSetAttribute failed\n"); grid = -1; return; }
        int per_cu = 0;
        if (hipOccupancyMaxActiveBlocksPerMultiprocessor(&per_cu, (const void*)fwd_kernel, 512, LDS_BYTES) != hipSuccess || per_cu < 1) fprintf(stderr, "kernel_launch: occupancy query says %d\n", per_cu);
        (void)hipGetLastError();
        grid = cus;
    }
    if (grid < 0) return;
    if (hipMemsetAsync((char*)d_ws + WS_CTL, 0, CTL_BYTES, stream) != hipSuccess) return;
    Params p{};
    for (int i = 0; i < 18; ++i) p.in[i] = (const float*)d_in[i];
    p.out = (float*)d_out; p.ws = (unsigned char*)d_ws;
    hipLaunchKernelGGL(fwd_kernel, dim3(grid), dim3(512), LDS_BYTES, stream, p);
}
```
